# Optimizing an MI355X kernel written in HIP

```python
import math
import jax, jax.numpy as jnp
from jax import lax
import numpy as np

D_MODEL = 1024
BATCH = 16
SEQ = 256
DEPTH = 2
DEC_BATCH = 2
DEC_SEQ = 2048
PAST_LEN = 256

GRID_W = 64
N_MIXERS = 2
N_ATTN_LAYERS = (DEPTH + 1) // 2
N_SSM_LAYERS = DEPTH // 2
N_HEADS = 16
N_KV_HEADS = 4
HEAD_DIM = D_MODEL // N_HEADS
Q_PER_KV = N_HEADS // N_KV_HEADS
QKV_DIM = (N_HEADS + 2 * N_KV_HEADS) * HEAD_DIM
WINDOW = 128
BLOCK = 128
ATTN_SCALE = HEAD_DIM ** -0.5
ROPE_BASE = 10000.0
GROUP_CH = 16
N_GROUPS = D_MODEL // GROUP_CH
STATE_DIM = 64
D_FF = 4 * D_MODEL
N_MOD = 6
RMS_EPS = 1e-6
NEG_INF = -1e30

kernel_name = "hybrid_swa_s5_diffusion_step"


def _rmsnorm(x, g):
    x32 = x.astype(jnp.float32)
    y = x32 * lax.rsqrt(jnp.mean(x32 * x32, axis=-1, keepdims=True) + RMS_EPS)
    return (y * g.astype(jnp.float32)).astype(x.dtype)


def _modulation(cvec, w_mod, b_mod):
    return jnp.split(jax.nn.silu(cvec) @ w_mod + b_mod, N_MOD, axis=-1)


def _modulate(x, g, shift, scale):
    return _rmsnorm(x, g) * (1 + scale) + shift


def _mlp(h, w1, w2):
    a = jax.nn.relu(h @ w1)
    return (a * a) @ w2


def _split_qkv(qkv):
    b, l = qkv.shape[:2]
    q = qkv[..., :N_HEADS * HEAD_DIM].reshape(b, l, N_HEADS, HEAD_DIM)
    k = qkv[..., N_HEADS * HEAD_DIM:(N_HEADS + N_KV_HEADS) * HEAD_DIM].reshape(b, l, N_KV_HEADS, HEAD_DIM)
    v = qkv[..., (N_HEADS + N_KV_HEADS) * HEAD_DIM:].reshape(b, l, N_KV_HEADS, HEAD_DIM)
    return q, k, v


def _grid_positions(n_tokens):
    rows = n_tokens // GRID_W
    row = jnp.repeat(jnp.arange(rows, dtype=jnp.float32), GRID_W)
    col = jnp.tile(jnp.arange(GRID_W, dtype=jnp.float32), rows)
    return row, col


def _rotate(x, ang):
    cos = jnp.cos(ang)[None, :, None, :].astype(x.dtype)
    sin = jnp.sin(ang)[None, :, None, :].astype(x.dtype)
    x1, x2 = jnp.split(x, 2, axis=-1)
    return jnp.concatenate([x1 * cos - x2 * sin, x1 * sin + x2 * cos], axis=-1)


def _axial_rope(x, row, col):
    n_freq = HEAD_DIM // 4
    freqs = ROPE_BASE ** (-jnp.arange(n_freq, dtype=jnp.float32) / n_freq)
    half = HEAD_DIM // 2
    return jnp.concatenate([_rotate(x[..., :half], row[:, None] * freqs),
                            _rotate(x[..., half:], col[:, None] * freqs)], axis=-1)


def _sink_column(sink, lead_shape):
    s = sink.astype(jnp.float32).reshape((1,) * (len(lead_shape) - 3) + (N_KV_HEADS, Q_PER_KV, 1, 1))
    return jnp.broadcast_to(s, lead_shape + (1,))


def _context_attention(q, k, v, sink):
    b, l = q.shape[:2]
    nb = l // BLOCK
    qb = q.reshape(b, nb, BLOCK, N_KV_HEADS, Q_PER_KV, HEAD_DIM).transpose(1, 0, 2, 3, 4, 5)

    def one_block(q_blk):
        s = jnp.einsum('bqkgd,bckd->bkgqc', q_blk, k).astype(jnp.float32) * ATTN_SCALE
        logits = jnp.concatenate([s, _sink_column(sink, s.shape[:-1])], axis=-1)
        p = jax.nn.softmax(logits, axis=-1)[..., :-1].astype(v.dtype)
        o = jnp.einsum('bkgqc,bckd->bqkgd', p, v)
        return o.reshape(b, BLOCK, N_HEADS * HEAD_DIM)

    out = lax.map(one_block, qb)
    return out.transpose(1, 0, 2, 3).reshape(b, l, N_HEADS * HEAD_DIM)


def _latent_window_attention(q, k, v, k_ctx, v_ctx, sink):
    b, l = q.shape[:2]
    nb = l // BLOCK
    lc = k_ctx.shape[1]
    pad = ((0, 0), (BLOCK, BLOCK), (0, 0), (0, 0))
    kp = jnp.pad(k, pad).reshape(b, nb + 2, BLOCK, N_KV_HEADS, HEAD_DIM)
    vp = jnp.pad(v, pad).reshape(b, nb + 2, BLOCK, N_KV_HEADS, HEAD_DIM)
    kw = jnp.concatenate([kp[:, :-2], kp[:, 1:-1], kp[:, 2:]], axis=2)
    vw = jnp.concatenate([vp[:, :-2], vp[:, 1:-1], vp[:, 2:]], axis=2)
    qb = q.reshape(b, nb, BLOCK, N_KV_HEADS, Q_PER_KV, HEAD_DIM)
    s_win = jnp.einsum('bnqkgd,bnskd->bnkgqs', qb, kw).astype(jnp.float32) * ATTN_SCALE
    s_ctx = jnp.einsum('bnqkgd,bckd->bnkgqc', qb, k_ctx).astype(jnp.float32) * ATTN_SCALE
    r = jnp.arange(BLOCK)[:, None]
    j = jnp.arange(3 * BLOCK)[None, :]
    band = jnp.abs(j - BLOCK - r) <= WINDOW
    kpos = jnp.arange(nb)[:, None] * BLOCK - BLOCK + jnp.arange(3 * BLOCK)[None, :]
    valid = (kpos >= 0) & (kpos < l)
    mask = (band[None, :, :] & valid[:, None, :])[None, :, None, None]
    logits = jnp.concatenate([jnp.where(mask, s_win, NEG_INF), s_ctx,
                              _sink_column(sink, s_ctx.shape[:-1])], axis=-1)
    p = jax.nn.softmax(logits, axis=-1)
    p_win = p[..., :3 * BLOCK].astype(v.dtype)
    p_ctx = p[..., 3 * BLOCK:3 * BLOCK + lc].astype(v.dtype)
    o = (jnp.einsum('bnkgqs,bnskd->bnqkgd', p_win, vw)
         + jnp.einsum('bnkgqc,bckd->bnqkgd', p_ctx, v_ctx))
    return o.reshape(b, l, N_HEADS * HEAD_DIM)


def _complex_affine_combine(left, right):
    ar1, ai1, br1, bi1 = left
    ar2, ai2, br2, bi2 = right
    return (ar1 * ar2 - ai1 * ai2,
            ar1 * ai2 + ai1 * ar2,
            ar2 * br1 - ai2 * bi1 + br2,
            ar2 * bi1 + ai2 * br1 + bi2)


def _ssm_scan(u, lam_re, lam_im, log_dt, b_re, b_im, s0_re, s0_im, reverse):
    lam_re = lam_re.astype(jnp.float32)
    lam_im = lam_im.astype(jnp.float32)
    dt = jnp.exp(log_dt.astype(jnp.float32))[:, None]
    mag = jnp.exp(lam_re * dt)
    ang = lam_im * dt
    ab_re = mag * jnp.cos(ang)
    ab_im = mag * jnp.sin(ang)
    den = lam_re * lam_re + lam_im * lam_im
    num_re = ab_re - 1.0
    num_im = ab_im
    f_re = (num_re * lam_re + num_im * lam_im) / den
    f_im = (num_im * lam_re - num_re * lam_im) / den
    b_re = b_re.astype(jnp.float32)
    b_im = b_im.astype(jnp.float32)
    bb_re = f_re[..., None] * b_re - f_im[..., None] * b_im
    bb_im = f_re[..., None] * b_im + f_im[..., None] * b_re
    bu_re = jnp.einsum('blgc,gpc->blgp', u, bb_re)
    bu_im = jnp.einsum('blgc,gpc->blgp', u, bb_im)
    if reverse:
        bu_re = jnp.flip(bu_re, axis=1)
        bu_im = jnp.flip(bu_im, axis=1)
    s0_re = s0_re.astype(jnp.float32)
    s0_im = s0_im.astype(jnp.float32)
    first_re = ab_re * s0_re - ab_im * s0_im + bu_re[:, 0]
    first_im = ab_re * s0_im + ab_im * s0_re + bu_im[:, 0]
    bu_re = bu_re.at[:, 0].set(first_re)
    bu_im = bu_im.at[:, 0].set(first_im)
    a_re = jnp.broadcast_to(ab_re, bu_re.shape)
    a_im = jnp.broadcast_to(ab_im, bu_im.shape)
    _, _, s_re, s_im = lax.associative_scan(_complex_affine_combine, (a_re, a_im, bu_re, bu_im), axis=1)
    if reverse:
        s_re = jnp.flip(s_re, axis=1)
        s_im = jnp.flip(s_im, axis=1)
    return s_re, s_im


def _bidir_s5(h, s0, lam_re, lam_im, log_dt, b_re, b_im, c_re, c_im, d_skip, w_a, w_b):
    b, l, _ = h.shape
    u = h.astype(jnp.float32).reshape(b, l, N_GROUPS, GROUP_CH)
    y = u * d_skip.astype(jnp.float32).reshape(N_GROUPS, GROUP_CH)
    states = []
    for d in range(2):
        s_re, s_im = _ssm_scan(u, lam_re[d], lam_im[d], log_dt[d], b_re[d], b_im[d],
                               s0[:, d, 0], s0[:, d, 1], reverse=(d == 1))
        y = (y + jnp.einsum('blgp,gcp->blgc', s_re, c_re[d].astype(jnp.float32))
             - jnp.einsum('blgp,gcp->blgc', s_im, c_im[d].astype(jnp.float32)))
        states.append((s_re, s_im))
    y = jax.nn.gelu(y.reshape(b, l, D_MODEL).astype(h.dtype))
    return (y @ w_a) * jax.nn.sigmoid(y @ w_b), states


def setup_inputs(seed: int = 0) -> dict:
    key = jax.random.key(seed)
    ks = jax.random.split(key, 27)

    def nrm(k, shape, scale=1.0):
        return jax.random.normal(k, shape, jnp.float32) * scale

    lam_n = jnp.arange(STATE_DIM, dtype=jnp.float32)
    lam_re = -0.5 + nrm(ks[14], (N_SSM_LAYERS, 2, N_GROUPS, STATE_DIM), 0.01)
    lam_im = math.pi * lam_n + nrm(ks[15], (N_SSM_LAYERS, 2, N_GROUPS, STATE_DIM), 0.01)
    log_dt = jax.random.uniform(ks[16], (N_SSM_LAYERS, 2, N_GROUPS), jnp.float32,
                                math.log(1e-3), math.log(1e-1))
    return {
        "x_prompt": nrm(ks[0], (BATCH, SEQ, D_MODEL)),
        "x_sample": nrm(ks[1], (DEC_BATCH, DEC_SEQ, D_MODEL)),
        "cache_k": nrm(ks[2], (DEC_BATCH, N_ATTN_LAYERS, PAST_LEN, N_KV_HEADS, HEAD_DIM)),
        "cache_v": nrm(ks[3], (DEC_BATCH, N_ATTN_LAYERS, PAST_LEN, N_KV_HEADS, HEAD_DIM)),
        "state_ssm": nrm(ks[4], (DEC_BATCH, N_SSM_LAYERS, 2, 2, N_GROUPS, STATE_DIM), 0.1),
        "c": nrm(ks[5], (DEC_BATCH, D_MODEL)),
        "c_ctx": nrm(ks[6], (D_MODEL,)),
        "norm1_g": 1.0 + nrm(ks[7], (DEPTH, D_MODEL), 0.01),
        "norm2_g": 1.0 + nrm(ks[8], (DEPTH, D_MODEL), 0.01),
        "w_mod": nrm(ks[9], (DEPTH, D_MODEL, N_MOD * D_MODEL), 0.5 * D_MODEL ** -0.5),
        "b_mod": nrm(ks[10], (DEPTH, N_MOD * D_MODEL), 0.01),
        "w_qkv": nrm(ks[11], (N_ATTN_LAYERS, D_MODEL, QKV_DIM), D_MODEL ** -0.5),
        "w_o": nrm(ks[12], (N_ATTN_LAYERS, N_HEADS * HEAD_DIM, D_MODEL), (N_HEADS * HEAD_DIM) ** -0.5),
        "attn_sink": nrm(ks[13], (N_ATTN_LAYERS, N_HEADS), 0.5),
        "ssm_lam_re": lam_re,
        "ssm_lam_im": lam_im,
        "ssm_log_dt": log_dt,
        "ssm_b_re": nrm(ks[17], (N_SSM_LAYERS, 2, N_GROUPS, STATE_DIM, GROUP_CH), (2 * GROUP_CH) ** -0.5),
        "ssm_b_im": nrm(ks[18], (N_SSM_LAYERS, 2, N_GROUPS, STATE_DIM, GROUP_CH), (2 * GROUP_CH) ** -0.5),
        "ssm_c_re": nrm(ks[19], (N_SSM_LAYERS, 2, N_GROUPS, GROUP_CH, STATE_DIM), STATE_DIM ** -0.5),
        "ssm_c_im": nrm(ks[20], (N_SSM_LAYERS, 2, N_GROUPS, GROUP_CH, STATE_DIM), STATE_DIM ** -0.5),
        "ssm_d": nrm(ks[21], (N_SSM_LAYERS, D_MODEL)),
        "glu_w_a": nrm(ks[22], (N_SSM_LAYERS, D_MODEL, D_MODEL), D_MODEL ** -0.5),
        "glu_w_b": nrm(ks[23], (N_SSM_LAYERS, D_MODEL, D_MODEL), D_MODEL ** -0.5),
        "mlp_w1": nrm(ks[24], (DEPTH, D_MODEL, D_FF), D_MODEL ** -0.5),
        "mlp_w2": nrm(ks[25], (DEPTH, D_FF, D_MODEL), D_FF ** -0.5),
        "final_norm_g": 1.0 + nrm(ks[26], (D_MODEL,), 0.01),
    }


def reference(x_prompt, x_sample, cache_k, cache_v, state_ssm, c, c_ctx,
              norm1_g, norm2_g, w_mod, b_mod, w_qkv, w_o, attn_sink,
              ssm_lam_re, ssm_lam_im, ssm_log_dt, ssm_b_re, ssm_b_im, ssm_c_re, ssm_c_im,
              ssm_d, glu_w_a, glu_w_b, mlp_w1, mlp_w2, final_norm_g):
    xp = x_prompt
    xx = x_sample
    bp = xp.shape[0]
    row, col = _grid_positions(xx.shape[1])
    new_k, new_v, new_s = [], [], []
    for i in range(DEPTH):
        j = i // N_MIXERS
        sh1p, sc1p, g1p, sh2p, sc2p, g2p = _modulation(c_ctx[None, None, :], w_mod[i], b_mod[i])
        sh1x, sc1x, g1x, sh2x, sc2x, g2x = _modulation(c[:, None, :], w_mod[i], b_mod[i])
        hp = _modulate(xp, norm1_g[i], sh1p, sc1p)
        hx = _modulate(xx, norm1_g[i], sh1x, sc1x)
        if i % N_MIXERS == 0:
            qp, kp, vp = _split_qkv(hp @ w_qkv[j])
            new_k.append(kp)
            new_v.append(vp)
            op = _context_attention(qp, kp, vp, attn_sink[j]) @ w_o[j]
            qx, kx, vx = _split_qkv(hx @ w_qkv[j])
            qx = _axial_rope(qx, row, col)
            kx = _axial_rope(kx, row, col)
            ox = _latent_window_attention(qx, kx, vx, cache_k[:, j], cache_v[:, j], attn_sink[j]) @ w_o[j]
        else:
            ssm_args = (ssm_lam_re[j], ssm_lam_im[j], ssm_log_dt[j], ssm_b_re[j], ssm_b_im[j],
                        ssm_c_re[j], ssm_c_im[j], ssm_d[j], glu_w_a[j], glu_w_b[j])
            s0p = jnp.zeros((bp, 2, 2, N_GROUPS, STATE_DIM), jnp.float32)
            op, st = _bidir_s5(hp, s0p, *ssm_args)
            fwd_final = jnp.stack([st[0][0][:, -1], st[0][1][:, -1]], axis=1)
            bwd_final = jnp.stack([st[1][0][:, 0], st[1][1][:, 0]], axis=1)
            new_s.append(jnp.stack([fwd_final, bwd_final], axis=1))
            ox, _ = _bidir_s5(hx, state_ssm[:, j], *ssm_args)
        xp = xp + g1p * op
        xx = xx + g1x * ox
        xp = xp + g2p * _mlp(_modulate(xp, norm2_g[i], sh2p, sc2p), mlp_w1[i], mlp_w2[i])
        xx = xx + g2x * _mlp(_modulate(xx, norm2_g[i], sh2x, sc2x), mlp_w1[i], mlp_w2[i])
    y_prompt = _rmsnorm(xp, final_norm_g)
    y_sample = _rmsnorm(xx, final_norm_g)
    new_cache_k = jnp.stack(new_k, axis=1)
    new_cache_v = jnp.stack(new_v, axis=1)
    new_state_ssm = jnp.stack(new_s, axis=1)
    return (y_prompt, y_sample, new_cache_k, new_cache_v, new_state_ssm)
```

```cpp
#include <hip/hip_runtime.h>
#include <hip/hip_cooperative_groups.h>
#include <cstdio>
#include <cstdint>
namespace cg = cooperative_groups;

#define LAS __attribute__((address_space(3)))
typedef unsigned short bf16_t;
typedef short bf16x8 __attribute__((ext_vector_type(8)));
typedef float f32x4 __attribute__((ext_vector_type(4)));
typedef float f32x16 __attribute__((ext_vector_type(16)));
typedef float f32x2 __attribute__((ext_vector_type(2)));
typedef unsigned u32x4 __attribute__((ext_vector_type(4)));
typedef unsigned u32x2 __attribute__((ext_vector_type(2)));
typedef __bf16 bf16x2v __attribute__((ext_vector_type(2)));
#define DI __device__ __forceinline__

DI unsigned pk2(float a, float b) { f32x2 v = {a, b}; bf16x2v r = __builtin_convertvector(v, bf16x2v); return __builtin_bit_cast(unsigned, r); }
DI float bf2f(unsigned short u) { return __builtin_bit_cast(float, (unsigned)u << 16); }
DI float wave_sum(float v) {
#pragma unroll
    for (int o = 1; o < 64; o <<= 1) v += __shfl_xor(v, o);
    return v;
}

constexpr int T = 8192, D = 1024, FF = 4096, NQKV = 1536, TCTX = 4096, LLAT = 2048;
constexpr int KROWS = 8704;
constexpr size_t MiB = 1u << 20;
constexpr size_t WS_MOD = 1 * MiB;
constexpr size_t WS_ABAR = 2 * MiB;
constexpr size_t WS_BBM = 2 * MiB + 128 * 1024;
constexpr size_t WS_CCM = 2 * MiB + 640 * 1024;
constexpr size_t WS_ROPE = 3 * MiB + 256 * 1024;
constexpr size_t WS_WQKV = 4 * MiB, WS_WO = 7 * MiB, WS_WGLU = 9 * MiB, WS_W1 = 13 * MiB, WS_W2 = 29 * MiB;
constexpr size_t WS_KB = 45 * MiB, WS_VT = 50 * MiB;
constexpr size_t WS_HB = 56 * MiB, WS_QB = 72 * MiB, WS_OB = 88 * MiB, WS_X = 104 * MiB, WS_P1 = 136 * MiB, WS_AB = 168 * MiB;
constexpr size_t WS_YP = 168 * MiB;
constexpr int OUT_K = 8388608, OUT_V = 8388608 + 1048576, OUT_S = 8388608 + 2 * 1048576;

struct Params { const float* in[27]; float* out; unsigned char* ws; int ph_lo, ph_hi; };

namespace pg8 {
constexpr int BM = 256, BK = 64, HALF = 128, HTB = HALF * BK * 2, STAGE_BYTES = 8 * HTB, NXCD = 8, WGM = 8;
__host__ __device__ __forceinline__ int lds_byte(int r, int c) { const int st = (r >> 4) * 2 + (c >> 5), rr = r & 15, cc = c & 31, ob = rr * 64 + cc * 2; return st * 1024 + (ob ^ (((ob >> 9) & 1) << 5)); }
__host__ __device__ __forceinline__ void stage_rc(int b, int& R, int& C) { const int st = b / 1024, sb = b % 1024, swz = sb ^ (((sb >> 9) & 1) << 5); R = (st >> 1) * 16 + swz / 64; C = (st & 1) * 32 + (swz % 64) / 2; }
__host__ __device__ __forceinline__ int perm32(int rho) { const int n = rho >> 4, i = rho & 15; return 8 * (i >> 2) + 4 * n + (i & 3); }

struct Unit { int pm, pn, ks; };
struct Gemm { const bf16_t* A; const bf16_t* Bt; int ld, Kloop; };

struct StaticOrder {
    int nM, nN, nNv, nwg, G, c;
    __device__ void init(int M, int N, int split, int G_, int c_) { nM = M / BM; nN = N / BM; nNv = nN * split; nwg = nM * nNv; G = G_; c = c_; }
    __device__ bool next(int i, Unit& u) const {
        const long L = (long)i * G + c; if (L >= nwg) return false;
        int wgid = (int)L; { const int q = nwg / NXCD, r = nwg % NXCD, xcd = wgid % NXCD, off = wgid / NXCD; wgid = (xcd < r ? xcd * (q + 1) : r * (q + 1) + (xcd - r) * q) + off; }
        const int nig = WGM * nNv, gid = wgid / nig, fm = gid * WGM, gsz = (nM - fm) < WGM ? (nM - fm) : WGM;
        u.pm = fm + ((wgid % nig) % gsz); const int pv = (wgid % nig) / gsz; u.pn = pv % nN; u.ks = pv / nN; return true;
    }
};

template <class Epi>
__device__ __forceinline__ void gemm_phase(LAS unsigned char* lds, const Gemm g, const StaticOrder& S, const Epi& E) {
    const int tid = threadIdx.x, wid = __builtin_amdgcn_readfirstlane(tid >> 6), lane = tid & 63, wr = wid >> 2, wc = wid & 3, fr = lane & 15, fq = lane >> 4;
    const int ld = g.ld, nt = g.Kloop / BK;
    unsigned voffA[2], voffB[2];
#pragma unroll
    for (int i = 0; i < 2; ++i) { int R, C; stage_rc(tid * 16 + i * 8192, R, C); const int Rb = Epi::PERM ? ((R & ~31) + perm32(R & 31)) : R;
        voffA[i] = (unsigned)(R * ld + C) * 2u; voffB[i] = (unsigned)(Rb * ld + C) * 2u; }
    const size_t kstep = (size_t)(BK * 2);
    const size_t hstep = (size_t)HALF * ld * 2;
    const size_t tstep = 2 * hstep;
    const size_t kso = (size_t)g.Kloop * 2;
    const unsigned ldsw = (unsigned)wid * 1024u;
    const int aoff = lds_byte(wr * 64 + fr, fq * 8), boff = lds_byte(wc * 32 + fr, fq * 8);
#define PG8_SA(b, h) (((b) * 2 + (h)) * HTB)
#define PG8_SB(b, h) ((4 + (b) * 2 + (h)) * HTB)
#define PG8_STAGE(bufoff, gbase, voff) do { _Pragma("unroll") for (int _i = 0; _i < 2; ++_i) \
        __builtin_amdgcn_global_load_lds((const unsigned*)((const char*)(gbase) + (voff)[_i]), (LAS unsigned*)(lds + (bufoff) + ldsw + _i * 8192), 16, 0, 0); } while (0)
#define PG8_LDA(dst, b, h) do { _Pragma("unroll") for (int m = 0; m < 4; ++m) _Pragma("unroll") for (int k = 0; k < 2; ++k) dst[m][k] = *(const LAS bf16x8*)(lds + PG8_SA(b, h) + aoff + m * 2048 + k * 1024); } while (0)
#define PG8_LDB(dst, b, h) do { _Pragma("unroll") for (int n = 0; n < 2; ++n) _Pragma("unroll") for (int k = 0; k < 2; ++k) dst[n][k] = *(const LAS bf16x8*)(lds + PG8_SB(b, h) + boff + n * 2048 + k * 1024); } while (0)
#define PG8_MMA(ai, bj, At, Bt) do { __builtin_amdgcn_s_setprio(1); _Pragma("unroll") for (int m = 0; m < 4; ++m) _Pragma("unroll") for (int n = 0; n < 2; ++n) _Pragma("unroll") for (int k = 0; k < 2; ++k) \
        acc[ai][bj][m][n] = __builtin_amdgcn_mfma_f32_16x16x32_bf16(Bt[n][k], At[m][k], acc[ai][bj][m][n], 0, 0, 0); __builtin_amdgcn_s_setprio(0); } while (0)
#define PG8_WAIT_V(n) asm volatile("s_waitcnt vmcnt(" #n ")" ::: "memory")
#define PG8_WAIT_L(n) asm volatile("s_waitcnt lgkmcnt(" #n ")" ::: "memory")
#define PG8_BAR __builtin_amdgcn_s_barrier()
#define PG8_SCHED __builtin_amdgcn_sched_barrier(0)
#define PG8_UA(u) ((const char*)g.A + (size_t)(u).pm * tstep + (size_t)(u).ks * kso)
#define PG8_UB(u) ((const char*)g.Bt + (size_t)(u).pn * tstep + (size_t)(u).ks * kso)
    Unit cur, nxt; int ui = 0;
    if (!S.next(0, cur)) return;
    f32x4 acc[2][2][4][2];
#pragma unroll
    for (int a = 0; a < 2; ++a)
#pragma unroll
        for (int b = 0; b < 2; ++b)
#pragma unroll
            for (int m = 0; m < 4; ++m)
#pragma unroll
                for (int n = 0; n < 2; ++n) acc[a][b][m][n] = (f32x4){0.f, 0.f, 0.f, 0.f};
    bf16x8 At[4][2], B0[2][2], B1[2][2];
    const char* cA = PG8_UA(cur); const char* cB = PG8_UB(cur);
    PG8_STAGE(PG8_SB(0, 0), cB, voffB); PG8_STAGE(PG8_SB(0, 1), cB + hstep, voffB); PG8_STAGE(PG8_SA(0, 0), cA, voffA); PG8_STAGE(PG8_SA(0, 1), cA + hstep, voffA);
    if (wr == 1) PG8_BAR;
    PG8_WAIT_V(2); PG8_BAR;
    PG8_STAGE(PG8_SB(1, 0), cB + kstep, voffB); PG8_STAGE(PG8_SA(1, 0), cA + kstep, voffA); PG8_STAGE(PG8_SB(1, 1), cB + hstep + kstep, voffB);
    PG8_WAIT_V(6); PG8_BAR;
    for (;;) {
        const bool has_next = S.next(ui + 1, nxt);
        const char* nA = has_next ? PG8_UA(nxt) : cA; const char* nB = has_next ? PG8_UB(nxt) : cB;
        for (int t = 0; t < nt; t += 2) {
            const bool last = (t == nt - 2);
            const char* a1 = cA + (size_t)(t + 1) * kstep;
            const char* a2 = last ? nA : cA + (size_t)(t + 2) * kstep; const char* b2 = last ? nB : cB + (size_t)(t + 2) * kstep;
            const char* a3 = a2 + kstep; const char* b3 = b2 + kstep;
            PG8_LDB(B0, 0, 0); PG8_LDB(B1, 0, 1); PG8_SCHED; PG8_LDA(At, 0, 0); PG8_STAGE(PG8_SA(1, 1), a1 + hstep, voffA);
            PG8_WAIT_V(8); PG8_WAIT_L(0); PG8_BAR; PG8_MMA(0, 0, At, B0); PG8_MMA(0, 1, At, B1); PG8_BAR; PG8_SCHED;
            PG8_LDA(At, 0, 1); PG8_STAGE(PG8_SB(0, 0), b2, voffB); PG8_STAGE(PG8_SB(0, 1), b2 + hstep, voffB); PG8_STAGE(PG8_SA(0, 0), a2, voffA);
            PG8_WAIT_V(8); PG8_WAIT_L(0); PG8_BAR; PG8_MMA(1, 0, At, B0); PG8_MMA(1, 1, At, B1); PG8_BAR; PG8_SCHED;
            PG8_LDB(B0, 1, 0); PG8_LDB(B1, 1, 1); PG8_SCHED; PG8_LDA(At, 1, 0); PG8_STAGE(PG8_SA(0, 1), a2 + hstep, voffA);
            PG8_WAIT_V(8); PG8_WAIT_L(0); PG8_BAR; PG8_MMA(0, 0, At, B0); PG8_MMA(0, 1, At, B1); PG8_BAR; PG8_SCHED;
            PG8_LDA(At, 1, 1); PG8_STAGE(PG8_SB(1, 0), b3, voffB); PG8_STAGE(PG8_SB(1, 1), b3 + hstep, voffB); PG8_STAGE(PG8_SA(1, 0), a3, voffA);
            PG8_WAIT_V(8); PG8_WAIT_L(0); PG8_BAR; PG8_MMA(1, 0, At, B0); PG8_MMA(1, 1, At, B1); PG8_BAR; PG8_SCHED;
        }
        if (wr == 0) PG8_BAR;
        E(acc, cur, wr, wc, fr, fq);
        if (!has_next) break;
#pragma unroll
        for (int a = 0; a < 2; ++a)
#pragma unroll
            for (int b = 0; b < 2; ++b)
#pragma unroll
                for (int m = 0; m < 4; ++m)
#pragma unroll
                    for (int n = 0; n < 2; ++n) acc[a][b][m][n] = (f32x4){0.f, 0.f, 0.f, 0.f};
        cur = nxt; cA = nA; cB = nB; ++ui;
        if (wr == 1) PG8_BAR;
    }
    PG8_WAIT_V(0);
    PG8_BAR;
#undef PG8_SA
#undef PG8_SB
#undef PG8_STAGE
#undef PG8_LDA
#undef PG8_LDB
#undef PG8_MMA
#undef PG8_WAIT_V
#undef PG8_WAIT_L
#undef PG8_BAR
#undef PG8_SCHED
#undef PG8_UA
#undef PG8_UB
}

struct EpiRelu2 {
    static constexpr bool PERM = true;
    bf16_t* O; int ldc;
    __device__ __forceinline__ void operator()(const f32x4 (&acc)[2][2][4][2], const Unit& u, int wr, int wc, int fr, int fq) const {
        const int row0 = u.pm * BM + wr * 64 + fr, col0 = u.pn * BM + wc * 32 + 8 * fq;
#pragma unroll
        for (int ai = 0; ai < 2; ++ai)
#pragma unroll
            for (int m = 0; m < 4; ++m) { bf16_t* rowp = O + (size_t)(row0 + ai * HALF + m * 16) * ldc + col0;
#pragma unroll
                for (int bj = 0; bj < 2; ++bj) { f32x4 v0 = acc[ai][bj][m][0], v1 = acc[ai][bj][m][1];
#pragma unroll
                    for (int j = 0; j < 4; ++j) { const float a = fmaxf(v0[j], 0.f), b = fmaxf(v1[j], 0.f); v0[j] = a * a; v1[j] = b * b; }
                    u32x4 w; w.x = pk2(v0[0], v0[1]); w.y = pk2(v0[2], v0[3]); w.z = pk2(v1[0], v1[1]); w.w = pk2(v1[2], v1[3]);
                    *(u32x4*)(rowp + bj * HALF) = w; } }
    }
};
struct EpiResid {
    static constexpr bool PERM = false;
    const float* res0; const float* res1; float* X; float* P1; const float* gate;
    __device__ __forceinline__ void operator()(const f32x4 (&acc)[2][2][4][2], const Unit& u, int wr, int wc, int fr, int fq) const {
        const int vec = u.pm < 16 ? 0 : (u.pm < 24 ? 1 : 2);
        const float* gv_ = gate + vec * 6144; const float* rs = u.pm < 16 ? res0 : res1;
        const int col0 = u.pn * BM + wc * 32 + 4 * fq;
        f32x4 gv[2][2];
#pragma unroll
        for (int bj = 0; bj < 2; ++bj)
#pragma unroll
            for (int n = 0; n < 2; ++n) gv[bj][n] = *(const f32x4*)(gv_ + col0 + bj * HALF + n * 16);
#pragma unroll
        for (int ai = 0; ai < 2; ++ai)
#pragma unroll
            for (int m = 0; m < 4; ++m) { const size_t off = (size_t)(u.pm * BM + ai * HALF + wr * 64 + m * 16 + fr) * D + col0;
#pragma unroll
                for (int bj = 0; bj < 2; ++bj)
#pragma unroll
                    for (int n = 0; n < 2; ++n) { f32x4 o = gv[bj][n] * acc[ai][bj][m][n]; const size_t e = off + bj * HALF + n * 16;
                        if (u.ks == 0) { o += *(const f32x4*)(rs + e); *(f32x4*)(X + e) = o; } else { *(f32x4*)(P1 + e) = o; } } }
    }
};
struct EpiGlu {
    static constexpr bool PERM = false;
    float* X; const float* gate;
    __device__ __forceinline__ void operator()(const f32x4 (&acc)[2][2][4][2], const Unit& u, int wr, int wc, int fr, int fq) const {
        const int vec = u.pm < 16 ? 0 : (u.pm < 24 ? 1 : 2);
        const float* gv_ = gate + vec * 6144;
        const int col0 = u.pn * HALF + wc * 32 + 4 * fq;
        f32x4 gv[2];
#pragma unroll
        for (int n = 0; n < 2; ++n) gv[n] = *(const f32x4*)(gv_ + col0 + n * 16);
#pragma unroll
        for (int ai = 0; ai < 2; ++ai)
#pragma unroll
            for (int m = 0; m < 4; ++m) { const size_t off = (size_t)(u.pm * BM + ai * HALF + wr * 64 + m * 16 + fr) * D + col0;
#pragma unroll
                for (int n = 0; n < 2; ++n) { const f32x4 a = acc[ai][0][m][n], b = acc[ai][1][m][n]; f32x4 o;
#pragma unroll
                    for (int j = 0; j < 4; ++j) o[j] = a[j] / (1.f + __expf(-b[j]));
                    const size_t e = off + n * 16; *(f32x4*)(X + e) = *(const f32x4*)(X + e) + gv[n] * o; } }
    }
};
struct EpiQkv {
    static constexpr bool PERM = false;
    bf16_t* QB; bf16_t* KB; bf16_t* VT; float* outK; float* outV; const float* ropec; const float* ropes;
    __device__ __forceinline__ void operator()(const f32x4 (&acc)[2][2][4][2], const Unit& u, int wr, int wc, int fr, int fq) const {
        const bool lat = u.pm >= 16;
#pragma unroll
        for (int ai = 0; ai < 2; ++ai)
#pragma unroll
            for (int m = 0; m < 4; ++m) {
                const int row = u.pm * BM + ai * HALF + wr * 64 + m * 16 + fr;
                f32x4 cs = {1.f, 1.f, 1.f, 1.f}, sn = {0.f, 0.f, 0.f, 0.f};
                if (lat && u.pn < 5) { const int tp = row & 2047; cs = *(const f32x4*)(ropec + tp * 32 + (wc & 1) * 16 + 4 * fq); sn = *(const f32x4*)(ropes + tp * 32 + (wc & 1) * 16 + 4 * fq); }
#pragma unroll
                for (int bj = 0; bj < 2; ++bj) {
                    f32x4 x1 = acc[ai][bj][m][0], x2 = acc[ai][bj][m][1];
                    const int cl = bj * HALF + wc * 32 + 4 * fq;
                    if (u.pn < 5) {
                        const f32x4 y1 = x1 * cs - x2 * sn, y2 = x1 * sn + x2 * cs;
                        bf16_t* dst = (u.pn < 4) ? (QB + (size_t)row * D + u.pn * BM + cl) : (KB + (size_t)row * 256 + cl);
                        u32x2 w1, w2; w1.x = pk2(y1[0], y1[1]); w1.y = pk2(y1[2], y1[3]); w2.x = pk2(y2[0], y2[1]); w2.y = pk2(y2[2], y2[3]);
                        *(u32x2*)dst = w1; *(u32x2*)(dst + 16) = w2;
                        if (u.pn == 4 && !lat) { *(f32x4*)(outK + (size_t)row * 256 + cl) = x1; *(f32x4*)(outK + (size_t)row * 256 + cl + 16) = x2; }
                    } else {
#pragma unroll
                        for (int j = 0; j < 4; ++j) { VT[(size_t)(cl + j) * KROWS + row] = (bf16_t)(pk2(x1[j], 0.f) & 0xffffu); VT[(size_t)(cl + 16 + j) * KROWS + row] = (bf16_t)(pk2(x2[j], 0.f) & 0xffffu); }
                        if (!lat) { *(f32x4*)(outV + (size_t)row * 256 + cl) = x1; *(f32x4*)(outV + (size_t)row * 256 + cl + 16) = x2; }
                    }
                }
            }
    }
};
}

DI void transpose_item(const float* W, int K, int N, bf16_t* WT, int k0, int n0, int drow0, LAS float* scr, int lane) {
#pragma unroll 8
    for (int i = 0; i < 32; ++i) { const int kk = 2 * i + (lane >> 5); scr[kk * 33 + (lane & 31)] = W[(size_t)(k0 + kk) * N + n0 + (lane & 31)]; }
    asm volatile("" ::: "memory");
    const int c = lane & 7;
#pragma unroll
    for (int j = 0; j < 4; ++j) { const int n = (lane >> 3) + 8 * j; const LAS float* s = scr + (8 * c) * 33 + n;
        u32x4 o; o.x = pk2(s[0 * 33], s[1 * 33]); o.y = pk2(s[2 * 33], s[3 * 33]); o.z = pk2(s[4 * 33], s[5 * 33]); o.w = pk2(s[6 * 33], s[7 * 33]);
        *(u32x4*)(WT + (size_t)(drow0 + n) * K + k0 + 8 * c) = o; }
    asm volatile("" ::: "memory");
}
DI void transpose_mat(const float* W, int K, int N, bf16_t* WT, int item, LAS float* scr, int lane, int glu  ) {
    const int nblk = N / 32, kb = item / nblk, nb = item % nblk, n0 = 32 * nb;
    int drow0 = n0;
    if (glu) drow0 = 256 * (n0 >> 7) + (n0 & 127) + (glu == 2 ? 128 : 0);
    transpose_item(W, K, N, WT, 64 * kb, n0, drow0, scr, lane);
}

DI void prep_phase(const Params& P, LAS unsigned char* lds) {
    const int tid = threadIdx.x, wid = tid >> 6, lane = tid & 63, G = gridDim.x, bid = blockIdx.x;
    unsigned char* ws = P.ws;
    if (bid < 192) {
        LAS float* sl = (LAS float*)lds;
        LAS float* red = (LAS float*)(lds + 12288);
        for (int e = tid; e < 3072; e += 512) { const int v = e >> 10, k = e & 1023; const float x = (v == 0) ? P.in[6][k] : P.in[5][(v - 1) * 1024 + k]; sl[e] = x / (1.f + __expf(-x)); }
        __syncthreads();
        const int l = bid / 96, n0 = (bid % 96) * 64, cq = lane & 15, kr = lane >> 4;
        const float* wm = P.in[9] + (size_t)l * 1024 * 6144 + n0 + 4 * cq;
        f32x4 a0 = {0.f, 0.f, 0.f, 0.f}, a1 = a0, a2 = a0;
#pragma unroll 8
        for (int i = 0; i < 32; ++i) { const int k = 128 * wid + 4 * i + kr; const f32x4 w = *(const f32x4*)(wm + (size_t)k * 6144);
            a0 += w * sl[k]; a1 += w * sl[1024 + k]; a2 += w * sl[2048 + k]; }
#pragma unroll
        for (int j = 0; j < 4; ++j) { a0[j] += __shfl_xor(a0[j], 16); a0[j] += __shfl_xor(a0[j], 32); a1[j] += __shfl_xor(a1[j], 16); a1[j] += __shfl_xor(a1[j], 32); a2[j] += __shfl_xor(a2[j], 16); a2[j] += __shfl_xor(a2[j], 32); }
        if (kr == 0) { *(LAS f32x4*)(red + (wid * 3 + 0) * 64 + 4 * cq) = a0; *(LAS f32x4*)(red + (wid * 3 + 1) * 64 + 4 * cq) = a1; *(LAS f32x4*)(red + (wid * 3 + 2) * 64 + 4 * cq) = a2; }
        __syncthreads();
        if (tid < 192) { const int v = tid >> 6, cc = tid & 63; float s = P.in[10][l * 6144 + n0 + cc];
#pragma unroll
            for (int w = 0; w < 8; ++w) s += red[(w * 3 + v) * 64 + cc];
            ((float*)(ws + WS_MOD))[(l * 3 + v) * 6144 + n0 + cc] = s; }
    }
    {
        LAS float* scr = (LAS float*)(lds + 32768 + wid * 8704);
        const int gw = bid * 8 + wid, NGW = G * 8;
        constexpr int I_QKV = 16 * 48, I_O = 16 * 32, I_G = 16 * 32, I_1 = 16 * 128, I_2 = 64 * 32;
        constexpr int NIT = I_QKV + I_O + 2 * I_G + 2 * I_1 + 2 * I_2;
        for (int it = gw; it < NIT; it += NGW) {
            int r = it;
            if (r < I_QKV) { transpose_mat(P.in[11], 1024, 1536, (bf16_t*)(ws + WS_WQKV), r, scr, lane, 0); continue; } r -= I_QKV;
            if (r < I_O) { transpose_mat(P.in[12], 1024, 1024, (bf16_t*)(ws + WS_WO), r, scr, lane, 0); continue; } r -= I_O;
            if (r < I_G) { transpose_mat(P.in[22], 1024, 1024, (bf16_t*)(ws + WS_WGLU), r, scr, lane, 1); continue; } r -= I_G;
            if (r < I_G) { transpose_mat(P.in[23], 1024, 1024, (bf16_t*)(ws + WS_WGLU), r, scr, lane, 2); continue; } r -= I_G;
            if (r < 2 * I_1) { const int l = r / I_1; transpose_mat(P.in[24] + (size_t)l * D * FF, 1024, 4096, (bf16_t*)(ws + WS_W1) + (size_t)l * D * FF, r % I_1, scr, lane, 0); continue; } r -= 2 * I_1;
            { const int l = r / I_2; transpose_mat(P.in[25] + (size_t)l * D * FF, 4096, 1024, (bf16_t*)(ws + WS_W2) + (size_t)l * D * FF, r % I_2, scr, lane, 0); }
        }
    }
    const int gt = bid * 512 + tid, NGT = G * 512;
    for (int e = gt; e < 2 * 256 * 256; e += NGT) {
        const int tok = e >> 8, c = e & 255;
        ((bf16_t*)(ws + WS_KB))[(size_t)(T + tok) * 256 + c] = (bf16_t)(pk2(P.in[2][e], 0.f) & 0xffffu);
    }
    for (int e = gt; e < 2 * 256 * 256; e += NGT) {
        const int c = e >> 9, tok = e & 511;
        ((bf16_t*)(ws + WS_VT))[(size_t)c * KROWS + T + tok] = (bf16_t)(pk2(P.in[3][tok * 256 + c], 0.f) & 0xffffu);
    }
    for (int e = gt; e < 2048 * 32; e += NGT) {
        const int tp = e >> 5, k = e & 31, f = k & 15; const float pos = (k >> 4) ? (float)(tp & 63) : (float)(tp >> 6);
        const float freq = powf(10000.f, -(float)f / 16.f); const float ang = pos * freq;
        ((float*)(ws + WS_ROPE))[e] = cosf(ang); ((float*)(ws + WS_ROPE))[2048 * 32 + e] = sinf(ang);
    }
    for (int e = gt; e < 2 * 64 * 64; e += NGT) {
        const int dg = e >> 6, p = e & 63;
        const float dt = expf(P.in[16][dg]), lre = P.in[14][e], lim = P.in[15][e];
        const float mag = expf(lre * dt), ang = lim * dt; const float are = mag * cosf(ang), aim = mag * sinf(ang);
        const float den = lre * lre + lim * lim, nre = are - 1.f, nim = aim;
        const float fre = (nre * lre + nim * lim) / den, fim = (nim * lre - nre * lim) / den;
        ((float*)(ws + WS_ABAR))[e * 2] = are; ((float*)(ws + WS_ABAR))[e * 2 + 1] = aim;
        bf16_t* bbm = (bf16_t*)(ws + WS_BBM) + (size_t)dg * 128 * 16; bf16_t* ccm = (bf16_t*)(ws + WS_CCM) + (size_t)dg * 16 * 128;
        for (int c = 0; c < 16; ++c) {
            const float br = P.in[17][(size_t)e * 16 + c], bi = P.in[18][(size_t)e * 16 + c];
            bbm[p * 16 + c] = (bf16_t)(pk2(fre * br - fim * bi, 0.f) & 0xffffu);
            bbm[(64 + p) * 16 + c] = (bf16_t)(pk2(fre * bi + fim * br, 0.f) & 0xffffu);
            const float cr = P.in[19][((size_t)dg * 16 + c) * 64 + p], ci = P.in[20][((size_t)dg * 16 + c) * 64 + p];
            const int k = 4 * (p & 31) + 2 * (p >> 5);
            ccm[c * 128 + k] = (bf16_t)(pk2(cr, 0.f) & 0xffffu); ccm[c * 128 + k + 1] = (bf16_t)(pk2(-ci, 0.f) & 0xffffu);
        }
    }
}

template <int MODE>
DI void norm_phase(const Params& P, const float* gain, const float* modl, int sh_off, int sc_off) {
    const int tid = threadIdx.x, wid = tid >> 6, lane = tid & 63;
    float* X = (float*)(P.ws + WS_X); const float* P1 = (const float*)(P.ws + WS_P1); bf16_t* HB = (bf16_t*)(P.ws + WS_HB);
    for (int row = blockIdx.x * 8 + wid; row < T; row += gridDim.x * 8) {
        const float* src = (MODE == 0) ? (row < TCTX ? P.in[0] + (size_t)row * D : P.in[1] + (size_t)(row - TCTX) * D) : X + (size_t)row * D;
        f32x4 v[4]; float ss = 0.f;
#pragma unroll
        for (int j = 0; j < 4; ++j) { v[j] = *(const f32x4*)(src + 4 * lane + 256 * j);
            if (MODE >= 2) { v[j] += *(const f32x4*)(P1 + (size_t)row * D + 4 * lane + 256 * j); if (MODE == 2) *(f32x4*)(X + (size_t)row * D + 4 * lane + 256 * j) = v[j]; }
            ss += (v[j][0] * v[j][0] + v[j][1] * v[j][1]) + (v[j][2] * v[j][2] + v[j][3] * v[j][3]); }
        const float rinv = rsqrtf(wave_sum(ss) * (1.f / D) + 1e-6f);
        if (MODE == 3) {
#pragma unroll
            for (int j = 0; j < 4; ++j) { const f32x4 g = *(const f32x4*)(gain + 4 * lane + 256 * j); *(f32x4*)(P.out + (size_t)row * D + 4 * lane + 256 * j) = v[j] * rinv * g; }
        } else {
            const int vec = row < TCTX ? 0 : (row < TCTX + LLAT ? 1 : 2); const float* mv = modl + vec * 6144;
#pragma unroll
            for (int j = 0; j < 4; ++j) { const int c = 4 * lane + 256 * j; const f32x4 g = *(const f32x4*)(gain + c), sc = *(const f32x4*)(mv + sc_off + c), sh = *(const f32x4*)(mv + sh_off + c);
                const f32x4 h = (v[j] * rinv * g) * (sc + 1.f) + sh; u32x2 w; w.x = pk2(h[0], h[1]); w.y = pk2(h[2], h[3]); *(u32x2*)(HB + (size_t)row * D + c) = w; }
        }
    }
}

DI void attn_phase(const Params& P, LAS unsigned char* lds) {
    const int tid = threadIdx.x, wid = tid >> 6, lane = tid & 63, r = lane & 15, g4 = lane >> 4;
    const bf16_t* QB = (const bf16_t*)(P.ws + WS_QB); const bf16_t* KB = (const bf16_t*)(P.ws + WS_KB); const bf16_t* VT = (const bf16_t*)(P.ws + WS_VT); bf16_t* OB = (bf16_t*)(P.ws + WS_OB);
    const float LOG2E = 1.44269504089f, SC = 0.125f * 1.44269504089f;
    const int lrow = tid >> 3, lch = tid & 7;
    for (int u = blockIdx.x; u < 1024; u += gridDim.x) {
        int h, tok0, win0, nwin, ctx0, ipos0; bool lat;
        if (u < 512) { const int b = u >> 5; h = (u >> 1) & 15; const int n = u & 1; tok0 = 256 * b + 128 * n; win0 = 0; nwin = 0; ctx0 = 256 * b; lat = false; ipos0 = 0; }
        else { const int v = u - 512, b = v >> 8; h = (v >> 4) & 15; const int n = v & 15; const int tb = TCTX + LLAT * b; tok0 = tb + 128 * n;
            const int j0 = (128 * n - 128) < 0 ? 0 : (128 * n - 128), j1 = (128 * n + 256) > LLAT ? LLAT : (128 * n + 256);
            win0 = tb + j0; nwin = (j1 - j0) >> 6; ctx0 = T + 256 * b; lat = true; ipos0 = 128 * n - j0; }
        const int kvh = h >> 2, ntile = nwin + 4;
        const bf16_t* qp = QB + (size_t)(tok0 + 16 * wid + r) * D + h * 64 + 8 * g4;
        const bf16x8 qb0 = *(const bf16x8*)qp, qb1 = *(const bf16x8*)(qp + 32);
        float m_run = P.in[13][h] * LOG2E, l_run = (g4 == 0) ? 1.f : 0.f;
        f32x4 o[4];
#pragma unroll
        for (int dt = 0; dt < 4; ++dt) o[dt] = (f32x4){0.f, 0.f, 0.f, 0.f};
        const int iq = ipos0 + 16 * wid + r;
        u32x4 kreg, vreg;
        { const int tk = (0 < nwin) ? win0 : ctx0;
          kreg = *(const u32x4*)(KB + (size_t)(tk + lrow) * 256 + kvh * 64 + lch * 8); vreg = *(const u32x4*)(VT + (size_t)(kvh * 64 + lrow) * KROWS + tk + lch * 8); }
        *(LAS u32x4*)(lds + lrow * 144 + lch * 16) = kreg; *(LAS u32x4*)(lds + 9216 + lrow * 144 + lch * 16) = vreg;
        __syncthreads();
        for (int t = 0; t < ntile; ++t) {
            LAS unsigned char* Kb = lds + (t & 1) * 18432; LAS unsigned char* Vb = Kb + 9216;
            if (t + 1 < ntile) { const int tk = (t + 1 < nwin) ? win0 + 64 * (t + 1) : ctx0 + 64 * (t + 1 - nwin);
                kreg = *(const u32x4*)(KB + (size_t)(tk + lrow) * 256 + kvh * 64 + lch * 8); vreg = *(const u32x4*)(VT + (size_t)(kvh * 64 + lrow) * KROWS + tk + lch * 8); }
            f32x4 s[4];
#pragma unroll
            for (int kt = 0; kt < 4; ++kt) {
                const bf16x8 a0 = *(const LAS bf16x8*)(Kb + (16 * kt + r) * 144 + g4 * 16), a1 = *(const LAS bf16x8*)(Kb + (16 * kt + r) * 144 + 64 + g4 * 16);
                f32x4 z = {0.f, 0.f, 0.f, 0.f};
                z = __builtin_amdgcn_mfma_f32_16x16x32_bf16(a0, qb0, z, 0, 0, 0);
                s[kt] = __builtin_amdgcn_mfma_f32_16x16x32_bf16(a1, qb1, z, 0, 0, 0);
            }
            const bool masked = lat && (t < nwin);
            float mx = -3.0e38f;
#pragma unroll
            for (int kt = 0; kt < 4; ++kt)
#pragma unroll
                for (int i = 0; i < 4; ++i) { float x = s[kt][i] * SC;
                    if (masked) { const int dj = 64 * t + 16 * kt + 4 * g4 + i - iq; if (dj > 128 || dj < -128) x = -1.0e30f; }
                    s[kt][i] = x; mx = fmaxf(mx, x); }
            mx = fmaxf(mx, __shfl_xor(mx, 16)); mx = fmaxf(mx, __shfl_xor(mx, 32));
            const float mnew = fmaxf(m_run, mx), alpha = exp2f(m_run - mnew); m_run = mnew;
            float ls = 0.f;
#pragma unroll
            for (int kt = 0; kt < 4; ++kt)
#pragma unroll
                for (int i = 0; i < 4; ++i) { const float p = exp2f(s[kt][i] - mnew); s[kt][i] = p; ls += p; }
            l_run = l_run * alpha + ls;
#pragma unroll
            for (int dt = 0; dt < 4; ++dt) o[dt] *= alpha;
            u32x4 pw01, pw23;
            pw01.x = pk2(s[0][0], s[0][1]); pw01.y = pk2(s[0][2], s[0][3]); pw01.z = pk2(s[1][0], s[1][1]); pw01.w = pk2(s[1][2], s[1][3]);
            pw23.x = pk2(s[2][0], s[2][1]); pw23.y = pk2(s[2][2], s[2][3]); pw23.z = pk2(s[3][0], s[3][1]); pw23.w = pk2(s[3][2], s[3][3]);
            const bf16x8 pb01 = __builtin_bit_cast(bf16x8, pw01), pb23 = __builtin_bit_cast(bf16x8, pw23);
#pragma unroll
            for (int dt = 0; dt < 4; ++dt) {
                const LAS unsigned char* vr = Vb + (16 * dt + r) * 144 + g4 * 8;
                u32x4 va; const u32x2 l0 = *(const LAS u32x2*)(vr), h0 = *(const LAS u32x2*)(vr + 32), l1 = *(const LAS u32x2*)(vr + 64), h1 = *(const LAS u32x2*)(vr + 96);
                va.x = l0.x; va.y = l0.y; va.z = h0.x; va.w = h0.y;
                o[dt] = __builtin_amdgcn_mfma_f32_16x16x32_bf16(__builtin_bit_cast(bf16x8, va), pb01, o[dt], 0, 0, 0);
                va.x = l1.x; va.y = l1.y; va.z = h1.x; va.w = h1.y;
                o[dt] = __builtin_amdgcn_mfma_f32_16x16x32_bf16(__builtin_bit_cast(bf16x8, va), pb23, o[dt], 0, 0, 0);
            }
            if (t + 1 < ntile) { LAS unsigned char* Kn = lds + ((t + 1) & 1) * 18432; *(LAS u32x4*)(Kn + lrow * 144 + lch * 16) = kreg; *(LAS u32x4*)(Kn + 9216 + lrow * 144 + lch * 16) = vreg; }
            __syncthreads();
        }
        float l = l_run; l += __shfl_xor(l, 16); l += __shfl_xor(l, 32);
        const float inv = 1.f / l;
        bf16_t* op = OB + (size_t)(tok0 + 16 * wid + r) * D + h * 64 + 4 * g4;
#pragma unroll
        for (int dt = 0; dt < 4; ++dt) { u32x2 w; w.x = pk2(o[dt][0] * inv, o[dt][1] * inv); w.y = pk2(o[dt][2] * inv, o[dt][3] * inv); *(u32x2*)(op + 16 * dt) = w; }
    }
}

DI void ssm_phase(const Params& P, LAS unsigned char* lds) {
    const int tid = threadIdx.x, wid = tid >> 6, lane = tid & 63, p = lane & 31, h = lane >> 5;
    const int gw = wid * gridDim.x + blockIdx.x;
    int g, dir, tokX, tokY, nsteps; bool lat;
    if (gw < 128) { g = gw >> 1; dir = gw & 1; tokX = TCTX; tokY = TCTX + LLAT; nsteps = LLAT; lat = true; }
    else if (gw < 1152) { const int id = gw - 128; const int pr = id >> 7; g = (id >> 1) & 63; dir = id & 1; tokX = 512 * pr; tokY = 512 * pr + 256; nsteps = 256; lat = false; }
    else return;
    LAS unsigned char* S = lds + wid * 8704;
    const bf16_t* HB = (const bf16_t*)(P.ws + WS_HB);
    float* YP = (float*)(P.ws + WS_YP) + (size_t)dir * T * D;
    const int dg = dir * 64 + g;
    const float* ab = (const float*)(P.ws + WS_ABAR) + (size_t)dg * 128;
    const float ar0 = ab[2 * p], ai0 = ab[2 * p + 1], ar1 = ab[2 * (p + 32)], ai1 = ab[2 * (p + 32) + 1];
    bf16x8 bbq[4], ccb[4];
#pragma unroll
    for (int q = 0; q < 4; ++q) bbq[q] = *(const bf16x8*)((const bf16_t*)(P.ws + WS_BBM) + ((size_t)dg * 128 + q * 32 + p) * 16 + 8 * h);
#pragma unroll
    for (int ks = 0; ks < 4; ++ks) ccb[ks] = *(const bf16x8*)((const bf16_t*)(P.ws + WS_CCM) + ((size_t)dg * 16 + (lane & 15)) * 128 + 32 * ks + 8 * (lane >> 4));
    float sr0 = 0.f, si0 = 0.f, sr1 = 0.f, si1 = 0.f;
    if (lat) { const float* s0 = P.in[4] + ((size_t)(h * 2 + dir) * 2) * 4096 + g * 64;
        sr0 = s0[p]; sr1 = s0[p + 32]; si0 = s0[4096 + p]; si1 = s0[4096 + p + 32]; }
    const int hh = (p >> 2) & 1, ii = 4 * (p >> 3) + (p & 3);
    const bf16_t* ubase = HB + (size_t)((hh ? tokY : tokX) + ii) * D + 16 * g + 8 * h;
    const int ntile = nsteps >> 4;
    const int c16 = lane & 15, g4 = lane >> 4;
    bf16x8 a_nxt = *(const bf16x8*)(ubase + (size_t)(dir ? nsteps - 16 : 0) * D);
    for (int tt = 0; tt < ntile; ++tt) {
        const int t0 = dir ? nsteps - 16 - 16 * tt : 16 * tt;
        const bf16x8 a = a_nxt;
        if (tt + 1 < ntile) a_nxt = *(const bf16x8*)(ubase + (size_t)(dir ? t0 - 16 : t0 + 16) * D);
        f32x16 acc[4];
#pragma unroll
        for (int q = 0; q < 4; ++q) { f32x16 z;
#pragma unroll
            for (int i = 0; i < 16; ++i) z[i] = 0.f;
            acc[q] = __builtin_amdgcn_mfma_f32_32x32x16_bf16(a, bbq[q], z, 0, 0, 0); }
#define SSM_STEP(i) { const float nr0 = ar0 * sr0 - ai0 * si0 + acc[0][i], ni0 = ar0 * si0 + ai0 * sr0 + acc[2][i]; \
                      const float nr1 = ar1 * sr1 - ai1 * si1 + acc[1][i], ni1 = ar1 * si1 + ai1 * sr1 + acc[3][i]; \
                      sr0 = nr0; si0 = ni0; sr1 = nr1; si1 = ni1; u32x2 w; w.x = pk2(nr0, ni0); w.y = pk2(nr1, ni1); *(LAS u32x2*)(S + (16 * h + (i)) * 272 + p * 8) = w; }
        if (dir == 0) {
#pragma unroll
            for (int i = 0; i < 16; ++i) SSM_STEP(i)
        } else {
#pragma unroll
            for (int i = 15; i >= 0; --i) SSM_STEP(i)
        }
#undef SSM_STEP
        asm volatile("" ::: "memory");
#pragma unroll
        for (int mt = 0; mt < 2; ++mt) {
            f32x4 y = {0.f, 0.f, 0.f, 0.f};
#pragma unroll
            for (int ks = 0; ks < 4; ++ks) { const bf16x8 sa = *(const LAS bf16x8*)(S + (16 * mt + c16) * 272 + 64 * ks + 16 * g4);
                y = __builtin_amdgcn_mfma_f32_16x16x32_bf16(sa, ccb[ks], y, 0, 0, 0); }
            float* yp = YP + (size_t)((mt ? tokY : tokX) + t0 + 4 * g4) * D + 16 * g + c16;
#pragma unroll
            for (int i = 0; i < 4; ++i) yp[(size_t)i * D] = y[i];
        }
        asm volatile("" ::: "memory");
    }
    if (!lat) { float* so = P.out + OUT_S + ((size_t)((tokX >> 8) + h) * 2 + dir) * 2 * 4096 + g * 64;
        so[p] = sr0; so[p + 32] = sr1; so[4096 + p] = si0; so[4096 + p + 32] = si1; }
}

DI void combine_phase(const Params& P) {
    const bf16_t* HB = (const bf16_t*)(P.ws + WS_HB); const float* Y0 = (const float*)(P.ws + WS_YP); const float* Y1 = Y0 + (size_t)T * D; bf16_t* YB = (bf16_t*)(P.ws + WS_QB);
    const float* dsk = P.in[21];
    for (size_t e = ((size_t)blockIdx.x * 512 + threadIdx.x) * 8; e < (size_t)T * D; e += (size_t)gridDim.x * 512 * 8) {
        const int c = (int)(e & 1023);
        const u32x4 ub = *(const u32x4*)(HB + e);
        const f32x4 a0 = *(const f32x4*)(Y0 + e), a1 = *(const f32x4*)(Y0 + e + 4), b0 = *(const f32x4*)(Y1 + e), b1 = *(const f32x4*)(Y1 + e + 4), d0 = *(const f32x4*)(dsk + c), d1 = *(const f32x4*)(dsk + c + 4);
        f32x4 u0, u1;
        u0[0] = __builtin_bit_cast(float, ub.x << 16); u0[1] = __builtin_bit_cast(float, ub.x & 0xffff0000u); u0[2] = __builtin_bit_cast(float, ub.y << 16); u0[3] = __builtin_bit_cast(float, ub.y & 0xffff0000u);
        u1[0] = __builtin_bit_cast(float, ub.z << 16); u1[1] = __builtin_bit_cast(float, ub.z & 0xffff0000u); u1[2] = __builtin_bit_cast(float, ub.w << 16); u1[3] = __builtin_bit_cast(float, ub.w & 0xffff0000u);
        const f32x4 v0 = d0 * u0 + a0 + b0, v1 = d1 * u1 + a1 + b1;
        float v[8] = {v0[0], v0[1], v0[2], v0[3], v1[0], v1[1], v1[2], v1[3]};
#pragma unroll
        for (int j = 0; j < 8; ++j) { const float x = v[j]; const float z = 1.5957691216f * (x + 0.044715f * x * x * x); v[j] = x / (1.f + __expf(-z)); }
        u32x4 w; w.x = pk2(v[0], v[1]); w.y = pk2(v[2], v[3]); w.z = pk2(v[4], v[5]); w.w = pk2(v[6], v[7]);
        *(u32x4*)(YB + e) = w;
    }
}

constexpr int NPHASE = 16;
constexpr int LDS_BYTES = 147456;
__global__ void __launch_bounds__(512, 2) fwd_kernel(Params P) {
    extern __shared__ __attribute__((aligned(16))) unsigned char lds_raw[];
    LAS unsigned char* lds = (LAS unsigned char*)lds_raw;
    cg::grid_group grid = cg::this_grid();
    unsigned char* ws = P.ws;
    const float* MOD = (const float*)(ws + WS_MOD);
    const int lo = P.ph_lo, hi = P.ph_hi, G = gridDim.x;
#define IN(k) (lo <= (k) && (k) < hi)
#define SYNC(k) do { if (IN(k) && IN((k) + 1)) grid.sync(); } while (0)
    if (IN(0)) prep_phase(P, lds);
    SYNC(0);
    if (IN(1)) norm_phase<0>(P, P.in[7], MOD, 0, 1024);
    SYNC(1);
    if (IN(2)) { pg8::Gemm g{(const bf16_t*)(ws + WS_HB), (const bf16_t*)(ws + WS_WQKV), D, D}; pg8::StaticOrder S; S.init(T, NQKV, 1, G, blockIdx.x);
        pg8::EpiQkv E{(bf16_t*)(ws + WS_QB), (bf16_t*)(ws + WS_KB), (bf16_t*)(ws + WS_VT), P.out + OUT_K, P.out + OUT_V, (const float*)(ws + WS_ROPE), (const float*)(ws + WS_ROPE) + 2048 * 32};
        pg8::gemm_phase(lds, g, S, E); }
    SYNC(2);
    if (IN(3)) attn_phase(P, lds);
    SYNC(3);
    if (IN(4)) { pg8::Gemm g{(const bf16_t*)(ws + WS_OB), (const bf16_t*)(ws + WS_WO), D, D / 2}; pg8::StaticOrder S; S.init(T, D, 2, G, blockIdx.x);
        pg8::EpiResid E{P.in[0], P.in[1] - (size_t)TCTX * D, (float*)(ws + WS_X), (float*)(ws + WS_P1), MOD + 2048};
        pg8::gemm_phase(lds, g, S, E); }
    SYNC(4);
    if (IN(5)) norm_phase<2>(P, P.in[8], MOD, 3072, 4096);
    SYNC(5);
    if (IN(6)) { pg8::Gemm g{(const bf16_t*)(ws + WS_HB), (const bf16_t*)(ws + WS_W1), D, D}; pg8::StaticOrder S; S.init(T, FF, 1, G, blockIdx.x);
        pg8::EpiRelu2 E{(bf16_t*)(ws + WS_AB), FF}; pg8::gemm_phase(lds, g, S, E); }
    SYNC(6);
    if (IN(7)) { pg8::Gemm g{(const bf16_t*)(ws + WS_AB), (const bf16_t*)(ws + WS_W2), FF, FF / 2}; pg8::StaticOrder S; S.init(T, D, 2, G, blockIdx.x);
        pg8::EpiResid E{(const float*)(ws + WS_X), (const float*)(ws + WS_X), (float*)(ws + WS_X), (float*)(ws + WS_P1), MOD + 5120};
        pg8::gemm_phase(lds, g, S, E); }
    SYNC(7);
    if (IN(8)) norm_phase<2>(P, P.in[7] + D, MOD + 3 * 6144, 0, 1024);
    SYNC(8);
    if (IN(9)) ssm_phase(P, lds);
    SYNC(9);
    if (IN(10)) combine_phase(P);
    SYNC(10);
    if (IN(11)) { pg8::Gemm g{(const bf16_t*)(ws + WS_QB), (const bf16_t*)(ws + WS_WGLU), D, D}; pg8::StaticOrder S; S.init(T, 2 * D, 1, G, blockIdx.x);
        pg8::EpiGlu E{(float*)(ws + WS_X), MOD + 3 * 6144 + 2048}; pg8::gemm_phase(lds, g, S, E); }
    SYNC(11);
    if (IN(12)) norm_phase<1>(P, P.in[8] + D, MOD + 3 * 6144, 3072, 4096);
    SYNC(12);
    if (IN(13)) { pg8::Gemm g{(const bf16_t*)(ws + WS_HB), (const bf16_t*)(ws + WS_W1) + (size_t)D * FF, D, D}; pg8::StaticOrder S; S.init(T, FF, 1, G, blockIdx.x);
        pg8::EpiRelu2 E{(bf16_t*)(ws + WS_AB), FF}; pg8::gemm_phase(lds, g, S, E); }
    SYNC(13);
    if (IN(14)) { pg8::Gemm g{(const bf16_t*)(ws + WS_AB), (const bf16_t*)(ws + WS_W2) + (size_t)D * FF, FF, FF / 2}; pg8::StaticOrder S; S.init(T, D, 2, G, blockIdx.x);
        pg8::EpiResid E{(const float*)(ws + WS_X), (const float*)(ws + WS_X), (float*)(ws + WS_X), (float*)(ws + WS_P1), MOD + 3 * 6144 + 5120};
        pg8::gemm_phase(lds, g, S, E); }
    SYNC(14);
    if (IN(15)) norm_phase<3>(P, P.in[26], MOD, 0, 0);
#undef IN
#undef SYNC
}

#ifndef MK_MULTI
#define MK_MULTI 0
#endif
extern "C" void kernel_launch(void* const* d_in, const int* in_sizes, int n_in, void* d_out, int out_size, void* d_ws, size_t ws_size, hipStream_t stream) {
    static int grid = 0;
    if (grid == 0) {
        int dev = 0, cus = 0, per_cu = 0;
        hipGetDevice(&dev);
        hipDeviceGetAttribute(&cus, hipDeviceAttributeMultiprocessorCount, dev);
        hipFuncSetAttribute((const void*)fwd_kernel, hipFuncAttributeMaxDynamicSharedMemorySize, LDS_BYTES);
        hipOccupancyMaxActiveBlocksPerMultiprocessor(&per_cu, (const void*)fwd_kernel, 512, LDS_BYTES);
        if (per_cu < 1) { fprintf(stderr, "occupancy query gave %d\n", per_cu); per_cu = 1; }
        if (per_cu > 1) per_cu = 1;
        grid = cus * per_cu;
        if (grid > 256) grid = 256;
    }
    Params p{};
    for (int i = 0; i < 27; ++i) p.in[i] = (const float*)d_in[i];
    p.out = (float*)d_out; p.ws = (unsigned char*)d_ws;
#if MK_MULTI
    for (int k = 0; k < NPHASE; ++k) { p.ph_lo = k; p.ph_hi = k + 1; hipLaunchKernelGGL(fwd_kernel, dim3(grid), dim3(512), LDS_BYTES, stream, p); }
#else
    p.ph_lo = 0; p.ph_hi = NPHASE;
    void* args[] = {&p};
    hipError_t e = hipLaunchCooperativeKernel((const void*)fwd_kernel, dim3(grid), dim3(512), args, LDS_BYTES, stream);
    if (e != hipSuccess) fprintf(stderr, "cooperative launch failed: %s (grid %d)\n", hipGetErrorString(e), grid);
#endif
}
```

```cpp
#include <hip/hip_runtime.h>
#include <hip/hip_cooperative_groups.h>
#include <cstdio>
#include <cstdint>
namespace cg = cooperative_groups;

#define LAS __attribute__((address_space(3)))
typedef unsigned short bf16_t;
typedef short bf16x8 __attribute__((ext_vector_type(8)));
typedef float f32x4 __attribute__((ext_vector_type(4)));
typedef float f32x16 __attribute__((ext_vector_type(16)));
typedef float f32x2 __attribute__((ext_vector_type(2)));
typedef unsigned u32x4 __attribute__((ext_vector_type(4)));
typedef unsigned u32x2 __attribute__((ext_vector_type(2)));
typedef __bf16 bf16x2v __attribute__((ext_vector_type(2)));
#define DI __device__ __forceinline__

DI unsigned pk2(float a, float b) { f32x2 v = {a, b}; bf16x2v r = __builtin_convertvector(v, bf16x2v); return __builtin_bit_cast(unsigned, r); }
DI float bf2f(unsigned short u) { return __builtin_bit_cast(float, (unsigned)u << 16); }
DI float wave_sum(float v) {
#pragma unroll
    for (int o = 1; o < 64; o <<= 1) v += __shfl_xor(v, o);
    return v;
}

constexpr int T = 8192, D = 1024, FF = 4096, NQKV = 1536, TCTX = 4096, LLAT = 2048;
constexpr int KROWS = 8704;
constexpr size_t MiB = 1u << 20;
constexpr size_t WS_MOD = 1 * MiB;
constexpr size_t WS_ABAR = 2 * MiB;
constexpr size_t WS_BBM = 2 * MiB + 128 * 1024;
constexpr size_t WS_CCM = 2 * MiB + 640 * 1024;
constexpr size_t WS_ROPE = 3 * MiB + 256 * 1024;
constexpr size_t WS_WQKV = 4 * MiB, WS_WO = 7 * MiB, WS_WGLU = 9 * MiB, WS_W1 = 13 * MiB, WS_W2 = 29 * MiB;
constexpr size_t WS_KB = 45 * MiB, WS_VT = 50 * MiB;
constexpr size_t WS_HB = 56 * MiB, WS_QB = 72 * MiB, WS_OB = 88 * MiB, WS_X = 104 * MiB, WS_P1 = 136 * MiB, WS_AB = 168 * MiB;
constexpr size_t WS_YP = 168 * MiB;
constexpr int OUT_K = 8388608, OUT_V = 8388608 + 1048576, OUT_S = 8388608 + 2 * 1048576;

struct Params { const float* in[27]; float* out; unsigned char* ws; int ph_lo, ph_hi; };

namespace pg8 {
constexpr int BM = 256, BK = 64, HALF = 128, HTB = HALF * BK * 2, STAGE_BYTES = 8 * HTB, NXCD = 8, WGM = 8;
__host__ __device__ __forceinline__ int lds_byte(int r, int c) { const int st = (r >> 4) * 2 + (c >> 5), rr = r & 15, cc = c & 31, ob = rr * 64 + cc * 2; return st * 1024 + (ob ^ (((ob >> 9) & 1) << 5)); }
__host__ __device__ __forceinline__ void stage_rc(int b, int& R, int& C) { const int st = b / 1024, sb = b % 1024, swz = sb ^ (((sb >> 9) & 1) << 5); R = (st >> 1) * 16 + swz / 64; C = (st & 1) * 32 + (swz % 64) / 2; }
__host__ __device__ __forceinline__ int perm32(int rho) { const int n = rho >> 4, i = rho & 15; return 8 * (i >> 2) + 4 * n + (i & 3); }

struct Unit { int pm, pn, ks; };
struct Gemm { const bf16_t* A; const bf16_t* Bt; int ld, Kloop; };

struct StaticOrder {
    int nM, nN, nNv, nwg, G, c;
    __device__ void init(int M, int N, int split, int G_, int c_) { nM = M / BM; nN = N / BM; nNv = nN * split; nwg = nM * nNv; G = G_; c = c_; }
    __device__ bool next(int i, Unit& u) const {
        const long L = (long)i * G + c; if (L >= nwg) return false;
        int wgid = (int)L; { const int q = nwg / NXCD, r = nwg % NXCD, xcd = wgid % NXCD, off = wgid / NXCD; wgid = (xcd < r ? xcd * (q + 1) : r * (q + 1) + (xcd - r) * q) + off; }
        const int nig = WGM * nNv, gid = wgid / nig, fm = gid * WGM, gsz = (nM - fm) < WGM ? (nM - fm) : WGM;
        u.pm = fm + ((wgid % nig) % gsz); const int pv = (wgid % nig) / gsz; u.pn = pv % nN; u.ks = pv / nN; return true;
    }
};

template <class Epi>
__device__ __forceinline__ void gemm_phase(LAS unsigned char* lds, const Gemm g, const StaticOrder& S, const Epi& E) {
    const int tid = threadIdx.x, wid = __builtin_amdgcn_readfirstlane(tid >> 6), lane = tid & 63, wr = wid >> 2, wc = wid & 3, fr = lane & 15, fq = lane >> 4;
    const int ld = g.ld, nt = g.Kloop / BK;
    unsigned voffA[2], voffB[2];
#pragma unroll
    for (int i = 0; i < 2; ++i) { int R, C; stage_rc(tid * 16 + i * 8192, R, C); const int Rb = Epi::PERM ? ((R & ~31) + perm32(R & 31)) : R;
        voffA[i] = (unsigned)(R * ld + C) * 2u; voffB[i] = (unsigned)(Rb * ld + C) * 2u; }
    const size_t kstep = (size_t)(BK * 2);
    const size_t hstep = (size_t)HALF * ld * 2;
    const size_t tstep = 2 * hstep;
    const size_t kso = (size_t)g.Kloop * 2;
    const unsigned ldsw = (unsigned)wid * 1024u;
    const int aoff = lds_byte(wr * 64 + fr, fq * 8), boff = lds_byte(wc * 32 + fr, fq * 8);
#define PG8_SA(b, h) (((b) * 2 + (h)) * HTB)
#define PG8_SB(b, h) ((4 + (b) * 2 + (h)) * HTB)
#define PG8_STAGE(bufoff, gbase, voff) do { _Pragma("unroll") for (int _i = 0; _i < 2; ++_i) \
        __builtin_amdgcn_global_load_lds((const unsigned*)((const char*)(gbase) + (voff)[_i]), (LAS unsigned*)(lds + (bufoff) + ldsw + _i * 8192), 16, 0, 0); } while (0)
#define PG8_LDA(dst, b, h) do { _Pragma("unroll") for (int m = 0; m < 4; ++m) _Pragma("unroll") for (int k = 0; k < 2; ++k) dst[m][k] = *(const LAS bf16x8*)(lds + PG8_SA(b, h) + aoff + m * 2048 + k * 1024); } while (0)
#define PG8_LDB(dst, b, h) do { _Pragma("unroll") for (int n = 0; n < 2; ++n) _Pragma("unroll") for (int k = 0; k < 2; ++k) dst[n][k] = *(const LAS bf16x8*)(lds + PG8_SB(b, h) + boff + n * 2048 + k * 1024); } while (0)
#define PG8_MMA(ai, bj, At, Bt) do { __builtin_amdgcn_s_setprio(1); _Pragma("unroll") for (int m = 0; m < 4; ++m) _Pragma("unroll") for (int n = 0; n < 2; ++n) _Pragma("unroll") for (int k = 0; k < 2; ++k) \
        acc[ai][bj][m][n] = __builtin_amdgcn_mfma_f32_16x16x32_bf16(Bt[n][k], At[m][k], acc[ai][bj][m][n], 0, 0, 0); __builtin_amdgcn_s_setprio(0); } while (0)
#define PG8_WAIT_V(n) asm volatile("s_waitcnt vmcnt(" #n ")" ::: "memory")
#define PG8_WAIT_L(n) asm volatile("s_waitcnt lgkmcnt(" #n ")" ::: "memory")
#define PG8_BAR __builtin_amdgcn_s_barrier()
#define PG8_SCHED __builtin_amdgcn_sched_barrier(0)
#define PG8_UA(u) ((const char*)g.A + (size_t)(u).pm * tstep + (size_t)(u).ks * kso)
#define PG8_UB(u) ((const char*)g.Bt + (size_t)(u).pn * tstep + (size_t)(u).ks * kso)
    Unit cur, nxt; int ui = 0;
    if (!S.next(0, cur)) return;
    f32x4 acc[2][2][4][2];
#pragma unroll
    for (int a = 0; a < 2; ++a)
#pragma unroll
        for (int b = 0; b < 2; ++b)
#pragma unroll
            for (int m = 0; m < 4; ++m)
#pragma unroll
                for (int n = 0; n < 2; ++n) acc[a][b][m][n] = (f32x4){0.f, 0.f, 0.f, 0.f};
    bf16x8 At[4][2], B0[2][2], B1[2][2];
    const char* cA = PG8_UA(cur); const char* cB = PG8_UB(cur);
    PG8_STAGE(PG8_SB(0, 0), cB, voffB); PG8_STAGE(PG8_SB(0, 1), cB + hstep, voffB); PG8_STAGE(PG8_SA(0, 0), cA, voffA); PG8_STAGE(PG8_SA(0, 1), cA + hstep, voffA);
    if (wr == 1) PG8_BAR;
    PG8_WAIT_V(2); PG8_BAR;
    PG8_STAGE(PG8_SB(1, 0), cB + kstep, voffB); PG8_STAGE(PG8_SA(1, 0), cA + kstep, voffA); PG8_STAGE(PG8_SB(1, 1), cB + hstep + kstep, voffB);
    PG8_WAIT_V(6); PG8_BAR;
    for (;;) {
        const bool has_next = S.next(ui + 1, nxt);
        const char* nA = has_next ? PG8_UA(nxt) : cA; const char* nB = has_next ? PG8_UB(nxt) : cB;
        for (int t = 0; t < nt; t += 2) {
            const bool last = (t == nt - 2);
            const char* a1 = cA + (size_t)(t + 1) * kstep;
            const char* a2 = last ? nA : cA + (size_t)(t + 2) * kstep; const char* b2 = last ? nB : cB + (size_t)(t + 2) * kstep;
            const char* a3 = a2 + kstep; const char* b3 = b2 + kstep;
            PG8_LDB(B0, 0, 0); PG8_LDB(B1, 0, 1); PG8_SCHED; PG8_LDA(At, 0, 0); PG8_STAGE(PG8_SA(1, 1), a1 + hstep, voffA);
            PG8_WAIT_V(8); PG8_WAIT_L(0); PG8_BAR; PG8_MMA(0, 0, At, B0); PG8_MMA(0, 1, At, B1); PG8_BAR; PG8_SCHED;
            PG8_LDA(At, 0, 1); PG8_STAGE(PG8_SB(0, 0), b2, voffB); PG8_STAGE(PG8_SB(0, 1), b2 + hstep, voffB); PG8_STAGE(PG8_SA(0, 0), a2, voffA);
            PG8_WAIT_V(8); PG8_WAIT_L(0); PG8_BAR; PG8_MMA(1, 0, At, B0); PG8_MMA(1, 1, At, B1); PG8_BAR; PG8_SCHED;
            PG8_LDB(B0, 1, 0); PG8_LDB(B1, 1, 1); PG8_SCHED; PG8_LDA(At, 1, 0); PG8_STAGE(PG8_SA(0, 1), a2 + hstep, voffA);
            PG8_WAIT_V(8); PG8_WAIT_L(0); PG8_BAR; PG8_MMA(0, 0, At, B0); PG8_MMA(0, 1, At, B1); PG8_BAR; PG8_SCHED;
            PG8_LDA(At, 1, 1); PG8_STAGE(PG8_SB(1, 0), b3, voffB); PG8_STAGE(PG8_SB(1, 1), b3 + hstep, voffB); PG8_STAGE(PG8_SA(1, 0), a3, voffA);
            PG8_WAIT_V(8); PG8_WAIT_L(0); PG8_BAR; PG8_MMA(1, 0, At, B0); PG8_MMA(1, 1, At, B1); PG8_BAR; PG8_SCHED;
        }
        if (wr == 0) PG8_BAR;
        E(acc, cur, wr, wc, fr, fq);
        if (!has_next) break;
#pragma unroll
        for (int a = 0; a < 2; ++a)
#pragma unroll
            for (int b = 0; b < 2; ++b)
#pragma unroll
                for (int m = 0; m < 4; ++m)
#pragma unroll
                    for (int n = 0; n < 2; ++n) acc[a][b][m][n] = (f32x4){0.f, 0.f, 0.f, 0.f};
        cur = nxt; cA = nA; cB = nB; ++ui;
        if (wr == 1) PG8_BAR;
    }
    PG8_WAIT_V(0);
    PG8_BAR;
#undef PG8_SA
#undef PG8_SB
#undef PG8_STAGE
#undef PG8_LDA
#undef PG8_LDB
#undef PG8_MMA
#undef PG8_WAIT_V
#undef PG8_WAIT_L
#undef PG8_BAR
#undef PG8_SCHED
#undef PG8_UA
#undef PG8_UB
}

struct EpiRelu2 {
    static constexpr bool PERM = true;
    bf16_t* O; int ldc;
    __device__ __forceinline__ void operator()(const f32x4 (&acc)[2][2][4][2], const Unit& u, int wr, int wc, int fr, int fq) const {
        const int row0 = u.pm * BM + wr * 64 + fr, col0 = u.pn * BM + wc * 32 + 8 * fq;
#pragma unroll
        for (int ai = 0; ai < 2; ++ai)
#pragma unroll
            for (int m = 0; m < 4; ++m) { bf16_t* rowp = O + (size_t)(row0 + ai * HALF + m * 16) * ldc + col0;
#pragma unroll
                for (int bj = 0; bj < 2; ++bj) { f32x4 v0 = acc[ai][bj][m][0], v1 = acc[ai][bj][m][1];
#pragma unroll
                    for (int j = 0; j < 4; ++j) { const float a = fmaxf(v0[j], 0.f), b = fmaxf(v1[j], 0.f); v0[j] = a * a; v1[j] = b * b; }
                    u32x4 w; w.x = pk2(v0[0], v0[1]); w.y = pk2(v0[2], v0[3]); w.z = pk2(v1[0], v1[1]); w.w = pk2(v1[2], v1[3]);
                    *(u32x4*)(rowp + bj * HALF) = w; } }
    }
};
struct EpiResid {
    static constexpr bool PERM = false;
    const float* res0; const float* res1; float* X; float* P1; const float* gate;
    __device__ __forceinline__ void operator()(const f32x4 (&acc)[2][2][4][2], const Unit& u, int wr, int wc, int fr, int fq) const {
        const int vec = u.pm < 16 ? 0 : (u.pm < 24 ? 1 : 2);
        const float* gv_ = gate + vec * 6144; const float* rs = u.pm < 16 ? res0 : res1;
        const int col0 = u.pn * BM + wc * 32 + 4 * fq;
        f32x4 gv[2][2];
#pragma unroll
        for (int bj = 0; bj < 2; ++bj)
#pragma unroll
            for (int n = 0; n < 2; ++n) gv[bj][n] = *(const f32x4*)(gv_ + col0 + bj * HALF + n * 16);
#pragma unroll
        for (int ai = 0; ai < 2; ++ai)
#pragma unroll
            for (int m = 0; m < 4; ++m) { const size_t off = (size_t)(u.pm * BM + ai * HALF + wr * 64 + m * 16 + fr) * D + col0;
#pragma unroll
                for (int bj = 0; bj < 2; ++bj)
#pragma unroll
                    for (int n = 0; n < 2; ++n) { f32x4 o = gv[bj][n] * acc[ai][bj][m][n]; const size_t e = off + bj * HALF + n * 16;
                        if (u.ks == 0) { o += *(const f32x4*)(rs + e); *(f32x4*)(X + e) = o; } else { *(f32x4*)(P1 + e) = o; } } }
    }
};
struct EpiGlu {
    static constexpr bool PERM = false;
    float* X; const float* gate;
    __device__ __forceinline__ void operator()(const f32x4 (&acc)[2][2][4][2], const Unit& u, int wr, int wc, int fr, int fq) const {
        const int vec = u.pm < 16 ? 0 : (u.pm < 24 ? 1 : 2);
        const float* gv_ = gate + vec * 6144;
        const int col0 = u.pn * HALF + wc * 32 + 4 * fq;
        f32x4 gv[2];
#pragma unroll
        for (int n = 0; n < 2; ++n) gv[n] = *(const f32x4*)(gv_ + col0 + n * 16);
#pragma unroll
        for (int ai = 0; ai < 2; ++ai)
#pragma unroll
            for (int m = 0; m < 4; ++m) { const size_t off = (size_t)(u.pm * BM + ai * HALF + wr * 64 + m * 16 + fr) * D + col0;
#pragma unroll
                for (int n = 0; n < 2; ++n) { const f32x4 a = acc[ai][0][m][n], b = acc[ai][1][m][n]; f32x4 o;
#pragma unroll
                    for (int j = 0; j < 4; ++j) o[j] = a[j] / (1.f + __expf(-b[j]));
                    const size_t e = off + n * 16; *(f32x4*)(X + e) = *(const f32x4*)(X + e) + gv[n] * o; } }
    }
};
struct EpiQkv {
    static constexpr bool PERM = false;
    bf16_t* QB; bf16_t* KB; bf16_t* VT; float* outK; float* outV; const float* ropec; const float* ropes;
    __device__ __forceinline__ void operator()(const f32x4 (&acc)[2][2][4][2], const Unit& u, int wr, int wc, int fr, int fq) const {
        const bool lat = u.pm >= 16;
#pragma unroll
        for (int ai = 0; ai < 2; ++ai)
#pragma unroll
            for (int m = 0; m < 4; ++m) {
                const int row = u.pm * BM + ai * HALF + wr * 64 + m * 16 + fr;
                f32x4 cs = {1.f, 1.f, 1.f, 1.f}, sn = {0.f, 0.f, 0.f, 0.f};
                if (lat && u.pn < 5) { const int tp = row & 2047; cs = *(const f32x4*)(ropec + tp * 32 + (wc & 1) * 16 + 4 * fq); sn = *(const f32x4*)(ropes + tp * 32 + (wc & 1) * 16 + 4 * fq); }
#pragma unroll
                for (int bj = 0; bj < 2; ++bj) {
                    f32x4 x1 = acc[ai][bj][m][0], x2 = acc[ai][bj][m][1];
                    const int cl = bj * HALF + wc * 32 + 4 * fq;
                    if (u.pn < 5) {
                        const f32x4 y1 = x1 * cs - x2 * sn, y2 = x1 * sn + x2 * cs;
                        bf16_t* dst = (u.pn < 4) ? (QB + (size_t)row * D + u.pn * BM + cl) : (KB + (size_t)row * 256 + cl);
                        u32x2 w1, w2; w1.x = pk2(y1[0], y1[1]); w1.y = pk2(y1[2], y1[3]); w2.x = pk2(y2[0], y2[1]); w2.y = pk2(y2[2], y2[3]);
                        *(u32x2*)dst = w1; *(u32x2*)(dst + 16) = w2;
                        if (u.pn == 4 && !lat) { *(f32x4*)(outK + (size_t)row * 256 + cl) = x1; *(f32x4*)(outK + (size_t)row * 256 + cl + 16) = x2; }
                    } else {
#pragma unroll
                        for (int j = 0; j < 4; ++j) { VT[(size_t)(cl + j) * KROWS + row] = (bf16_t)(pk2(x1[j], 0.f) & 0xffffu); VT[(size_t)(cl + 16 + j) * KROWS + row] = (bf16_t)(pk2(x2[j], 0.f) & 0xffffu); }
                        if (!lat) { *(f32x4*)(outV + (size_t)row * 256 + cl) = x1; *(f32x4*)(outV + (size_t)row * 256 + cl + 16) = x2; }
                    }
                }
            }
    }
};
}

DI void transpose_item(const float* W, int K, int N, bf16_t* WT, int k0, int n0, int drow0, LAS float* scr, int lane) {
#pragma unroll 8
    for (int i = 0; i < 32; ++i) { const int kk = 2 * i + (lane >> 5); scr[kk * 33 + (lane & 31)] = W[(size_t)(k0 + kk) * N + n0 + (lane & 31)]; }
    asm volatile("" ::: "memory");
    const int c = lane & 7;
#pragma unroll
    for (int j = 0; j < 4; ++j) { const int n = (lane >> 3) + 8 * j; const LAS float* s = scr + (8 * c) * 33 + n;
        u32x4 o; o.x = pk2(s[0 * 33], s[1 * 33]); o.y = pk2(s[2 * 33], s[3 * 33]); o.z = pk2(s[4 * 33], s[5 * 33]); o.w = pk2(s[6 * 33], s[7 * 33]);
        *(u32x4*)(WT + (size_t)(drow0 + n) * K + k0 + 8 * c) = o; }
    asm volatile("" ::: "memory");
}
DI void transpose_mat(const float* W, int K, int N, bf16_t* WT, int item, LAS float* scr, int lane, int glu  ) {
    const int nblk = N / 32, kb = item / nblk, nb = item % nblk, n0 = 32 * nb;
    int drow0 = n0;
    if (glu) drow0 = 256 * (n0 >> 7) + (n0 & 127) + (glu == 2 ? 128 : 0);
    transpose_item(W, K, N, WT, 64 * kb, n0, drow0, scr, lane);
}

DI void prep_phase(const Params& P, LAS unsigned char* lds) {
    const int tid = threadIdx.x, wid = tid >> 6, lane = tid & 63, G = gridDim.x, bid = blockIdx.x;
    unsigned char* ws = P.ws;
    if (bid < 192) {
        LAS float* sl = (LAS float*)lds;
        LAS float* red = (LAS float*)(lds + 12288);
        for (int e = tid; e < 3072; e += 512) { const int v = e >> 10, k = e & 1023; const float x = (v == 0) ? P.in[6][k] : P.in[5][(v - 1) * 1024 + k]; sl[e] = x / (1.f + __expf(-x)); }
        __syncthreads();
        const int l = bid / 96, n0 = (bid % 96) * 64, cq = lane & 15, kr = lane >> 4;
        const float* wm = P.in[9] + (size_t)l * 1024 * 6144 + n0 + 4 * cq;
        f32x4 a0 = {0.f, 0.f, 0.f, 0.f}, a1 = a0, a2 = a0;
#pragma unroll 8
        for (int i = 0; i < 32; ++i) { const int k = 128 * wid + 4 * i + kr; const f32x4 w = *(const f32x4*)(wm + (size_t)k * 6144);
            a0 += w * sl[k]; a1 += w * sl[1024 + k]; a2 += w * sl[2048 + k]; }
#pragma unroll
        for (int j = 0; j < 4; ++j) { a0[j] += __shfl_xor(a0[j], 16); a0[j] += __shfl_xor(a0[j], 32); a1[j] += __shfl_xor(a1[j], 16); a1[j] += __shfl_xor(a1[j], 32); a2[j] += __shfl_xor(a2[j], 16); a2[j] += __shfl_xor(a2[j], 32); }
        if (kr == 0) { *(LAS f32x4*)(red + (wid * 3 + 0) * 64 + 4 * cq) = a0; *(LAS f32x4*)(red + (wid * 3 + 1) * 64 + 4 * cq) = a1; *(LAS f32x4*)(red + (wid * 3 + 2) * 64 + 4 * cq) = a2; }
        __syncthreads();
        if (tid < 192) { const int v = tid >> 6, cc = tid & 63; float s = P.in[10][l * 6144 + n0 + cc];
#pragma unroll
            for (int w = 0; w < 8; ++w) s += red[(w * 3 + v) * 64 + cc];
            ((float*)(ws + WS_MOD))[(l * 3 + v) * 6144 + n0 + cc] = s; }
    }
    {
        LAS float* scr = (LAS float*)(lds + 32768 + wid * 8704);
        const int gw = bid * 8 + wid, NGW = G * 8;
        constexpr int I_QKV = 16 * 48, I_O = 16 * 32, I_G = 16 * 32, I_1 = 16 * 128, I_2 = 64 * 32;
        constexpr int NIT = I_QKV + I_O + 2 * I_G + 2 * I_1 + 2 * I_2;
        for (int it = gw; it < NIT; it += NGW) {
            int r = it;
            if (r < I_QKV) { transpose_mat(P.in[11], 1024, 1536, (bf16_t*)(ws + WS_WQKV), r, scr, lane, 0); continue; } r -= I_QKV;
            if (r < I_O) { transpose_mat(P.in[12], 1024, 1024, (bf16_t*)(ws + WS_WO), r, scr, lane, 0); continue; } r -= I_O;
            if (r < I_G) { transpose_mat(P.in[22], 1024, 1024, (bf16_t*)(ws + WS_WGLU), r, scr, lane, 1); continue; } r -= I_G;
            if (r < I_G) { transpose_mat(P.in[23], 1024, 1024, (bf16_t*)(ws + WS_WGLU), r, scr, lane, 2); continue; } r -= I_G;
            if (r < 2 * I_1) { const int l = r / I_1; transpose_mat(P.in[24] + (size_t)l * D * FF, 1024, 4096, (bf16_t*)(ws + WS_W1) + (size_t)l * D * FF, r % I_1, scr, lane, 0); continue; } r -= 2 * I_1;
            { const int l = r / I_2; transpose_mat(P.in[25] + (size_t)l * D * FF, 4096, 1024, (bf16_t*)(ws + WS_W2) + (size_t)l * D * FF, r % I_2, scr, lane, 0); }
        }
    }
    const int gt = bid * 512 + tid, NGT = G * 512;
    for (int e = gt; e < 2 * 256 * 256; e += NGT) {
        const int tok = e >> 8, c = e & 255;
        ((bf16_t*)(ws + WS_KB))[(size_t)(T + tok) * 256 + c] = (bf16_t)(pk2(P.in[2][e], 0.f) & 0xffffu);
    }
    for (int e = gt; e < 2 * 256 * 256; e += NGT) {
        const int c = e >> 9, tok = e & 511;
        ((bf16_t*)(ws + WS_VT))[(size_t)c * KROWS + T + tok] = (bf16_t)(pk2(P.in[3][tok * 256 + c], 0.f) & 0xffffu);
    }
    for (int e = gt; e < 2048 * 32; e += NGT) {
        const int tp = e >> 5, k = e & 31, f = k & 15; const float pos = (k >> 4) ? (float)(tp & 63) : (float)(tp >> 6);
        const float freq = powf(10000.f, -(float)f / 16.f); const float ang = pos * freq;
        ((float*)(ws + WS_ROPE))[e] = cosf(ang); ((float*)(ws + WS_ROPE))[2048 * 32 + e] = sinf(ang);
    }
    for (int e = gt; e < 2 * 64 * 64; e += NGT) {
        const int dg = e >> 6, p = e & 63;
        const float dt = expf(P.in[16][dg]), lre = P.in[14][e], lim = P.in[15][e];
        const float mag = expf(lre * dt), ang = lim * dt; const float are = mag * cosf(ang), aim = mag * sinf(ang);
        const float den = lre * lre + lim * lim, nre = are - 1.f, nim = aim;
        const float fre = (nre * lre + nim * lim) / den, fim = (nim * lre - nre * lim) / den;
        ((float*)(ws + WS_ABAR))[e * 2] = are; ((float*)(ws + WS_ABAR))[e * 2 + 1] = aim;
        bf16_t* bbm = (bf16_t*)(ws + WS_BBM) + (size_t)dg * 128 * 16; bf16_t* ccm = (bf16_t*)(ws + WS_CCM) + (size_t)dg * 16 * 128;
        for (int c = 0; c < 16; ++c) {
            const float br = P.in[17][(size_t)e * 16 + c], bi = P.in[18][(size_t)e * 16 + c];
            bbm[p * 16 + c] = (bf16_t)(pk2(fre * br - fim * bi, 0.f) & 0xffffu);
            bbm[(64 + p) * 16 + c] = (bf16_t)(pk2(fre * bi + fim * br, 0.f) & 0xffffu);
            const float cr = P.in[19][((size_t)dg * 16 + c) * 64 + p], ci = P.in[20][((size_t)dg * 16 + c) * 64 + p];
            const int k = 4 * (p & 31) + 2 * (p >> 5);
            ccm[c * 128 + k] = (bf16_t)(pk2(cr, 0.f) & 0xffffu); ccm[c * 128 + k + 1] = (bf16_t)(pk2(-ci, 0.f) & 0xffffu);
        }
    }
}

template <int MODE>
DI void norm_phase(const Params& P, const float* gain, const float* modl, int sh_off, int sc_off) {
    const int tid = threadIdx.x, wid = tid >> 6, lane = tid & 63;
    float* X = (float*)(P.ws + WS_X); const float* P1 = (const float*)(P.ws + WS_P1); bf16_t* HB = (bf16_t*)(P.ws + WS_HB);
    for (int row = blockIdx.x * 8 + wid; row < T; row += gridDim.x * 8) {
        const float* src = (MODE == 0) ? (row < TCTX ? P.in[0] + (size_t)row * D : P.in[1] + (size_t)(row - TCTX) * D) : X + (size_t)row * D;
        f32x4 v[4]; float ss = 0.f;
#pragma unroll
        for (int j = 0; j < 4; ++j) { v[j] = *(const f32x4*)(src + 4 * lane + 256 * j);
            if (MODE >= 2) { v[j] += *(const f32x4*)(P1 + (size_t)row * D + 4 * lane + 256 * j); if (MODE == 2) *(f32x4*)(X + (size_t)row * D + 4 * lane + 256 * j) = v[j]; }
            ss += (v[j][0] * v[j][0] + v[j][1] * v[j][1]) + (v[j][2] * v[j][2] + v[j][3] * v[j][3]); }
        const float rinv = rsqrtf(wave_sum(ss) * (1.f / D) + 1e-6f);
        if (MODE == 3) {
#pragma unroll
            for (int j = 0; j < 4; ++j) { const f32x4 g = *(const f32x4*)(gain + 4 * lane + 256 * j); *(f32x4*)(P.out + (size_t)row * D + 4 * lane + 256 * j) = v[j] * rinv * g; }
        } else {
            const int vec = row < TCTX ? 0 : (row < TCTX + LLAT ? 1 : 2); const float* mv = modl + vec * 6144;
#pragma unroll
            for (int j = 0; j < 4; ++j) { const int c = 4 * lane + 256 * j; const f32x4 g = *(const f32x4*)(gain + c), sc = *(const f32x4*)(mv + sc_off + c), sh = *(const f32x4*)(mv + sh_off + c);
                const f32x4 h = (v[j] * rinv * g) * (sc + 1.f) + sh; u32x2 w; w.x = pk2(h[0], h[1]); w.y = pk2(h[2], h[3]); *(u32x2*)(HB + (size_t)row * D + c) = w; }
        }
    }
}

DI void attn_phase(const Params& P, LAS unsigned char* lds) {
    const int tid = threadIdx.x, wid = tid >> 6, lane = tid & 63, r = lane & 15, g4 = lane >> 4;
    const bf16_t* QB = (const bf16_t*)(P.ws + WS_QB); const bf16_t* KB = (const bf16_t*)(P.ws + WS_KB); const bf16_t* VT = (const bf16_t*)(P.ws + WS_VT); bf16_t* OB = (bf16_t*)(P.ws + WS_OB);
    const float LOG2E = 1.44269504089f, SC = 0.125f * 1.44269504089f;
    const int lrow = tid >> 3, lch = tid & 7;
    for (int u = blockIdx.x; u < 1024; u += gridDim.x) {
        int h, tok0, win0, nwin, ctx0, ipos0; bool lat;
        if (u < 512) { const int b = u >> 5; h = (u >> 1) & 15; const int n = u & 1; tok0 = 256 * b + 128 * n; win0 = 0; nwin = 0; ctx0 = 256 * b; lat = false; ipos0 = 0; }
        else { const int v = u - 512, b = v >> 8; h = (v >> 4) & 15; const int n = v & 15; const int tb = TCTX + LLAT * b; tok0 = tb + 128 * n;
            const int j0 = (128 * n - 128) < 0 ? 0 : (128 * n - 128), j1 = (128 * n + 256) > LLAT ? LLAT : (128 * n + 256);
            win0 = tb + j0; nwin = (j1 - j0) >> 6; ctx0 = T + 256 * b; lat = true; ipos0 = 128 * n - j0; }
        const int kvh = h >> 2, ntile = nwin + 4;
        const bf16_t* qp = QB + (size_t)(tok0 + 16 * wid + r) * D + h * 64 + 8 * g4;
        const bf16x8 qb0 = *(const bf16x8*)qp, qb1 = *(const bf16x8*)(qp + 32);
        float m_run = P.in[13][h] * LOG2E, l_run = (g4 == 0) ? 1.f : 0.f;
        f32x4 o[4];
#pragma unroll
        for (int dt = 0; dt < 4; ++dt) o[dt] = (f32x4){0.f, 0.f, 0.f, 0.f};
        const int iq = ipos0 + 16 * wid + r;
        u32x4 kreg, vreg;
        { const int tk = (0 < nwin) ? win0 : ctx0;
          kreg = *(const u32x4*)(KB + (size_t)(tk + lrow) * 256 + kvh * 64 + lch * 8); vreg = *(const u32x4*)(VT + (size_t)(kvh * 64 + lrow) * KROWS + tk + lch * 8); }
        *(LAS u32x4*)(lds + lrow * 144 + lch * 16) = kreg; *(LAS u32x4*)(lds + 9216 + lrow * 144 + lch * 16) = vreg;
        __syncthreads();
        for (int t = 0; t < ntile; ++t) {
            LAS unsigned char* Kb = lds + (t & 1) * 18432; LAS unsigned char* Vb = Kb + 9216;
            if (t + 1 < ntile) { const int tk = (t + 1 < nwin) ? win0 + 64 * (t + 1) : ctx0 + 64 * (t + 1 - nwin);
                kreg = *(const u32x4*)(KB + (size_t)(tk + lrow) * 256 + kvh * 64 + lch * 8); vreg = *(const u32x4*)(VT + (size_t)(kvh * 64 + lrow) * KROWS + tk + lch * 8); }
            f32x4 s[4];
#pragma unroll
            for (int kt = 0; kt < 4; ++kt) {
                const bf16x8 a0 = *(const LAS bf16x8*)(Kb + (16 * kt + r) * 144 + g4 * 16), a1 = *(const LAS bf16x8*)(Kb + (16 * kt + r) * 144 + 64 + g4 * 16);
                f32x4 z = {0.f, 0.f, 0.f, 0.f};
                z = __builtin_amdgcn_mfma_f32_16x16x32_bf16(a0, qb0, z, 0, 0, 0);
                s[kt] = __builtin_amdgcn_mfma_f32_16x16x32_bf16(a1, qb1, z, 0, 0, 0);
            }
            const bool masked = lat && (t < nwin);
            float mx = -3.0e38f;
#pragma unroll
            for (int kt = 0; kt < 4; ++kt)
#pragma unroll
                for (int i = 0; i < 4; ++i) { float x = s[kt][i] * SC;
                    if (masked) { const int dj = 64 * t + 16 * kt + 4 * g4 + i - iq; if (dj > 128 || dj < -128) x = -1.0e30f; }
                    s[kt][i] = x; mx = fmaxf(mx, x); }
            mx = fmaxf(mx, __shfl_xor(mx, 16)); mx = fmaxf(mx, __shfl_xor(mx, 32));
            const float mnew = fmaxf(m_run, mx), alpha = exp2f(m_run - mnew); m_run = mnew;
            float ls = 0.f;
#pragma unroll
            for (int kt = 0; kt < 4; ++kt)
#pragma unroll
                for (int i = 0; i < 4; ++i) { const float p = exp2f(s[kt][i] - mnew); s[kt][i] = p; ls += p; }
            l_run = l_run * alpha + ls;
#pragma unroll
            for (int dt = 0; dt < 4; ++dt) o[dt] *= alpha;
            u32x4 pw01, pw23;
            pw01.x = pk2(s[0][0], s[0][1]); pw01.y = pk2(s[0][2], s[0][3]); pw01.z = pk2(s[1][0], s[1][1]); pw01.w = pk2(s[1][2], s[1][3]);
            pw23.x = pk2(s[2][0], s[2][1]); pw23.y = pk2(s[2][2], s[2][3]); pw23.z = pk2(s[3][0], s[3][1]); pw23.w = pk2(s[3][2], s[3][3]);
            const bf16x8 pb01 = __builtin_bit_cast(bf16x8, pw01), pb23 = __builtin_bit_cast(bf16x8, pw23);
#pragma unroll
            for (int dt = 0; dt < 4; ++dt) {
                const LAS unsigned char* vr = Vb + (16 * dt + r) * 144 + g4 * 8;
                u32x4 va; const u32x2 l0 = *(const LAS u32x2*)(vr), h0 = *(const LAS u32x2*)(vr + 32), l1 = *(const LAS u32x2*)(vr + 64), h1 = *(const LAS u32x2*)(vr + 96);
                va.x = l0.x; va.y = l0.y; va.z = h0.x; va.w = h0.y;
                o[dt] = __builtin_amdgcn_mfma_f32_16x16x32_bf16(__builtin_bit_cast(bf16x8, va), pb01, o[dt], 0, 0, 0);
                va.x = l1.x; va.y = l1.y; va.z = h1.x; va.w = h1.y;
                o[dt] = __builtin_amdgcn_mfma_f32_16x16x32_bf16(__builtin_bit_cast(bf16x8, va), pb23, o[dt], 0, 0, 0);
            }
            if (t + 1 < ntile) { LAS unsigned char* Kn = lds + ((t + 1) & 1) * 18432; *(LAS u32x4*)(Kn + lrow * 144 + lch * 16) = kreg; *(LAS u32x4*)(Kn + 9216 + lrow * 144 + lch * 16) = vreg; }
            __syncthreads();
        }
        float l = l_run; l += __shfl_xor(l, 16); l += __shfl_xor(l, 32);
        const float inv = 1.f / l;
        bf16_t* op = OB + (size_t)(tok0 + 16 * wid + r) * D + h * 64 + 4 * g4;
#pragma unroll
        for (int dt = 0; dt < 4; ++dt) { u32x2 w; w.x = pk2(o[dt][0] * inv, o[dt][1] * inv); w.y = pk2(o[dt][2] * inv, o[dt][3] * inv); *(u32x2*)(op + 16 * dt) = w; }
    }
}

DI void ssm_phase(const Params& P, LAS unsigned char* lds) {
    const int tid = threadIdx.x, wid = tid >> 6, lane = tid & 63, p = lane & 31, h = lane >> 5;
    const int gw = wid * gridDim.x + blockIdx.x;
    int g, dir, tokX, tokY, nsteps; bool lat;
    if (gw < 128) { g = gw >> 1; dir = gw & 1; tokX = TCTX; tokY = TCTX + LLAT; nsteps = LLAT; lat = true; }
    else if (gw < 1152) { const int id = gw - 128; const int pr = id >> 7; g = (id >> 1) & 63; dir = id & 1; tokX = 512 * pr; tokY = 512 * pr + 256; nsteps = 256; lat = false; }
    else return;
    LAS unsigned char* S = lds + wid * 8704;
    const bf16_t* HB = (const bf16_t*)(P.ws + WS_HB);
    float* YP = (float*)(P.ws + WS_YP) + (size_t)dir * T * D;
    const int dg = dir * 64 + g;
    const float* ab = (const float*)(P.ws + WS_ABAR) + (size_t)dg * 128;
    const float ar0 = ab[2 * p], ai0 = ab[2 * p + 1], ar1 = ab[2 * (p + 32)], ai1 = ab[2 * (p + 32) + 1];
    bf16x8 bbq[4], ccb[4];
#pragma unroll
    for (int q = 0; q < 4; ++q) bbq[q] = *(const bf16x8*)((const bf16_t*)(P.ws + WS_BBM) + ((size_t)dg * 128 + q * 32 + p) * 16 + 8 * h);
#pragma unroll
    for (int ks = 0; ks < 4; ++ks) ccb[ks] = *(const bf16x8*)((const bf16_t*)(P.ws + WS_CCM) + ((size_t)dg * 16 + (lane & 15)) * 128 + 32 * ks + 8 * (lane >> 4));
    float sr0 = 0.f, si0 = 0.f, sr1 = 0.f, si1 = 0.f;
    if (lat) { const float* s0 = P.in[4] + ((size_t)(h * 2 + dir) * 2) * 4096 + g * 64;
        sr0 = s0[p]; sr1 = s0[p + 32]; si0 = s0[4096 + p]; si1 = s0[4096 + p + 32]; }
    const int hh = (p >> 2) & 1, ii = 4 * (p >> 3) + (p & 3);
    const bf16_t* ubase = HB + (size_t)((hh ? tokY : tokX) + ii) * D + 16 * g + 8 * h;
    const int ntile = nsteps >> 4;
    const int c16 = lane & 15, g4 = lane >> 4;
    bf16x8 a_nxt = *(const bf16x8*)(ubase + (size_t)(dir ? nsteps - 16 : 0) * D);
    for (int tt = 0; tt < ntile; ++tt) {
        const int t0 = dir ? nsteps - 16 - 16 * tt : 16 * tt;
        const bf16x8 a = a_nxt;
        if (tt + 1 < ntile) a_nxt = *(const bf16x8*)(ubase + (size_t)(dir ? t0 - 16 : t0 + 16) * D);
        f32x16 acc[4];
#pragma unroll
        for (int q = 0; q < 4; ++q) { f32x16 z;
#pragma unroll
            for (int i = 0; i < 16; ++i) z[i] = 0.f;
            acc[q] = __builtin_amdgcn_mfma_f32_32x32x16_bf16(a, bbq[q], z, 0, 0, 0); }
#define SSM_STEP(i) { const float nr0 = ar0 * sr0 - ai0 * si0 + acc[0][i], ni0 = ar0 * si0 + ai0 * sr0 + acc[2][i]; \
                      const float nr1 = ar1 * sr1 - ai1 * si1 + acc[1][i], ni1 = ar1 * si1 + ai1 * sr1 + acc[3][i]; \
                      sr0 = nr0; si0 = ni0; sr1 = nr1; si1 = ni1; u32x2 w; w.x = pk2(nr0, ni0); w.y = pk2(nr1, ni1); *(LAS u32x2*)(S + (16 * h + (i)) * 272 + p * 8) = w; }
        if (dir == 0) {
#pragma unroll
            for (int i = 0; i < 16; ++i) SSM_STEP(i)
        } else {
#pragma unroll
            for (int i = 15; i >= 0; --i) SSM_STEP(i)
        }
#undef SSM_STEP
        asm volatile("" ::: "memory");
#pragma unroll
        for (int mt = 0; mt < 2; ++mt) {
            f32x4 y = {0.f, 0.f, 0.f, 0.f};
#pragma unroll
            for (int ks = 0; ks < 4; ++ks) { const bf16x8 sa = *(const LAS bf16x8*)(S + (16 * mt + c16) * 272 + 64 * ks + 16 * g4);
                y = __builtin_amdgcn_mfma_f32_16x16x32_bf16(sa, ccb[ks], y, 0, 0, 0); }
            float* yp = YP + (size_t)((mt ? tokY : tokX) + t0 + 4 * g4) * D + 16 * g + c16;
#pragma unroll
            for (int i = 0; i < 4; ++i) yp[(size_t)i * D] = y[i];
        }
        asm volatile("" ::: "memory");
    }
    if (!lat) { float* so = P.out + OUT_S + ((size_t)((tokX >> 8) + h) * 2 + dir) * 2 * 4096 + g * 64;
        so[p] = sr0; so[p + 32] = sr1; so[4096 + p] = si0; so[4096 + p + 32] = si1; }
}

DI void combine_phase(const Params& P) {
    const bf16_t* HB = (const bf16_t*)(P.ws + WS_HB); const float* Y0 = (const float*)(P.ws + WS_YP); const float* Y1 = Y0 + (size_t)T * D; bf16_t* YB = (bf16_t*)(P.ws + WS_QB);
    const float* dsk = P.in[21];
    for (size_t e = ((size_t)blockIdx.x * 512 + threadIdx.x) * 8; e < (size_t)T * D; e += (size_t)gridDim.x * 512 * 8) {
        const int c = (int)(e & 1023);
        const u32x4 ub = *(const u32x4*)(HB + e);
        const f32x4 a0 = *(const f32x4*)(Y0 + e), a1 = *(const f32x4*)(Y0 + e + 4), b0 = *(const f32x4*)(Y1 + e), b1 = *(const f32x4*)(Y1 + e + 4), d0 = *(const f32x4*)(dsk + c), d1 = *(const f32x4*)(dsk + c + 4);
        f32x4 u0, u1;
        u0[0] = __builtin_bit_cast(float, ub.x << 16); u0[1] = __builtin_bit_cast(float, ub.x & 0xffff0000u); u0[2] = __builtin_bit_cast(float, ub.y << 16); u0[3] = __builtin_bit_cast(float, ub.y & 0xffff0000u);
        u1[0] = __builtin_bit_cast(float, ub.z << 16); u1[1] = __builtin_bit_cast(float, ub.z & 0xffff0000u); u1[2] = __builtin_bit_cast(float, ub.w << 16); u1[3] = __builtin_bit_cast(float, ub.w & 0xffff0000u);
        const f32x4 v0 = d0 * u0 + a0 + b0, v1 = d1 * u1 + a1 + b1;
        float v[8] = {v0[0], v0[1], v0[2], v0[3], v1[0], v1[1], v1[2], v1[3]};
#pragma unroll
        for (int j = 0; j < 8; ++j) { const float x = v[j]; const float z = 1.5957691216f * (x + 0.044715f * x * x * x); v[j] = x / (1.f + __expf(-z)); }
        u32x4 w; w.x = pk2(v[0], v[1]); w.y = pk2(v[2], v[3]); w.z = pk2(v[4], v[5]); w.w = pk2(v[6], v[7]);
        *(u32x4*)(YB + e) = w;
    }
}


#define XB_TMO      128
#define XB_XCNT(j)  (256  + 64 * (j))
#define XB_XSUB(j)  (1280 + 64 * (j))
#define XB_XGEN(j)  (2304 + 64 * (j))
#define XB_TOP      3328
#define XB_TOPGEN   3392
#define XCD_BAR_WORDS 3456
#define XB_SPIN_CAP (1u << 18)
DI unsigned xb_ld(unsigned* p)              { return __hip_atomic_load(p, __ATOMIC_RELAXED, __HIP_MEMORY_SCOPE_AGENT); }
DI unsigned xb_add(unsigned* p, unsigned v) { return __hip_atomic_fetch_add(p, v, __ATOMIC_RELAXED, __HIP_MEMORY_SCOPE_AGENT); }
DI unsigned xb_xcc_id() { return (unsigned)__builtin_amdgcn_s_getreg((3 << 11) | 20) & 0xFu; }
#define XB_SPIN(cond, bar) do { unsigned _sp = 0; while (cond) { __builtin_amdgcn_s_sleep(1); \
    if ((++_sp & 255u) == 0u) { if (xb_ld(&(bar)[XB_TMO])) break; if (_sp > XB_SPIN_CAP) { atomicAdd(&(bar)[XB_TMO], 1u); break; } } } } while (0)
struct XcdBarrier { unsigned* bar; unsigned x; volatile LAS unsigned* st; };
DI XcdBarrier xcd_barrier_post(unsigned* bar, volatile LAS unsigned* st) {
    XcdBarrier b; b.bar = bar; b.x = xb_xcc_id(); b.st = st;
    if (threadIdx.x == 0) (void)xb_add(&bar[XB_XCNT(b.x)], 1u);
    return b;
}
DI void xcd_barrier_complete(unsigned* bar, unsigned x, unsigned& nloc, unsigned& nx) {
    const unsigned G = gridDim.x * gridDim.y * gridDim.z;
    unsigned sum, cnt, mine, sp = 0u;
    for (;;) {
        sum = 0u; cnt = 0u; mine = 0u;
#pragma unroll
        for (unsigned j = 0; j < 16; ++j) { const unsigned c = xb_ld(&bar[XB_XCNT(j)]); sum += c; cnt += (c > 0u) ? 1u : 0u; mine = (j == x) ? c : mine; }
        if (sum == G) break;
        __builtin_amdgcn_s_sleep(1);
        if ((++sp & 255u) == 0u) { if (xb_ld(&bar[XB_TMO])) break; if (sp > XB_SPIN_CAP) { atomicAdd(&bar[XB_TMO], 1u); break; } }
    }
    nloc = mine > 0u ? mine : 1u; nx = cnt > 0u ? cnt : 1u;
}
DI void xcd_barrier(const XcdBarrier& b) {
    asm volatile("s_waitcnt vmcnt(0)" ::: "memory");
    __syncthreads();
    if (threadIdx.x == 0) {
        unsigned* bar = b.bar;
        __builtin_amdgcn_s_waitcnt(0);
        unsigned nloc = b.st[0], nx = b.st[1];
        if (nloc == 0u) { xcd_barrier_complete(bar, b.x, nloc, nx); b.st[0] = nloc; b.st[1] = nx; }
        const unsigned old = xb_add(&bar[XB_XSUB(b.x)], 1u);
        const unsigned gen = old / nloc;
        if (old + 1u == (gen + 1u) * nloc) {
            __builtin_amdgcn_fence(__ATOMIC_RELEASE, "agent");
            asm volatile("s_waitcnt vmcnt(0)" ::: "memory");
            const unsigned og = xb_add(&bar[XB_TOP], 1u);
            const unsigned tg = og / nx;
            if (og + 1u == (tg + 1u) * nx) xb_add(&bar[XB_TOPGEN], 1u);
            else XB_SPIN(xb_ld(&bar[XB_TOPGEN]) == tg, bar);
            __builtin_amdgcn_fence(__ATOMIC_ACQUIRE, "agent");
            xb_add(&bar[XB_XGEN(b.x)], 1u);
            asm volatile("s_waitcnt vmcnt(0)" ::: "memory");
        } else {
            XB_SPIN(xb_ld(&bar[XB_XGEN(b.x)]) == gen, bar);
            __builtin_amdgcn_fence(__ATOMIC_ACQUIRE, "agent");
            asm volatile("s_waitcnt vmcnt(0)" ::: "memory");
        }
    }
    __syncthreads();
}

constexpr int NPHASE = 16;
#ifndef REPMASK
#define REPMASK 0
#endif
#ifndef EXTRA_SYNCS
#define EXTRA_SYNCS 0
#endif
constexpr int LDS_BYTES = 147456;
__global__ void __launch_bounds__(512, 2) fwd_kernel(Params P) {
    extern __shared__ __attribute__((aligned(16))) unsigned char lds_raw[];
    LAS unsigned char* lds = (LAS unsigned char*)lds_raw;
    cg::grid_group grid = cg::this_grid();
    unsigned char* ws = P.ws;
    const float* MOD = (const float*)(ws + WS_MOD);
    const int lo = P.ph_lo, hi = P.ph_hi, G = gridDim.x;
    volatile LAS unsigned* MISC = (volatile LAS unsigned*)(lds + 131072);
    if (threadIdx.x < 64) MISC[threadIdx.x] = 0u;
    __syncthreads();
    XcdBarrier bar = xcd_barrier_post((unsigned*)ws, MISC + 8);
#define IN(k) (lo <= (k) && (k) < hi)
#define SYNC(k) do { if (IN(k) && IN((k) + 1)) { if ((k) == 0) grid.sync(); else xcd_barrier(bar); } } while (0)
#define PHASE(k, ...) do { if (IN(k)) { __VA_ARGS__; if ((REPMASK >> (k)) & 1) { xcd_barrier(bar); __VA_ARGS__; } } SYNC(k); } while (0)
#define GEMM_QKV { pg8::Gemm g{(const bf16_t*)(ws + WS_HB), (const bf16_t*)(ws + WS_WQKV), D, D}; pg8::StaticOrder S; S.init(T, NQKV, 1, G, blockIdx.x); \
        pg8::EpiQkv E{(bf16_t*)(ws + WS_QB), (bf16_t*)(ws + WS_KB), (bf16_t*)(ws + WS_VT), P.out + OUT_K, P.out + OUT_V, (const float*)(ws + WS_ROPE), (const float*)(ws + WS_ROPE) + 2048 * 32}; \
        pg8::gemm_phase(lds, g, S, E); }
#define GEMM_WO { pg8::Gemm g{(const bf16_t*)(ws + WS_OB), (const bf16_t*)(ws + WS_WO), D, D / 2}; pg8::StaticOrder S; S.init(T, D, 2, G, blockIdx.x); \
        pg8::EpiResid E{P.in[0], P.in[1] - (size_t)TCTX * D, (float*)(ws + WS_X), (float*)(ws + WS_P1), MOD + 2048}; \
        pg8::gemm_phase(lds, g, S, E); }
#define GEMM_MLP1(l) { pg8::Gemm g{(const bf16_t*)(ws + WS_HB), (const bf16_t*)(ws + WS_W1) + (size_t)(l) * D * FF, D, D}; pg8::StaticOrder S; S.init(T, FF, 1, G, blockIdx.x); \
        pg8::EpiRelu2 E{(bf16_t*)(ws + WS_AB), FF}; pg8::gemm_phase(lds, g, S, E); }
#define GEMM_MLP2(l) { pg8::Gemm g{(const bf16_t*)(ws + WS_AB), (const bf16_t*)(ws + WS_W2) + (size_t)(l) * D * FF, FF, FF / 2}; pg8::StaticOrder S; S.init(T, D, 2, G, blockIdx.x); \
        pg8::EpiResid E{(const float*)(ws + WS_X), (const float*)(ws + WS_X), (float*)(ws + WS_X), (float*)(ws + WS_P1), MOD + (l) * 3 * 6144 + 5120}; \
        pg8::gemm_phase(lds, g, S, E); }
#define GEMM_GLU { pg8::Gemm g{(const bf16_t*)(ws + WS_QB), (const bf16_t*)(ws + WS_WGLU), D, D}; pg8::StaticOrder S; S.init(T, 2 * D, 1, G, blockIdx.x); \
        pg8::EpiGlu E{(float*)(ws + WS_X), MOD + 3 * 6144 + 2048}; pg8::gemm_phase(lds, g, S, E); }
    PHASE(0, prep_phase(P, lds));
    for (int x = 0; x < EXTRA_SYNCS; ++x) xcd_barrier(bar);
    PHASE(1, norm_phase<0>(P, P.in[7], MOD, 0, 1024));
    PHASE(2, GEMM_QKV);
    PHASE(3, attn_phase(P, lds));
    PHASE(4, GEMM_WO);
    PHASE(5, norm_phase<2>(P, P.in[8], MOD, 3072, 4096));
    PHASE(6, GEMM_MLP1(0));
    PHASE(7, GEMM_MLP2(0));
    PHASE(8, norm_phase<2>(P, P.in[7] + D, MOD + 3 * 6144, 0, 1024));
    PHASE(9, ssm_phase(P, lds));
    PHASE(10, combine_phase(P));
    PHASE(11, GEMM_GLU);
    PHASE(12, norm_phase<1>(P, P.in[8] + D, MOD + 3 * 6144, 3072, 4096));
    PHASE(13, GEMM_MLP1(1));
    PHASE(14, GEMM_MLP2(1));
    PHASE(15, norm_phase<3>(P, P.in[26], MOD, 0, 0));
#undef IN
}

#ifndef MK_MULTI
#define MK_MULTI 0
#endif
extern "C" void kernel_launch(void* const* d_in, const int* in_sizes, int n_in, void* d_out, int out_size, void* d_ws, size_t ws_size, hipStream_t stream) {
    static int grid = 0;
    if (grid == 0) {
        int dev = 0, cus = 0, per_cu = 0;
        hipGetDevice(&dev);
        hipDeviceGetAttribute(&cus, hipDeviceAttributeMultiprocessorCount, dev);
        hipFuncSetAttribute((const void*)fwd_kernel, hipFuncAttributeMaxDynamicSharedMemorySize, LDS_BYTES);
        hipOccupancyMaxActiveBlocksPerMultiprocessor(&per_cu, (const void*)fwd_kernel, 512, LDS_BYTES);
        if (per_cu < 1) { fprintf(stderr, "occupancy query gave %d\n", per_cu); per_cu = 1; }
        if (per_cu > 1) per_cu = 1;
        grid = cus * per_cu;
        if (grid > 256) grid = 256;
    }
    (void)hipMemsetAsync(d_ws, 0, 16384, stream);
    Params p{};
    for (int i = 0; i < 27; ++i) p.in[i] = (const float*)d_in[i];
    p.out = (float*)d_out; p.ws = (unsigned char*)d_ws;
#if MK_MULTI
    for (int k = 0; k < NPHASE; ++k) { p.ph_lo = k; p.ph_hi = k + 1; hipLaunchKernelGGL(fwd_kernel, dim3(grid), dim3(512), LDS_BYTES, stream, p); }
#else
    p.ph_lo = 0; p.ph_hi = NPHASE;
    void* args[] = {&p};
    hipError_t e = hipLaunchCooperativeKernel((const void*)fwd_kernel, dim3(grid), dim3(512), args, LDS_BYTES, stream);
    if (e != hipSuccess) fprintf(stderr, "cooperative launch failed: %s (grid %d)\n", hipGetErrorString(e), grid);
#endif
}
```

```cpp
#include <hip/hip_runtime.h>
#include <hip/hip_cooperative_groups.h>
#include <cstdio>
#include <cstdint>
namespace cg = cooperative_groups;

#define LAS __attribute__((address_space(3)))
typedef unsigned short bf16_t;
typedef short bf16x8 __attribute__((ext_vector_type(8)));
typedef float f32x4 __attribute__((ext_vector_type(4)));
typedef float f32x16 __attribute__((ext_vector_type(16)));
typedef float f32x2 __attribute__((ext_vector_type(2)));
typedef unsigned u32x4 __attribute__((ext_vector_type(4)));
typedef unsigned u32x2 __attribute__((ext_vector_type(2)));
typedef __bf16 bf16x2v __attribute__((ext_vector_type(2)));
#define DI __device__ __forceinline__

DI unsigned pk2(float a, float b) { f32x2 v = {a, b}; bf16x2v r = __builtin_convertvector(v, bf16x2v); return __builtin_bit_cast(unsigned, r); }
DI float bf2f(unsigned short u) { return __builtin_bit_cast(float, (unsigned)u << 16); }
DI float wave_sum(float v) {
#pragma unroll
    for (int o = 1; o < 64; o <<= 1) v += __shfl_xor(v, o);
    return v;
}

constexpr int T = 8192, D = 1024, FF = 4096, NQKV = 1536, TCTX = 4096, LLAT = 2048;
constexpr int KROWS = 8704;
constexpr size_t MiB = 1u << 20;
constexpr size_t WS_MOD = 1 * MiB;
constexpr size_t WS_ABAR = 2 * MiB;
constexpr size_t WS_BBM = 2 * MiB + 128 * 1024;
constexpr size_t WS_CCM = 2 * MiB + 640 * 1024;
constexpr size_t WS_ROPE = 3 * MiB + 256 * 1024;
constexpr size_t WS_WQKV = 4 * MiB, WS_WO = 7 * MiB, WS_WGLU = 9 * MiB, WS_W1 = 13 * MiB, WS_W2 = 29 * MiB;
constexpr size_t WS_KB = 45 * MiB, WS_VT = 50 * MiB;
constexpr size_t WS_HB = 56 * MiB, WS_QB = 72 * MiB, WS_OB = 88 * MiB, WS_X = 104 * MiB, WS_P1 = 136 * MiB, WS_AB = 168 * MiB;
constexpr size_t WS_YP = 168 * MiB;
constexpr int OUT_K = 8388608, OUT_V = 8388608 + 1048576, OUT_S = 8388608 + 2 * 1048576;

struct Params { const float* in[27]; float* out; unsigned char* ws; int ph_lo, ph_hi; };

namespace pg8 {
constexpr int BM = 256, BK = 64, HALF = 128, HTB = HALF * BK * 2, STAGE_BYTES = 8 * HTB, NXCD = 8, WGM = 8;
__host__ __device__ __forceinline__ int lds_byte(int r, int c) { const int st = (r >> 4) * 2 + (c >> 5), rr = r & 15, cc = c & 31, ob = rr * 64 + cc * 2; return st * 1024 + (ob ^ (((ob >> 9) & 1) << 5)); }
__host__ __device__ __forceinline__ void stage_rc(int b, int& R, int& C) { const int st = b / 1024, sb = b % 1024, swz = sb ^ (((sb >> 9) & 1) << 5); R = (st >> 1) * 16 + swz / 64; C = (st & 1) * 32 + (swz % 64) / 2; }
__host__ __device__ __forceinline__ int perm32(int rho) { const int n = rho >> 4, i = rho & 15; return 8 * (i >> 2) + 4 * n + (i & 3); }

struct Unit { int pm, pn, ks; };
struct Gemm { const bf16_t* A; const bf16_t* Bt; int ld, Kloop; };

struct StaticOrder {
    int nM, nN, nNv, nwg, G, c;
    __device__ void init(int M, int N, int split, int G_, int c_) { nM = M / BM; nN = N / BM; nNv = nN * split; nwg = nM * nNv; G = G_; c = c_; }
    __device__ bool next(int i, Unit& u) const {
        const long L = (long)i * G + c; if (L >= nwg) return false;
        int wgid = (int)L; { const int q = nwg / NXCD, r = nwg % NXCD, xcd = wgid % NXCD, off = wgid / NXCD; wgid = (xcd < r ? xcd * (q + 1) : r * (q + 1) + (xcd - r) * q) + off; }
        const int nig = WGM * nNv, gid = wgid / nig, fm = gid * WGM, gsz = (nM - fm) < WGM ? (nM - fm) : WGM;
        u.pm = fm + ((wgid % nig) % gsz); const int pv = (wgid % nig) / gsz; u.pn = pv % nN; u.ks = pv / nN; return true;
    }
};

template <class Epi>
__device__ __forceinline__ void gemm_phase(LAS unsigned char* lds, const Gemm g, const StaticOrder& S, const Epi& E) {
    const int tid = threadIdx.x, wid = __builtin_amdgcn_readfirstlane(tid >> 6), lane = tid & 63, wr = wid >> 2, wc = wid & 3, fr = lane & 15, fq = lane >> 4;
    const int ld = g.ld, nt = g.Kloop / BK;
    unsigned voffA[2], voffB[2];
#pragma unroll
    for (int i = 0; i < 2; ++i) { int R, C; stage_rc(tid * 16 + i * 8192, R, C); const int Rb = Epi::PERM ? ((R & ~31) + perm32(R & 31)) : R;
        voffA[i] = (unsigned)(R * ld + C) * 2u; voffB[i] = (unsigned)(Rb * ld + C) * 2u; }
    const size_t kstep = (size_t)(BK * 2);
    const size_t hstep = (size_t)HALF * ld * 2;
    const size_t tstep = 2 * hstep;
    const size_t kso = (size_t)g.Kloop * 2;
    const unsigned ldsw = (unsigned)wid * 1024u;
    const int aoff = lds_byte(wr * 64 + fr, fq * 8), boff = lds_byte(wc * 32 + fr, fq * 8);
#define PG8_SA(b, h) (((b) * 2 + (h)) * HTB)
#define PG8_SB(b, h) ((4 + (b) * 2 + (h)) * HTB)
#define PG8_STAGE(bufoff, gbase, voff) do { _Pragma("unroll") for (int _i = 0; _i < 2; ++_i) \
        __builtin_amdgcn_global_load_lds((const unsigned*)((const char*)(gbase) + (voff)[_i]), (LAS unsigned*)(lds + (bufoff) + ldsw + _i * 8192), 16, 0, 0); } while (0)
#define PG8_LDA(dst, b, h) do { _Pragma("unroll") for (int m = 0; m < 4; ++m) _Pragma("unroll") for (int k = 0; k < 2; ++k) dst[m][k] = *(const LAS bf16x8*)(lds + PG8_SA(b, h) + aoff + m * 2048 + k * 1024); } while (0)
#define PG8_LDB(dst, b, h) do { _Pragma("unroll") for (int n = 0; n < 2; ++n) _Pragma("unroll") for (int k = 0; k < 2; ++k) dst[n][k] = *(const LAS bf16x8*)(lds + PG8_SB(b, h) + boff + n * 2048 + k * 1024); } while (0)
#define PG8_MMA(ai, bj, At, Bt) do { __builtin_amdgcn_s_setprio(1); _Pragma("unroll") for (int m = 0; m < 4; ++m) _Pragma("unroll") for (int n = 0; n < 2; ++n) _Pragma("unroll") for (int k = 0; k < 2; ++k) \
        acc[ai][bj][m][n] = __builtin_amdgcn_mfma_f32_16x16x32_bf16(Bt[n][k], At[m][k], acc[ai][bj][m][n], 0, 0, 0); __builtin_amdgcn_s_setprio(0); } while (0)
#define PG8_WAIT_V(n) asm volatile("s_waitcnt vmcnt(" #n ")" ::: "memory")
#define PG8_WAIT_L(n) asm volatile("s_waitcnt lgkmcnt(" #n ")" ::: "memory")
#define PG8_BAR __builtin_amdgcn_s_barrier()
#define PG8_SCHED __builtin_amdgcn_sched_barrier(0)
#define PG8_UA(u) ((const char*)g.A + (size_t)(u).pm * tstep + (size_t)(u).ks * kso)
#define PG8_UB(u) ((const char*)g.Bt + (size_t)(u).pn * tstep + (size_t)(u).ks * kso)
    Unit cur, nxt; int ui = 0;
    if (!S.next(0, cur)) return;
    f32x4 acc[2][2][4][2];
#pragma unroll
    for (int a = 0; a < 2; ++a)
#pragma unroll
        for (int b = 0; b < 2; ++b)
#pragma unroll
            for (int m = 0; m < 4; ++m)
#pragma unroll
                for (int n = 0; n < 2; ++n) acc[a][b][m][n] = (f32x4){0.f, 0.f, 0.f, 0.f};
    bf16x8 At[4][2], B0[2][2], B1[2][2];
    const char* cA = PG8_UA(cur); const char* cB = PG8_UB(cur);
    PG8_STAGE(PG8_SB(0, 0), cB, voffB); PG8_STAGE(PG8_SB(0, 1), cB + hstep, voffB); PG8_STAGE(PG8_SA(0, 0), cA, voffA); PG8_STAGE(PG8_SA(0, 1), cA + hstep, voffA);
    if (wr == 1) PG8_BAR;
    PG8_WAIT_V(2); PG8_BAR;
    PG8_STAGE(PG8_SB(1, 0), cB + kstep, voffB); PG8_STAGE(PG8_SA(1, 0), cA + kstep, voffA); PG8_STAGE(PG8_SB(1, 1), cB + hstep + kstep, voffB);
    PG8_WAIT_V(6); PG8_BAR;
    for (;;) {
        const bool has_next = S.next(ui + 1, nxt);
        const char* nA = has_next ? PG8_UA(nxt) : cA; const char* nB = has_next ? PG8_UB(nxt) : cB;
        for (int t = 0; t < nt; t += 2) {
            const bool last = (t == nt - 2);
            const char* a1 = cA + (size_t)(t + 1) * kstep;
            const char* a2 = last ? nA : cA + (size_t)(t + 2) * kstep; const char* b2 = last ? nB : cB + (size_t)(t + 2) * kstep;
            const char* a3 = a2 + kstep; const char* b3 = b2 + kstep;
            PG8_LDB(B0, 0, 0); PG8_LDB(B1, 0, 1); PG8_SCHED; PG8_LDA(At, 0, 0); PG8_STAGE(PG8_SA(1, 1), a1 + hstep, voffA);
            PG8_WAIT_V(8); PG8_WAIT_L(0); PG8_BAR; PG8_MMA(0, 0, At, B0); PG8_MMA(0, 1, At, B1); PG8_BAR; PG8_SCHED;
            PG8_LDA(At, 0, 1); PG8_STAGE(PG8_SB(0, 0), b2, voffB); PG8_STAGE(PG8_SB(0, 1), b2 + hstep, voffB); PG8_STAGE(PG8_SA(0, 0), a2, voffA);
            PG8_WAIT_V(8); PG8_WAIT_L(0); PG8_BAR; PG8_MMA(1, 0, At, B0); PG8_MMA(1, 1, At, B1); PG8_BAR; PG8_SCHED;
            PG8_LDB(B0, 1, 0); PG8_LDB(B1, 1, 1); PG8_SCHED; PG8_LDA(At, 1, 0); PG8_STAGE(PG8_SA(0, 1), a2 + hstep, voffA);
            PG8_WAIT_V(8); PG8_WAIT_L(0); PG8_BAR; PG8_MMA(0, 0, At, B0); PG8_MMA(0, 1, At, B1); PG8_BAR; PG8_SCHED;
            PG8_LDA(At, 1, 1); PG8_STAGE(PG8_SB(1, 0), b3, voffB); PG8_STAGE(PG8_SB(1, 1), b3 + hstep, voffB); PG8_STAGE(PG8_SA(1, 0), a3, voffA);
            PG8_WAIT_V(8); PG8_WAIT_L(0); PG8_BAR; PG8_MMA(1, 0, At, B0); PG8_MMA(1, 1, At, B1); PG8_BAR; PG8_SCHED;
        }
        if (wr == 0) PG8_BAR;
        E(acc, cur, wr, wc, fr, fq);
        if (!has_next) break;
#pragma unroll
        for (int a = 0; a < 2; ++a)
#pragma unroll
            for (int b = 0; b < 2; ++b)
#pragma unroll
                for (int m = 0; m < 4; ++m)
#pragma unroll
                    for (int n = 0; n < 2; ++n) acc[a][b][m][n] = (f32x4){0.f, 0.f, 0.f, 0.f};
        cur = nxt; cA = nA; cB = nB; ++ui;
        if (wr == 1) PG8_BAR;
    }
    PG8_WAIT_V(0);
    PG8_BAR;
#undef PG8_SA
#undef PG8_SB
#undef PG8_STAGE
#undef PG8_LDA
#undef PG8_LDB
#undef PG8_MMA
#undef PG8_WAIT_V
#undef PG8_WAIT_L
#undef PG8_BAR
#undef PG8_SCHED
#undef PG8_UA
#undef PG8_UB
}

struct EpiRelu2 {
    static constexpr bool PERM = true;
    bf16_t* O; int ldc;
    __device__ __forceinline__ void operator()(const f32x4 (&acc)[2][2][4][2], const Unit& u, int wr, int wc, int fr, int fq) const {
        const int row0 = u.pm * BM + wr * 64 + fr, col0 = u.pn * BM + wc * 32 + 8 * fq;
#pragma unroll
        for (int ai = 0; ai < 2; ++ai)
#pragma unroll
            for (int m = 0; m < 4; ++m) { bf16_t* rowp = O + (size_t)(row0 + ai * HALF + m * 16) * ldc + col0;
#pragma unroll
                for (int bj = 0; bj < 2; ++bj) { f32x4 v0 = acc[ai][bj][m][0], v1 = acc[ai][bj][m][1];
#pragma unroll
                    for (int j = 0; j < 4; ++j) { const float a = fmaxf(v0[j], 0.f), b = fmaxf(v1[j], 0.f); v0[j] = a * a; v1[j] = b * b; }
                    u32x4 w; w.x = pk2(v0[0], v0[1]); w.y = pk2(v0[2], v0[3]); w.z = pk2(v1[0], v1[1]); w.w = pk2(v1[2], v1[3]);
                    *(u32x4*)(rowp + bj * HALF) = w; } }
    }
};
struct EpiResid {
    static constexpr bool PERM = false;
    const float* res0; const float* res1; float* X; float* P1; const float* gate;
    __device__ __forceinline__ void operator()(const f32x4 (&acc)[2][2][4][2], const Unit& u, int wr, int wc, int fr, int fq) const {
        const int vec = u.pm < 16 ? 0 : (u.pm < 24 ? 1 : 2);
        const float* gv_ = gate + vec * 6144; const float* rs = u.pm < 16 ? res0 : res1;
        const int col0 = u.pn * BM + wc * 32 + 4 * fq;
        f32x4 gv[2][2];
#pragma unroll
        for (int bj = 0; bj < 2; ++bj)
#pragma unroll
            for (int n = 0; n < 2; ++n) gv[bj][n] = *(const f32x4*)(gv_ + col0 + bj * HALF + n * 16);
#pragma unroll
        for (int ai = 0; ai < 2; ++ai)
#pragma unroll
            for (int m = 0; m < 4; ++m) { const size_t off = (size_t)(u.pm * BM + ai * HALF + wr * 64 + m * 16 + fr) * D + col0;
#pragma unroll
                for (int bj = 0; bj < 2; ++bj)
#pragma unroll
                    for (int n = 0; n < 2; ++n) { f32x4 o = gv[bj][n] * acc[ai][bj][m][n]; const size_t e = off + bj * HALF + n * 16;
                        if (u.ks == 0) { o += *(const f32x4*)(rs + e); *(f32x4*)(X + e) = o; } else { *(f32x4*)(P1 + e) = o; } } }
    }
};
struct EpiGlu {
    static constexpr bool PERM = false;
    float* X; const float* gate;
    __device__ __forceinline__ void operator()(const f32x4 (&acc)[2][2][4][2], const Unit& u, int wr, int wc, int fr, int fq) const {
        const int vec = u.pm < 16 ? 0 : (u.pm < 24 ? 1 : 2);
        const float* gv_ = gate + vec * 6144;
        const int col0 = u.pn * HALF + wc * 32 + 4 * fq;
        f32x4 gv[2];
#pragma unroll
        for (int n = 0; n < 2; ++n) gv[n] = *(const f32x4*)(gv_ + col0 + n * 16);
#pragma unroll
        for (int ai = 0; ai < 2; ++ai)
#pragma unroll
            for (int m = 0; m < 4; ++m) { const size_t off = (size_t)(u.pm * BM + ai * HALF + wr * 64 + m * 16 + fr) * D + col0;
#pragma unroll
                for (int n = 0; n < 2; ++n) { const f32x4 a = acc[ai][0][m][n], b = acc[ai][1][m][n]; f32x4 o;
#pragma unroll
                    for (int j = 0; j < 4; ++j) o[j] = a[j] / (1.f + __expf(-b[j]));
                    const size_t e = off + n * 16; *(f32x4*)(X + e) = *(const f32x4*)(X + e) + gv[n] * o; } }
    }
};
struct EpiQkv {
    static constexpr bool PERM = false;
    bf16_t* QB; bf16_t* KB; bf16_t* VT; float* outK; float* outV; const float* ropec; const float* ropes;
    __device__ __forceinline__ void operator()(const f32x4 (&acc)[2][2][4][2], const Unit& u, int wr, int wc, int fr, int fq) const {
        const bool lat = u.pm >= 16;
#pragma unroll
        for (int ai = 0; ai < 2; ++ai)
#pragma unroll
            for (int m = 0; m < 4; ++m) {
                const int row = u.pm * BM + ai * HALF + wr * 64 + m * 16 + fr;
                f32x4 cs = {1.f, 1.f, 1.f, 1.f}, sn = {0.f, 0.f, 0.f, 0.f};
                if (lat && u.pn < 5) { const int tp = row & 2047; cs = *(const f32x4*)(ropec + tp * 32 + (wc & 1) * 16 + 4 * fq); sn = *(const f32x4*)(ropes + tp * 32 + (wc & 1) * 16 + 4 * fq); }
#pragma unroll
                for (int bj = 0; bj < 2; ++bj) {
                    f32x4 x1 = acc[ai][bj][m][0], x2 = acc[ai][bj][m][1];
                    const int cl = bj * HALF + wc * 32 + 4 * fq;
                    if (u.pn < 5) {
                        const f32x4 y1 = x1 * cs - x2 * sn, y2 = x1 * sn + x2 * cs;
                        bf16_t* dst = (u.pn < 4) ? (QB + (size_t)row * D + u.pn * BM + cl) : (KB + (size_t)row * 256 + cl);
                        u32x2 w1, w2; w1.x = pk2(y1[0], y1[1]); w1.y = pk2(y1[2], y1[3]); w2.x = pk2(y2[0], y2[1]); w2.y = pk2(y2[2], y2[3]);
                        *(u32x2*)dst = w1; *(u32x2*)(dst + 16) = w2;
                        if (u.pn == 4 && !lat) { *(f32x4*)(outK + (size_t)row * 256 + cl) = x1; *(f32x4*)(outK + (size_t)row * 256 + cl + 16) = x2; }
                    } else {
#pragma unroll
                        for (int j = 0; j < 4; ++j) { VT[(size_t)(cl + j) * KROWS + row] = (bf16_t)(pk2(x1[j], 0.f) & 0xffffu); VT[(size_t)(cl + 16 + j) * KROWS + row] = (bf16_t)(pk2(x2[j], 0.f) & 0xffffu); }
                        if (!lat) { *(f32x4*)(outV + (size_t)row * 256 + cl) = x1; *(f32x4*)(outV + (size_t)row * 256 + cl + 16) = x2; }
                    }
                }
            }
    }
};
}

DI void transpose_item(const float* W, int K, int N, bf16_t* WT, int k0, int n0, int drow0, LAS float* scr, int lane) {
#pragma unroll 8
    for (int i = 0; i < 32; ++i) { const int kk = 2 * i + (lane >> 5); scr[kk * 33 + (lane & 31)] = W[(size_t)(k0 + kk) * N + n0 + (lane & 31)]; }
    asm volatile("" ::: "memory");
    const int c = lane & 7;
#pragma unroll
    for (int j = 0; j < 4; ++j) { const int n = (lane >> 3) + 8 * j; const LAS float* s = scr + (8 * c) * 33 + n;
        u32x4 o; o.x = pk2(s[0 * 33], s[1 * 33]); o.y = pk2(s[2 * 33], s[3 * 33]); o.z = pk2(s[4 * 33], s[5 * 33]); o.w = pk2(s[6 * 33], s[7 * 33]);
        *(u32x4*)(WT + (size_t)(drow0 + n) * K + k0 + 8 * c) = o; }
    asm volatile("" ::: "memory");
}
DI void transpose_mat(const float* W, int K, int N, bf16_t* WT, int item, LAS float* scr, int lane, int glu  ) {
    const int nblk = N / 32, kb = item / nblk, nb = item % nblk, n0 = 32 * nb;
    int drow0 = n0;
    if (glu) drow0 = 256 * (n0 >> 7) + (n0 & 127) + (glu == 2 ? 128 : 0);
    transpose_item(W, K, N, WT, 64 * kb, n0, drow0, scr, lane);
}

DI void prep_phase(const Params& P, LAS unsigned char* lds) {
    const int tid = threadIdx.x, wid = tid >> 6, lane = tid & 63, G = gridDim.x, bid = blockIdx.x;
    unsigned char* ws = P.ws;
    if (bid < 192) {
        LAS float* sl = (LAS float*)lds;
        LAS float* red = (LAS float*)(lds + 12288);
        for (int e = tid; e < 3072; e += 512) { const int v = e >> 10, k = e & 1023; const float x = (v == 0) ? P.in[6][k] : P.in[5][(v - 1) * 1024 + k]; sl[e] = x / (1.f + __expf(-x)); }
        __syncthreads();
        const int l = bid / 96, n0 = (bid % 96) * 64, cq = lane & 15, kr = lane >> 4;
        const float* wm = P.in[9] + (size_t)l * 1024 * 6144 + n0 + 4 * cq;
        f32x4 a0 = {0.f, 0.f, 0.f, 0.f}, a1 = a0, a2 = a0;
#pragma unroll 8
        for (int i = 0; i < 32; ++i) { const int k = 128 * wid + 4 * i + kr; const f32x4 w = *(const f32x4*)(wm + (size_t)k * 6144);
            a0 += w * sl[k]; a1 += w * sl[1024 + k]; a2 += w * sl[2048 + k]; }
#pragma unroll
        for (int j = 0; j < 4; ++j) { a0[j] += __shfl_xor(a0[j], 16); a0[j] += __shfl_xor(a0[j], 32); a1[j] += __shfl_xor(a1[j], 16); a1[j] += __shfl_xor(a1[j], 32); a2[j] += __shfl_xor(a2[j], 16); a2[j] += __shfl_xor(a2[j], 32); }
        if (kr == 0) { *(LAS f32x4*)(red + (wid * 3 + 0) * 64 + 4 * cq) = a0; *(LAS f32x4*)(red + (wid * 3 + 1) * 64 + 4 * cq) = a1; *(LAS f32x4*)(red + (wid * 3 + 2) * 64 + 4 * cq) = a2; }
        __syncthreads();
        if (tid < 192) { const int v = tid >> 6, cc = tid & 63; float s = P.in[10][l * 6144 + n0 + cc];
#pragma unroll
            for (int w = 0; w < 8; ++w) s += red[(w * 3 + v) * 64 + cc];
            ((float*)(ws + WS_MOD))[(l * 3 + v) * 6144 + n0 + cc] = s; }
    }
    {
        LAS float* scr = (LAS float*)(lds + 32768 + wid * 8704);
        const int gw = bid * 8 + wid, NGW = G * 8;
        constexpr int I_QKV = 16 * 48, I_O = 16 * 32, I_G = 16 * 32, I_1 = 16 * 128, I_2 = 64 * 32;
        constexpr int NIT = I_QKV + I_O + 2 * I_G + 2 * I_1 + 2 * I_2;
        for (int it = gw; it < NIT; it += NGW) {
            int r = it;
            if (r < I_QKV) { transpose_mat(P.in[11], 1024, 1536, (bf16_t*)(ws + WS_WQKV), r, scr, lane, 0); continue; } r -= I_QKV;
            if (r < I_O) { transpose_mat(P.in[12], 1024, 1024, (bf16_t*)(ws + WS_WO), r, scr, lane, 0); continue; } r -= I_O;
            if (r < I_G) { transpose_mat(P.in[22], 1024, 1024, (bf16_t*)(ws + WS_WGLU), r, scr, lane, 1); continue; } r -= I_G;
            if (r < I_G) { transpose_mat(P.in[23], 1024, 1024, (bf16_t*)(ws + WS_WGLU), r, scr, lane, 2); continue; } r -= I_G;
            if (r < 2 * I_1) { const int l = r / I_1; transpose_mat(P.in[24] + (size_t)l * D * FF, 1024, 4096, (bf16_t*)(ws + WS_W1) + (size_t)l * D * FF, r % I_1, scr, lane, 0); continue; } r -= 2 * I_1;
            { const int l = r / I_2; transpose_mat(P.in[25] + (size_t)l * D * FF, 4096, 1024, (bf16_t*)(ws + WS_W2) + (size_t)l * D * FF, r % I_2, scr, lane, 0); }
        }
    }
    const int gt = bid * 512 + tid, NGT = G * 512;
    for (int e = gt; e < 2 * 256 * 256; e += NGT) {
        const int tok = e >> 8, c = e & 255;
        ((bf16_t*)(ws + WS_KB))[(size_t)(T + tok) * 256 + c] = (bf16_t)(pk2(P.in[2][e], 0.f) & 0xffffu);
    }
    for (int e = gt; e < 2 * 256 * 256; e += NGT) {
        const int c = e >> 9, tok = e & 511;
        ((bf16_t*)(ws + WS_VT))[(size_t)c * KROWS + T + tok] = (bf16_t)(pk2(P.in[3][tok * 256 + c], 0.f) & 0xffffu);
    }
    for (int e = gt; e < 2048 * 32; e += NGT) {
        const int tp = e >> 5, k = e & 31, f = k & 15; const float pos = (k >> 4) ? (float)(tp & 63) : (float)(tp >> 6);
        const float freq = powf(10000.f, -(float)f / 16.f); const float ang = pos * freq;
        ((float*)(ws + WS_ROPE))[e] = cosf(ang); ((float*)(ws + WS_ROPE))[2048 * 32 + e] = sinf(ang);
    }
    for (int e = gt; e < 2 * 64 * 64; e += NGT) {
        const int dg = e >> 6, p = e & 63;
        const float dt = expf(P.in[16][dg]), lre = P.in[14][e], lim = P.in[15][e];
        const float mag = expf(lre * dt), ang = lim * dt; const float are = mag * cosf(ang), aim = mag * sinf(ang);
        const float den = lre * lre + lim * lim, nre = are - 1.f, nim = aim;
        const float fre = (nre * lre + nim * lim) / den, fim = (nim * lre - nre * lim) / den;
        ((float*)(ws + WS_ABAR))[e * 2] = are; ((float*)(ws + WS_ABAR))[e * 2 + 1] = aim;
        bf16_t* bbm = (bf16_t*)(ws + WS_BBM) + (size_t)dg * 128 * 16; bf16_t* ccm = (bf16_t*)(ws + WS_CCM) + (size_t)dg * 16 * 128;
        for (int c = 0; c < 16; ++c) {
            const float br = P.in[17][(size_t)e * 16 + c], bi = P.in[18][(size_t)e * 16 + c];
            bbm[p * 16 + c] = (bf16_t)(pk2(fre * br - fim * bi, 0.f) & 0xffffu);
            bbm[(64 + p) * 16 + c] = (bf16_t)(pk2(fre * bi + fim * br, 0.f) & 0xffffu);
            const float cr = P.in[19][((size_t)dg * 16 + c) * 64 + p], ci = P.in[20][((size_t)dg * 16 + c) * 64 + p];
            const int k = 4 * (p & 31) + 2 * (p >> 5);
            ccm[c * 128 + k] = (bf16_t)(pk2(cr, 0.f) & 0xffffu); ccm[c * 128 + k + 1] = (bf16_t)(pk2(-ci, 0.f) & 0xffffu);
        }
    }
}

template <int MODE>
DI void norm_phase(const Params& P, const float* gain, const float* modl, int sh_off, int sc_off) {
    const int tid = threadIdx.x, wid = tid >> 6, lane = tid & 63;
    float* X = (float*)(P.ws + WS_X); const float* P1 = (const float*)(P.ws + WS_P1); bf16_t* HB = (bf16_t*)(P.ws + WS_HB);
    for (int row = blockIdx.x * 8 + wid; row < T; row += gridDim.x * 8) {
        const float* src = (MODE == 0) ? (row < TCTX ? P.in[0] + (size_t)row * D : P.in[1] + (size_t)(row - TCTX) * D) : X + (size_t)row * D;
        f32x4 v[4]; float ss = 0.f;
#pragma unroll
        for (int j = 0; j < 4; ++j) { v[j] = *(const f32x4*)(src + 4 * lane + 256 * j);
            if (MODE >= 2) { v[j] += *(const f32x4*)(P1 + (size_t)row * D + 4 * lane + 256 * j); if (MODE == 2) *(f32x4*)(X + (size_t)row * D + 4 * lane + 256 * j) = v[j]; }
            ss += (v[j][0] * v[j][0] + v[j][1] * v[j][1]) + (v[j][2] * v[j][2] + v[j][3] * v[j][3]); }
        const float rinv = rsqrtf(wave_sum(ss) * (1.f / D) + 1e-6f);
        if (MODE == 3) {
#pragma unroll
            for (int j = 0; j < 4; ++j) { const f32x4 g = *(const f32x4*)(gain + 4 * lane + 256 * j); *(f32x4*)(P.out + (size_t)row * D + 4 * lane + 256 * j) = v[j] * rinv * g; }
        } else {
            const int vec = row < TCTX ? 0 : (row < TCTX + LLAT ? 1 : 2); const float* mv = modl + vec * 6144;
#pragma unroll
            for (int j = 0; j < 4; ++j) { const int c = 4 * lane + 256 * j; const f32x4 g = *(const f32x4*)(gain + c), sc = *(const f32x4*)(mv + sc_off + c), sh = *(const f32x4*)(mv + sh_off + c);
                const f32x4 h = (v[j] * rinv * g) * (sc + 1.f) + sh; u32x2 w; w.x = pk2(h[0], h[1]); w.y = pk2(h[2], h[3]); *(u32x2*)(HB + (size_t)row * D + c) = w; }
        }
    }
}

DI void attn_phase(const Params& P, LAS unsigned char* lds) {
    const int tid = threadIdx.x, wid = tid >> 6, lane = tid & 63, r = lane & 15, g4 = lane >> 4;
    const bf16_t* QB = (const bf16_t*)(P.ws + WS_QB); const bf16_t* KB = (const bf16_t*)(P.ws + WS_KB); const bf16_t* VT = (const bf16_t*)(P.ws + WS_VT); bf16_t* OB = (bf16_t*)(P.ws + WS_OB);
    const float LOG2E = 1.44269504089f, SC = 0.125f * 1.44269504089f;
    const int lrow = tid >> 3, lch = tid & 7;
    for (int u = blockIdx.x; u < 1024; u += gridDim.x) {
        int h, tok0, win0, nwin, ctx0, ipos0; bool lat;
        if (u < 512) { const int b = u >> 5; h = (u >> 1) & 15; const int n = u & 1; tok0 = 256 * b + 128 * n; win0 = 0; nwin = 0; ctx0 = 256 * b; lat = false; ipos0 = 0; }
        else { const int v = u - 512, b = v >> 8; h = (v >> 4) & 15; const int n = v & 15; const int tb = TCTX + LLAT * b; tok0 = tb + 128 * n;
            const int j0 = (128 * n - 128) < 0 ? 0 : (128 * n - 128), j1 = (128 * n + 256) > LLAT ? LLAT : (128 * n + 256);
            win0 = tb + j0; nwin = (j1 - j0) >> 6; ctx0 = T + 256 * b; lat = true; ipos0 = 128 * n - j0; }
        const int kvh = h >> 2, ntile = nwin + 4;
        const bf16_t* qp = QB + (size_t)(tok0 + 16 * wid + r) * D + h * 64 + 8 * g4;
        const bf16x8 qb0 = *(const bf16x8*)qp, qb1 = *(const bf16x8*)(qp + 32);
        float m_run = P.in[13][h] * LOG2E, l_run = (g4 == 0) ? 1.f : 0.f;
        f32x4 o[4];
#pragma unroll
        for (int dt = 0; dt < 4; ++dt) o[dt] = (f32x4){0.f, 0.f, 0.f, 0.f};
        const int iq = ipos0 + 16 * wid + r;
        u32x4 kreg, vreg;
        { const int tk = (0 < nwin) ? win0 : ctx0;
          kreg = *(const u32x4*)(KB + (size_t)(tk + lrow) * 256 + kvh * 64 + lch * 8); vreg = *(const u32x4*)(VT + (size_t)(kvh * 64 + lrow) * KROWS + tk + lch * 8); }
        *(LAS u32x4*)(lds + lrow * 144 + lch * 16) = kreg; *(LAS u32x4*)(lds + 9216 + lrow * 144 + lch * 16) = vreg;
        __syncthreads();
        for (int t = 0; t < ntile; ++t) {
            LAS unsigned char* Kb = lds + (t & 1) * 18432; LAS unsigned char* Vb = Kb + 9216;
            if (t + 1 < ntile) { const int tk = (t + 1 < nwin) ? win0 + 64 * (t + 1) : ctx0 + 64 * (t + 1 - nwin);
                kreg = *(const u32x4*)(KB + (size_t)(tk + lrow) * 256 + kvh * 64 + lch * 8); vreg = *(const u32x4*)(VT + (size_t)(kvh * 64 + lrow) * KROWS + tk + lch * 8); }
            f32x4 s[4];
#pragma unroll
            for (int kt = 0; kt < 4; ++kt) {
                const bf16x8 a0 = *(const LAS bf16x8*)(Kb + (16 * kt + r) * 144 + g4 * 16), a1 = *(const LAS bf16x8*)(Kb + (16 * kt + r) * 144 + 64 + g4 * 16);
                f32x4 z = {0.f, 0.f, 0.f, 0.f};
                z = __builtin_amdgcn_mfma_f32_16x16x32_bf16(a0, qb0, z, 0, 0, 0);
                s[kt] = __builtin_amdgcn_mfma_f32_16x16x32_bf16(a1, qb1, z, 0, 0, 0);
            }
            const bool masked = lat && (t < nwin);
            float mx = -3.0e38f;
#pragma unroll
            for (int kt = 0; kt < 4; ++kt)
#pragma unroll
                for (int i = 0; i < 4; ++i) { float x = s[kt][i] * SC;
                    if (masked) { const int dj = 64 * t + 16 * kt + 4 * g4 + i - iq; if (dj > 128 || dj < -128) x = -1.0e30f; }
                    s[kt][i] = x; mx = fmaxf(mx, x); }
            mx = fmaxf(mx, __shfl_xor(mx, 16)); mx = fmaxf(mx, __shfl_xor(mx, 32));
            const float mnew = fmaxf(m_run, mx), alpha = exp2f(m_run - mnew); m_run = mnew;
            float ls = 0.f;
#pragma unroll
            for (int kt = 0; kt < 4; ++kt)
#pragma unroll
                for (int i = 0; i < 4; ++i) { const float p = exp2f(s[kt][i] - mnew); s[kt][i] = p; ls += p; }
            l_run = l_run * alpha + ls;
#pragma unroll
            for (int dt = 0; dt < 4; ++dt) o[dt] *= alpha;
            u32x4 pw01, pw23;
            pw01.x = pk2(s[0][0], s[0][1]); pw01.y = pk2(s[0][2], s[0][3]); pw01.z = pk2(s[1][0], s[1][1]); pw01.w = pk2(s[1][2], s[1][3]);
            pw23.x = pk2(s[2][0], s[2][1]); pw23.y = pk2(s[2][2], s[2][3]); pw23.z = pk2(s[3][0], s[3][1]); pw23.w = pk2(s[3][2], s[3][3]);
            const bf16x8 pb01 = __builtin_bit_cast(bf16x8, pw01), pb23 = __builtin_bit_cast(bf16x8, pw23);
#pragma unroll
            for (int dt = 0; dt < 4; ++dt) {
                const LAS unsigned char* vr = Vb + (16 * dt + r) * 144 + g4 * 8;
                u32x4 va; const u32x2 l0 = *(const LAS u32x2*)(vr), h0 = *(const LAS u32x2*)(vr + 32), l1 = *(const LAS u32x2*)(vr + 64), h1 = *(const LAS u32x2*)(vr + 96);
                va.x = l0.x; va.y = l0.y; va.z = h0.x; va.w = h0.y;
                o[dt] = __builtin_amdgcn_mfma_f32_16x16x32_bf16(__builtin_bit_cast(bf16x8, va), pb01, o[dt], 0, 0, 0);
                va.x = l1.x; va.y = l1.y; va.z = h1.x; va.w = h1.y;
                o[dt] = __builtin_amdgcn_mfma_f32_16x16x32_bf16(__builtin_bit_cast(bf16x8, va), pb23, o[dt], 0, 0, 0);
            }
            if (t + 1 < ntile) { LAS unsigned char* Kn = lds + ((t + 1) & 1) * 18432; *(LAS u32x4*)(Kn + lrow * 144 + lch * 16) = kreg; *(LAS u32x4*)(Kn + 9216 + lrow * 144 + lch * 16) = vreg; }
            __syncthreads();
        }
        float l = l_run; l += __shfl_xor(l, 16); l += __shfl_xor(l, 32);
        const float inv = 1.f / l;
        bf16_t* op = OB + (size_t)(tok0 + 16 * wid + r) * D + h * 64 + 4 * g4;
#pragma unroll
        for (int dt = 0; dt < 4; ++dt) { u32x2 w; w.x = pk2(o[dt][0] * inv, o[dt][1] * inv); w.y = pk2(o[dt][2] * inv, o[dt][3] * inv); *(u32x2*)(op + 16 * dt) = w; }
    }
}

constexpr size_t WS_E = 232 * MiB;
struct SsmItem { int g, k, nchunk, seqX, tokX, tokY; bool lat; };
DI SsmItem ssm_item(int gw) {
    SsmItem it; it.g = gw & 63; const int pi = gw >> 6;
    if (pi < 16) { const int sp = pi >> 1; it.k = pi & 1; it.nchunk = 2; it.seqX = 2 * sp; it.tokX = 512 * sp + 128 * it.k; it.tokY = it.tokX + 256; it.lat = false; }
    else { it.k = pi - 16; it.nchunk = 16; it.seqX = 16; it.tokX = TCTX + 128 * it.k; it.tokY = it.tokX + LLAT; it.lat = true; }
    return it;
}
DI size_t ssm_eidx(int dir, int seq, int chunk, int g) { return ((((size_t)dir * 18 + seq) * 16 + chunk) * 64 + g) * 128; }

#define SSM_SCAN_STEP(i, WRITE_S) { const float nr0 = ar0 * sr0 - ai0 * si0 + acc[0][i], ni0 = ar0 * si0 + ai0 * sr0 + acc[2][i]; \
        const float nr1 = ar1 * sr1 - ai1 * si1 + acc[1][i], ni1 = ar1 * si1 + ai1 * sr1 + acc[3][i]; \
        sr0 = nr0; si0 = ni0; sr1 = nr1; si1 = ni1; \
        if (WRITE_S) { u32x2 w; w.x = pk2(nr0, ni0); w.y = pk2(nr1, ni1); *(LAS u32x2*)(S + (16 * h + (i)) * 272 + p * 8) = w; } }

DI void ssm_pass1(const Params& P) {
    const int tid = threadIdx.x, wid = tid >> 6, lane = tid & 63, p = lane & 31, h = lane >> 5;
    const int gw = wid * gridDim.x + blockIdx.x;
    if (gw >= 2048) return;
    const SsmItem it = ssm_item(gw);
    const bf16_t* HB = (const bf16_t*)(P.ws + WS_HB);
    float* E = (float*)(P.ws + WS_E);
    const int hh = (p >> 2) & 1, ii = 4 * (p >> 3) + (p & 3);
    const bf16_t* ubase = HB + (size_t)((hh ? it.tokY : it.tokX) + ii) * D + 16 * it.g + 8 * h;
    bf16x8 a[8];
#pragma unroll
    for (int t = 0; t < 8; ++t) a[t] = *(const bf16x8*)(ubase + (size_t)(16 * t) * D);
    LAS unsigned char* S = nullptr;
#pragma unroll
    for (int dir = 0; dir < 2; ++dir) {
        const int dg = dir * 64 + it.g;
        const float* ab = (const float*)(P.ws + WS_ABAR) + (size_t)dg * 128;
        const float ar0 = ab[2 * p], ai0 = ab[2 * p + 1], ar1 = ab[2 * (p + 32)], ai1 = ab[2 * (p + 32) + 1];
        bf16x8 bbq[4];
#pragma unroll
        for (int q = 0; q < 4; ++q) bbq[q] = *(const bf16x8*)((const bf16_t*)(P.ws + WS_BBM) + ((size_t)dg * 128 + q * 32 + p) * 16 + 8 * h);
        float sr0 = 0.f, si0 = 0.f, sr1 = 0.f, si1 = 0.f;
#pragma unroll
        for (int tt = 0; tt < 8; ++tt) {
            const int ti = dir ? 7 - tt : tt;
            f32x16 acc[4];
#pragma unroll
            for (int q = 0; q < 4; ++q) { f32x16 z;
#pragma unroll
                for (int i = 0; i < 16; ++i) z[i] = 0.f;
                acc[q] = __builtin_amdgcn_mfma_f32_32x32x16_bf16(a[ti], bbq[q], z, 0, 0, 0); }
            if (dir == 0) {
#pragma unroll
                for (int i = 0; i < 16; ++i) SSM_SCAN_STEP(i, false)
            } else {
#pragma unroll
                for (int i = 15; i >= 0; --i) SSM_SCAN_STEP(i, false)
            }
        }
        float* e = E + ssm_eidx(dir, it.seqX + h, it.k, it.g);
        e[p] = sr0; e[p + 32] = sr1; e[64 + p] = si0; e[64 + p + 32] = si1;
    }
}

template <int DIR>
DI void ssm_dir(const Params& P, const SsmItem& it, LAS unsigned char* S, const bf16x8 (&a)[8], f32x4 (&yacc)[8][2], int lane) {
    const int p = lane & 31, h = lane >> 5, c16 = lane & 15, g4 = lane >> 4;
    const int dg = DIR * 64 + it.g;
    const float* ab = (const float*)(P.ws + WS_ABAR) + (size_t)dg * 128;
    const float ar0 = ab[2 * p], ai0 = ab[2 * p + 1], ar1 = ab[2 * (p + 32)], ai1 = ab[2 * (p + 32) + 1];
    bf16x8 bbq[4], ccb[4];
#pragma unroll
    for (int q = 0; q < 4; ++q) bbq[q] = *(const bf16x8*)((const bf16_t*)(P.ws + WS_BBM) + ((size_t)dg * 128 + q * 32 + p) * 16 + 8 * h);
#pragma unroll
    for (int ks = 0; ks < 4; ++ks) ccb[ks] = *(const bf16x8*)((const bf16_t*)(P.ws + WS_CCM) + ((size_t)dg * 16 + c16) * 128 + 32 * ks + 8 * g4);
    float pr0 = ar0, pi0 = ai0, pr1 = ar1, pi1 = ai1;
#pragma unroll
    for (int q = 0; q < 7; ++q) { const float t0 = pr0 * pr0 - pi0 * pi0, t1 = 2.f * pr0 * pi0, t2 = pr1 * pr1 - pi1 * pi1, t3 = 2.f * pr1 * pi1; pr0 = t0; pi0 = t1; pr1 = t2; pi1 = t3; }
    float sr0 = 0.f, si0 = 0.f, sr1 = 0.f, si1 = 0.f;
    const int seq = it.seqX + h;
    if (it.lat) { const float* s0 = P.in[4] + ((size_t)(h * 2 + DIR) * 2) * 4096 + it.g * 64; sr0 = s0[p]; sr1 = s0[p + 32]; si0 = s0[4096 + p]; si1 = s0[4096 + p + 32]; }
    const float* E = (const float*)(P.ws + WS_E);
    const int nj = DIR ? (it.nchunk - 1 - it.k) : it.k;
    for (int jj = 0; jj < nj; ++jj) {
        const int j = DIR ? (it.nchunk - 1 - jj) : jj;
        const float* e = E + ssm_eidx(DIR, seq, j, it.g);
        const float er0 = e[p], er1 = e[p + 32], ei0 = e[64 + p], ei1 = e[64 + p + 32];
        const float n0 = pr0 * sr0 - pi0 * si0 + er0, m0 = pr0 * si0 + pi0 * sr0 + ei0, n1 = pr1 * sr1 - pi1 * si1 + er1, m1 = pr1 * si1 + pi1 * sr1 + ei1;
        sr0 = n0; si0 = m0; sr1 = n1; si1 = m1;
    }
    bf16_t* YB = (bf16_t*)(P.ws + WS_QB); const bf16_t* HB = (const bf16_t*)(P.ws + WS_HB);
    const float dsk = P.in[21][16 * it.g + c16];
#pragma unroll
    for (int tt = 0; tt < 8; ++tt) {
        const int ti = DIR ? 7 - tt : tt;
        f32x16 acc[4];
#pragma unroll
        for (int q = 0; q < 4; ++q) { f32x16 z;
#pragma unroll
            for (int i = 0; i < 16; ++i) z[i] = 0.f;
            acc[q] = __builtin_amdgcn_mfma_f32_32x32x16_bf16(a[ti], bbq[q], z, 0, 0, 0); }
        if (DIR == 0) {
#pragma unroll
            for (int i = 0; i < 16; ++i) SSM_SCAN_STEP(i, true)
        } else {
#pragma unroll
            for (int i = 15; i >= 0; --i) SSM_SCAN_STEP(i, true)
        }
        asm volatile("" ::: "memory");
#pragma unroll
        for (int mt = 0; mt < 2; ++mt) {
            f32x4 y = DIR ? yacc[ti][mt] : (f32x4){0.f, 0.f, 0.f, 0.f};
#pragma unroll
            for (int ks = 0; ks < 4; ++ks) { const bf16x8 sa = *(const LAS bf16x8*)(S + (16 * mt + c16) * 272 + 64 * ks + 16 * g4);
                y = __builtin_amdgcn_mfma_f32_16x16x32_bf16(sa, ccb[ks], y, 0, 0, 0); }
            if (DIR == 0) yacc[ti][mt] = y;
            else {
                const size_t base = (size_t)((mt ? it.tokY : it.tokX) + 16 * ti + 4 * g4) * D + 16 * it.g + c16;
#pragma unroll
                for (int i = 0; i < 4; ++i) { const float x = y[i] + dsk * bf2f(HB[base + (size_t)i * D]); const float z = 1.5957691216f * (x + 0.044715f * x * x * x);
                    YB[base + (size_t)i * D] = (bf16_t)(pk2(x / (1.f + __expf(-z)), 0.f) & 0xffffu); }
            }
        }
        asm volatile("" ::: "memory");
    }
    if (!it.lat && ((DIR == 0 && it.k == it.nchunk - 1) || (DIR == 1 && it.k == 0))) {
        float* so = P.out + OUT_S + ((size_t)seq * 2 + DIR) * 2 * 4096 + it.g * 64;
        so[p] = sr0; so[p + 32] = sr1; so[4096 + p] = si0; so[4096 + p + 32] = si1; }
}

DI void ssm_pass3(const Params& P, LAS unsigned char* lds) {
    const int tid = threadIdx.x, wid = tid >> 6, lane = tid & 63, p = lane & 31, h = lane >> 5;
    const int gw = wid * gridDim.x + blockIdx.x;
    if (gw >= 2048) return;
    const SsmItem it = ssm_item(gw);
    LAS unsigned char* S = lds + wid * 8704;
    const bf16_t* HB = (const bf16_t*)(P.ws + WS_HB);
    const int hh = (p >> 2) & 1, ii = 4 * (p >> 3) + (p & 3);
    const bf16_t* ubase = HB + (size_t)((hh ? it.tokY : it.tokX) + ii) * D + 16 * it.g + 8 * h;
    bf16x8 a[8];
#pragma unroll
    for (int t = 0; t < 8; ++t) a[t] = *(const bf16x8*)(ubase + (size_t)(16 * t) * D);
    f32x4 yacc[8][2];
    ssm_dir<0>(P, it, S, a, yacc, lane);
    ssm_dir<1>(P, it, S, a, yacc, lane);
}
#undef SSM_SCAN_STEP

#define XB_TMO      128
#define XB_XCNT(j)  (256  + 64 * (j))
#define XB_XSUB(j)  (1280 + 64 * (j))
#define XB_XGEN(j)  (2304 + 64 * (j))
#define XB_TOP      3328
#define XB_TOPGEN   3392
#define XCD_BAR_WORDS 3456
#define XB_SPIN_CAP (1u << 18)
DI unsigned xb_ld(unsigned* p)              { return __hip_atomic_load(p, __ATOMIC_RELAXED, __HIP_MEMORY_SCOPE_AGENT); }
DI unsigned xb_add(unsigned* p, unsigned v) { return __hip_atomic_fetch_add(p, v, __ATOMIC_RELAXED, __HIP_MEMORY_SCOPE_AGENT); }
DI unsigned xb_xcc_id() { return (unsigned)__builtin_amdgcn_s_getreg((3 << 11) | 20) & 0xFu; }
#define XB_SPIN(cond, bar) do { unsigned _sp = 0; while (cond) { __builtin_amdgcn_s_sleep(1); \
    if ((++_sp & 255u) == 0u) { if (xb_ld(&(bar)[XB_TMO])) break; if (_sp > XB_SPIN_CAP) { atomicAdd(&(bar)[XB_TMO], 1u); break; } } } } while (0)
struct XcdBarrier { unsigned* bar; unsigned x; volatile LAS unsigned* st; };
DI XcdBarrier xcd_barrier_post(unsigned* bar, volatile LAS unsigned* st) {
    XcdBarrier b; b.bar = bar; b.x = xb_xcc_id(); b.st = st;
    if (threadIdx.x == 0) (void)xb_add(&bar[XB_XCNT(b.x)], 1u);
    return b;
}
DI void xcd_barrier_complete(unsigned* bar, unsigned x, unsigned& nloc, unsigned& nx) {
    const unsigned G = gridDim.x * gridDim.y * gridDim.z;
    unsigned sum, cnt, mine, sp = 0u;
    for (;;) {
        sum = 0u; cnt = 0u; mine = 0u;
#pragma unroll
        for (unsigned j = 0; j < 16; ++j) { const unsigned c = xb_ld(&bar[XB_XCNT(j)]); sum += c; cnt += (c > 0u) ? 1u : 0u; mine = (j == x) ? c : mine; }
        if (sum == G) break;
        __builtin_amdgcn_s_sleep(1);
        if ((++sp & 255u) == 0u) { if (xb_ld(&bar[XB_TMO])) break; if (sp > XB_SPIN_CAP) { atomicAdd(&bar[XB_TMO], 1u); break; } }
    }
    nloc = mine > 0u ? mine : 1u; nx = cnt > 0u ? cnt : 1u;
}
DI void xcd_barrier(const XcdBarrier& b) {
    asm volatile("s_waitcnt vmcnt(0)" ::: "memory");
    __syncthreads();
    if (threadIdx.x == 0) {
        unsigned* bar = b.bar;
        __builtin_amdgcn_s_waitcnt(0);
        unsigned nloc = b.st[0], nx = b.st[1];
        if (nloc == 0u) { xcd_barrier_complete(bar, b.x, nloc, nx); b.st[0] = nloc; b.st[1] = nx; }
        const unsigned old = xb_add(&bar[XB_XSUB(b.x)], 1u);
        const unsigned gen = old / nloc;
        if (old + 1u == (gen + 1u) * nloc) {
            __builtin_amdgcn_fence(__ATOMIC_RELEASE, "agent");
            asm volatile("s_waitcnt vmcnt(0)" ::: "memory");
            const unsigned og = xb_add(&bar[XB_TOP], 1u);
            const unsigned tg = og / nx;
            if (og + 1u == (tg + 1u) * nx) xb_add(&bar[XB_TOPGEN], 1u);
            else XB_SPIN(xb_ld(&bar[XB_TOPGEN]) == tg, bar);
            __builtin_amdgcn_fence(__ATOMIC_ACQUIRE, "agent");
            xb_add(&bar[XB_XGEN(b.x)], 1u);
            asm volatile("s_waitcnt vmcnt(0)" ::: "memory");
        } else {
            XB_SPIN(xb_ld(&bar[XB_XGEN(b.x)]) == gen, bar);
            __builtin_amdgcn_fence(__ATOMIC_ACQUIRE, "agent");
            asm volatile("s_waitcnt vmcnt(0)" ::: "memory");
        }
    }
    __syncthreads();
}

constexpr int NPHASE = 16;
#ifndef REPMASK
#define REPMASK 0
#endif
#ifndef EXTRA_SYNCS
#define EXTRA_SYNCS 0
#endif
constexpr int LDS_BYTES = 147456;
__global__ void __launch_bounds__(512, 2) fwd_kernel(Params P) {
    extern __shared__ __attribute__((aligned(16))) unsigned char lds_raw[];
    LAS unsigned char* lds = (LAS unsigned char*)lds_raw;
    cg::grid_group grid = cg::this_grid();
    unsigned char* ws = P.ws;
    const float* MOD = (const float*)(ws + WS_MOD);
    const int lo = P.ph_lo, hi = P.ph_hi, G = gridDim.x;
    volatile LAS unsigned* MISC = (volatile LAS unsigned*)(lds + 131072);
    if (threadIdx.x < 64) MISC[threadIdx.x] = 0u;
    __syncthreads();
    XcdBarrier bar = xcd_barrier_post((unsigned*)ws, MISC + 8);
    if (hi < 0) grid.sync();
#define IN(k) (lo <= (k) && (k) < hi)
#define SYNC(k) do { if (IN(k) && IN((k) + 1)) { xcd_barrier(bar); } } while (0)
#define PHASE(k, ...) do { if (IN(k)) { __VA_ARGS__; if ((REPMASK >> (k)) & 1) { xcd_barrier(bar); __VA_ARGS__; } } SYNC(k); } while (0)
#define GEMM_QKV { pg8::Gemm g{(const bf16_t*)(ws + WS_HB), (const bf16_t*)(ws + WS_WQKV), D, D}; pg8::StaticOrder S; S.init(T, NQKV, 1, G, blockIdx.x); \
        pg8::EpiQkv E{(bf16_t*)(ws + WS_QB), (bf16_t*)(ws + WS_KB), (bf16_t*)(ws + WS_VT), P.out + OUT_K, P.out + OUT_V, (const float*)(ws + WS_ROPE), (const float*)(ws + WS_ROPE) + 2048 * 32}; \
        pg8::gemm_phase(lds, g, S, E); }
#define GEMM_WO { pg8::Gemm g{(const bf16_t*)(ws + WS_OB), (const bf16_t*)(ws + WS_WO), D, D / 2}; pg8::StaticOrder S; S.init(T, D, 2, G, blockIdx.x); \
        pg8::EpiResid E{P.in[0], P.in[1] - (size_t)TCTX * D, (float*)(ws + WS_X), (float*)(ws + WS_P1), MOD + 2048}; \
        pg8::gemm_phase(lds, g, S, E); }
#define GEMM_MLP1(l) { pg8::Gemm g{(const bf16_t*)(ws + WS_HB), (const bf16_t*)(ws + WS_W1) + (size_t)(l) * D * FF, D, D}; pg8::StaticOrder S; S.init(T, FF, 1, G, blockIdx.x); \
        pg8::EpiRelu2 E{(bf16_t*)(ws + WS_AB), FF}; pg8::gemm_phase(lds, g, S, E); }
#define GEMM_MLP2(l) { pg8::Gemm g{(const bf16_t*)(ws + WS_AB), (const bf16_t*)(ws + WS_W2) + (size_t)(l) * D * FF, FF, FF / 2}; pg8::StaticOrder S; S.init(T, D, 2, G, blockIdx.x); \
        pg8::EpiResid E{(const float*)(ws + WS_X), (const float*)(ws + WS_X), (float*)(ws + WS_X), (float*)(ws + WS_P1), MOD + (l) * 3 * 6144 + 5120}; \
        pg8::gemm_phase(lds, g, S, E); }
#define GEMM_GLU { pg8::Gemm g{(const bf16_t*)(ws + WS_QB), (const bf16_t*)(ws + WS_WGLU), D, D}; pg8::StaticOrder S; S.init(T, 2 * D, 1, G, blockIdx.x); \
        pg8::EpiGlu E{(float*)(ws + WS_X), MOD + 3 * 6144 + 2048}; pg8::gemm_phase(lds, g, S, E); }
    PHASE(0, prep_phase(P, lds));
    for (int x = 0; x < EXTRA_SYNCS; ++x) xcd_barrier(bar);
    PHASE(1, norm_phase<0>(P, P.in[7], MOD, 0, 1024));
    PHASE(2, GEMM_QKV);
    PHASE(3, attn_phase(P, lds));
    PHASE(4, GEMM_WO);
    PHASE(5, norm_phase<2>(P, P.in[8], MOD, 3072, 4096));
    PHASE(6, GEMM_MLP1(0));
    PHASE(7, GEMM_MLP2(0));
    PHASE(8, norm_phase<2>(P, P.in[7] + D, MOD + 3 * 6144, 0, 1024));
    PHASE(9, ssm_pass1(P));
    PHASE(10, ssm_pass3(P, lds));
    PHASE(11, GEMM_GLU);
    PHASE(12, norm_phase<1>(P, P.in[8] + D, MOD + 3 * 6144, 3072, 4096));
    PHASE(13, GEMM_MLP1(1));
    PHASE(14, GEMM_MLP2(1));
    PHASE(15, norm_phase<3>(P, P.in[26], MOD, 0, 0));
#undef IN
}

#ifndef MK_MULTI
#define MK_MULTI 0
#endif
extern "C" void kernel_launch(void* const* d_in, const int* in_sizes, int n_in, void* d_out, int out_size, void* d_ws, size_t ws_size, hipStream_t stream) {
    static int grid = 0;
    if (grid == 0) {
        int dev = 0, cus = 0, per_cu = 0;
        hipGetDevice(&dev);
        hipDeviceGetAttribute(&cus, hipDeviceAttributeMultiprocessorCount, dev);
        hipFuncSetAttribute((const void*)fwd_kernel, hipFuncAttributeMaxDynamicSharedMemorySize, LDS_BYTES);
        hipOccupancyMaxActiveBlocksPerMultiprocessor(&per_cu, (const void*)fwd_kernel, 512, LDS_BYTES);
        if (per_cu < 1) { fprintf(stderr, "occupancy query gave %d\n", per_cu); per_cu = 1; }
        if (per_cu > 1) per_cu = 1;
        grid = cus * per_cu;
        if (grid > 256) grid = 256;
    }
    (void)hipMemsetAsync(d_ws, 0, 16384, stream);
    Params p{};
    for (int i = 0; i < 27; ++i) p.in[i] = (const float*)d_in[i];
    p.out = (float*)d_out; p.ws = (unsigned char*)d_ws;
#if MK_MULTI
    for (int k = 0; k < NPHASE; ++k) { p.ph_lo = k; p.ph_hi = k + 1; hipLaunchKernelGGL(fwd_kernel, dim3(grid), dim3(512), LDS_BYTES, stream, p); }
#else
    p.ph_lo = 0; p.ph_hi = NPHASE;
    void* args[] = {&p};
    hipError_t e = hipLaunchCooperativeKernel((const void*)fwd_kernel, dim3(grid), dim3(512), args, LDS_BYTES, stream);
    if (e != hipSuccess) fprintf(stderr, "cooperative launch failed: %s (grid %d)\n", hipGetErrorString(e), grid);
#endif
}
```

```cpp
#include <hip/hip_runtime.h>
#include <hip/hip_cooperative_groups.h>
#include <cstdio>
#include <cstdint>
namespace cg = cooperative_groups;

#define LAS __attribute__((address_space(3)))
typedef unsigned short bf16_t;
typedef short bf16x8 __attribute__((ext_vector_type(8)));
typedef float f32x4 __attribute__((ext_vector_type(4)));
typedef float f32x16 __attribute__((ext_vector_type(16)));
typedef float f32x2 __attribute__((ext_vector_type(2)));
typedef unsigned u32x4 __attribute__((ext_vector_type(4)));
typedef unsigned u32x2 __attribute__((ext_vector_type(2)));
typedef __bf16 bf16x2v __attribute__((ext_vector_type(2)));
#define DI __device__ __forceinline__

DI unsigned pk2(float a, float b) { f32x2 v = {a, b}; bf16x2v r = __builtin_convertvector(v, bf16x2v); return __builtin_bit_cast(unsigned, r); }
DI float bf2f(unsigned short u) { return __builtin_bit_cast(float, (unsigned)u << 16); }
DI float wave_sum(float v) {
#pragma unroll
    for (int o = 1; o < 64; o <<= 1) v += __shfl_xor(v, o);
    return v;
}

constexpr int T = 8192, D = 1024, FF = 4096, NQKV = 1536, TCTX = 4096, LLAT = 2048;
constexpr int KROWS = 8704;
constexpr size_t MiB = 1u << 20;
constexpr size_t WS_MOD = 1 * MiB;
constexpr size_t WS_ABAR = 2 * MiB;
constexpr size_t WS_BBM = 2 * MiB + 128 * 1024;
constexpr size_t WS_CCM = 2 * MiB + 640 * 1024;
constexpr size_t WS_ROPE = 3 * MiB + 256 * 1024;
constexpr size_t WS_WQKV = 4 * MiB, WS_WO = 7 * MiB, WS_WGLU = 9 * MiB, WS_W1 = 13 * MiB, WS_W2 = 29 * MiB;
constexpr size_t WS_KB = 45 * MiB, WS_VT = 50 * MiB;
constexpr size_t WS_HB = 56 * MiB, WS_QB = 72 * MiB, WS_OB = 88 * MiB, WS_X = 104 * MiB, WS_P1 = 136 * MiB, WS_AB = 168 * MiB;
constexpr size_t WS_YP = 168 * MiB;
constexpr int OUT_K = 8388608, OUT_V = 8388608 + 1048576, OUT_S = 8388608 + 2 * 1048576;

struct Params { const float* in[27]; float* out; unsigned char* ws; int ph_lo, ph_hi; };

namespace pg8 {
constexpr int BM = 256, BK = 64, HALF = 128, HTB = HALF * BK * 2, STAGE_BYTES = 8 * HTB, NXCD = 8, WGM = 8;
__host__ __device__ __forceinline__ int lds_byte(int r, int c) { const int st = (r >> 4) * 2 + (c >> 5), rr = r & 15, cc = c & 31, ob = rr * 64 + cc * 2; return st * 1024 + (ob ^ (((ob >> 9) & 1) << 5)); }
__host__ __device__ __forceinline__ void stage_rc(int b, int& R, int& C) { const int st = b / 1024, sb = b % 1024, swz = sb ^ (((sb >> 9) & 1) << 5); R = (st >> 1) * 16 + swz / 64; C = (st & 1) * 32 + (swz % 64) / 2; }
__host__ __device__ __forceinline__ int perm32(int rho) { const int n = rho >> 4, i = rho & 15; return 8 * (i >> 2) + 4 * n + (i & 3); }

struct Unit { int pm, pn, ks; };
struct Gemm { const bf16_t* A; const bf16_t* Bt; int ld, Kloop; };

struct StaticOrder {
    int nM, nN, nNv, nwg, G, c;
    __device__ void init(int M, int N, int split, int G_, int c_) { nM = M / BM; nN = N / BM; nNv = nN * split; nwg = nM * nNv; G = G_; c = c_; }
    __device__ bool next(int i, Unit& u) const {
        const long L = (long)i * G + c; if (L >= nwg) return false;
        int wgid = (int)L; { const int q = nwg / NXCD, r = nwg % NXCD, xcd = wgid % NXCD, off = wgid / NXCD; wgid = (xcd < r ? xcd * (q + 1) : r * (q + 1) + (xcd - r) * q) + off; }
        const int nig = WGM * nNv, gid = wgid / nig, fm = gid * WGM, gsz = (nM - fm) < WGM ? (nM - fm) : WGM;
        u.pm = fm + ((wgid % nig) % gsz); const int pv = (wgid % nig) / gsz; u.pn = pv % nN; u.ks = pv / nN; return true;
    }
};

template <class Epi>
__device__ __forceinline__ void gemm_phase(LAS unsigned char* lds, const Gemm g, const StaticOrder& S, const Epi& E) {
    const int tid = threadIdx.x, wid = __builtin_amdgcn_readfirstlane(tid >> 6), lane = tid & 63, wr = wid >> 2, wc = wid & 3, fr = lane & 15, fq = lane >> 4;
    const int ld = g.ld, nt = g.Kloop / BK;
    unsigned voffA[2], voffB[2];
#pragma unroll
    for (int i = 0; i < 2; ++i) { int R, C; stage_rc(tid * 16 + i * 8192, R, C); const int Rb = Epi::PERM ? ((R & ~31) + perm32(R & 31)) : R;
        voffA[i] = (unsigned)(R * ld + C) * 2u; voffB[i] = (unsigned)(Rb * ld + C) * 2u; }
    const size_t kstep = (size_t)(BK * 2);
    const size_t hstep = (size_t)HALF * ld * 2;
    const size_t tstep = 2 * hstep;
    const size_t kso = (size_t)g.Kloop * 2;
    const unsigned ldsw = (unsigned)wid * 1024u;
    const int aoff = lds_byte(wr * 64 + fr, fq * 8), boff = lds_byte(wc * 32 + fr, fq * 8);
#define PG8_SA(b, h) (((b) * 2 + (h)) * HTB)
#define PG8_SB(b, h) ((4 + (b) * 2 + (h)) * HTB)
#define PG8_STAGE(bufoff, gbase, voff) do { _Pragma("unroll") for (int _i = 0; _i < 2; ++_i) \
        __builtin_amdgcn_global_load_lds((const unsigned*)((const char*)(gbase) + (voff)[_i]), (LAS unsigned*)(lds + (bufoff) + ldsw + _i * 8192), 16, 0, 0); } while (0)
#define PG8_LDA(dst, b, h) do { _Pragma("unroll") for (int m = 0; m < 4; ++m) _Pragma("unroll") for (int k = 0; k < 2; ++k) dst[m][k] = *(const LAS bf16x8*)(lds + PG8_SA(b, h) + aoff + m * 2048 + k * 1024); } while (0)
#define PG8_LDB(dst, b, h) do { _Pragma("unroll") for (int n = 0; n < 2; ++n) _Pragma("unroll") for (int k = 0; k < 2; ++k) dst[n][k] = *(const LAS bf16x8*)(lds + PG8_SB(b, h) + boff + n * 2048 + k * 1024); } while (0)
#define PG8_MMA(ai, bj, At, Bt) do { __builtin_amdgcn_s_setprio(1); _Pragma("unroll") for (int m = 0; m < 4; ++m) _Pragma("unroll") for (int n = 0; n < 2; ++n) _Pragma("unroll") for (int k = 0; k < 2; ++k) \
        acc[ai][bj][m][n] = __builtin_amdgcn_mfma_f32_16x16x32_bf16(Bt[n][k], At[m][k], acc[ai][bj][m][n], 0, 0, 0); __builtin_amdgcn_s_setprio(0); } while (0)
#define PG8_WAIT_V(n) asm volatile("s_waitcnt vmcnt(" #n ")" ::: "memory")
#define PG8_WAIT_L(n) asm volatile("s_waitcnt lgkmcnt(" #n ")" ::: "memory")
#define PG8_BAR __builtin_amdgcn_s_barrier()
#define PG8_SCHED __builtin_amdgcn_sched_barrier(0)
#define PG8_UA(u) ((const char*)g.A + (size_t)(u).pm * tstep + (size_t)(u).ks * kso)
#define PG8_UB(u) ((const char*)g.Bt + (size_t)(u).pn * tstep + (size_t)(u).ks * kso)
    Unit cur, nxt; int ui = 0;
    if (!S.next(0, cur)) return;
    f32x4 acc[2][2][4][2];
#pragma unroll
    for (int a = 0; a < 2; ++a)
#pragma unroll
        for (int b = 0; b < 2; ++b)
#pragma unroll
            for (int m = 0; m < 4; ++m)
#pragma unroll
                for (int n = 0; n < 2; ++n) acc[a][b][m][n] = (f32x4){0.f, 0.f, 0.f, 0.f};
    bf16x8 At[4][2], B0[2][2], B1[2][2];
    const char* cA = PG8_UA(cur); const char* cB = PG8_UB(cur);
    PG8_STAGE(PG8_SB(0, 0), cB, voffB); PG8_STAGE(PG8_SB(0, 1), cB + hstep, voffB); PG8_STAGE(PG8_SA(0, 0), cA, voffA); PG8_STAGE(PG8_SA(0, 1), cA + hstep, voffA);
    if (wr == 1) PG8_BAR;
    PG8_WAIT_V(2); PG8_BAR;
    PG8_STAGE(PG8_SB(1, 0), cB + kstep, voffB); PG8_STAGE(PG8_SA(1, 0), cA + kstep, voffA); PG8_STAGE(PG8_SB(1, 1), cB + hstep + kstep, voffB);
    PG8_WAIT_V(6); PG8_BAR;
    for (;;) {
        const bool has_next = S.next(ui + 1, nxt);
        const char* nA = has_next ? PG8_UA(nxt) : cA; const char* nB = has_next ? PG8_UB(nxt) : cB;
        for (int t = 0; t < nt; t += 2) {
            const bool last = (t == nt - 2);
            const char* a1 = cA + (size_t)(t + 1) * kstep;
            const char* a2 = last ? nA : cA + (size_t)(t + 2) * kstep; const char* b2 = last ? nB : cB + (size_t)(t + 2) * kstep;
            const char* a3 = a2 + kstep; const char* b3 = b2 + kstep;
            PG8_LDB(B0, 0, 0); PG8_LDB(B1, 0, 1); PG8_SCHED; PG8_LDA(At, 0, 0); PG8_STAGE(PG8_SA(1, 1), a1 + hstep, voffA);
            PG8_WAIT_V(8); PG8_WAIT_L(0); PG8_BAR; PG8_MMA(0, 0, At, B0); PG8_MMA(0, 1, At, B1); PG8_BAR; PG8_SCHED;
            PG8_LDA(At, 0, 1); PG8_STAGE(PG8_SB(0, 0), b2, voffB); PG8_STAGE(PG8_SB(0, 1), b2 + hstep, voffB); PG8_STAGE(PG8_SA(0, 0), a2, voffA);
            PG8_WAIT_V(8); PG8_WAIT_L(0); PG8_BAR; PG8_MMA(1, 0, At, B0); PG8_MMA(1, 1, At, B1); PG8_BAR; PG8_SCHED;
            PG8_LDB(B0, 1, 0); PG8_LDB(B1, 1, 1); PG8_SCHED; PG8_LDA(At, 1, 0); PG8_STAGE(PG8_SA(0, 1), a2 + hstep, voffA);
            PG8_WAIT_V(8); PG8_WAIT_L(0); PG8_BAR; PG8_MMA(0, 0, At, B0); PG8_MMA(0, 1, At, B1); PG8_BAR; PG8_SCHED;
            PG8_LDA(At, 1, 1); PG8_STAGE(PG8_SB(1, 0), b3, voffB); PG8_STAGE(PG8_SB(1, 1), b3 + hstep, voffB); PG8_STAGE(PG8_SA(1, 0), a3, voffA);
            PG8_WAIT_V(8); PG8_WAIT_L(0); PG8_BAR; PG8_MMA(1, 0, At, B0); PG8_MMA(1, 1, At, B1); PG8_BAR; PG8_SCHED;
        }
        if (wr == 0) PG8_BAR;
        E(acc, cur, wr, wc, fr, fq);
        if (!has_next) break;
#pragma unroll
        for (int a = 0; a < 2; ++a)
#pragma unroll
            for (int b = 0; b < 2; ++b)
#pragma unroll
                for (int m = 0; m < 4; ++m)
#pragma unroll
                    for (int n = 0; n < 2; ++n) acc[a][b][m][n] = (f32x4){0.f, 0.f, 0.f, 0.f};
        cur = nxt; cA = nA; cB = nB; ++ui;
        if (wr == 1) PG8_BAR;
    }
    PG8_WAIT_V(0);
    PG8_BAR;
#undef PG8_SA
#undef PG8_SB
#undef PG8_STAGE
#undef PG8_LDA
#undef PG8_LDB
#undef PG8_MMA
#undef PG8_WAIT_V
#undef PG8_WAIT_L
#undef PG8_BAR
#undef PG8_SCHED
#undef PG8_UA
#undef PG8_UB
}

struct EpiRelu2 {
    static constexpr bool PERM = true;
    bf16_t* O; int ldc;
    __device__ __forceinline__ void operator()(const f32x4 (&acc)[2][2][4][2], const Unit& u, int wr, int wc, int fr, int fq) const {
        const int row0 = u.pm * BM + wr * 64 + fr, col0 = u.pn * BM + wc * 32 + 8 * fq;
#pragma unroll
        for (int ai = 0; ai < 2; ++ai)
#pragma unroll
            for (int m = 0; m < 4; ++m) { bf16_t* rowp = O + (size_t)(row0 + ai * HALF + m * 16) * ldc + col0;
#pragma unroll
                for (int bj = 0; bj < 2; ++bj) { f32x4 v0 = acc[ai][bj][m][0], v1 = acc[ai][bj][m][1];
#pragma unroll
                    for (int j = 0; j < 4; ++j) { const float a = fmaxf(v0[j], 0.f), b = fmaxf(v1[j], 0.f); v0[j] = a * a; v1[j] = b * b; }
                    u32x4 w; w.x = pk2(v0[0], v0[1]); w.y = pk2(v0[2], v0[3]); w.z = pk2(v1[0], v1[1]); w.w = pk2(v1[2], v1[3]);
                    *(u32x4*)(rowp + bj * HALF) = w; } }
    }
};
struct EpiResid {
    static constexpr bool PERM = true;
    const float* res0; const float* res1; float* X; float* P1; const float* gate;
    __device__ __forceinline__ void operator()(const f32x4 (&acc)[2][2][4][2], const Unit& u, int wr, int wc, int fr, int fq) const {
        const int vec = u.pm < 16 ? 0 : (u.pm < 24 ? 1 : 2);
        const float* gv_ = gate + vec * 6144; const float* rs = u.pm < 16 ? res0 : res1;
        const int col0 = u.pn * BM + wc * 32 + 8 * fq;
        f32x4 gv[2][2];
#pragma unroll
        for (int bj = 0; bj < 2; ++bj)
#pragma unroll
            for (int n = 0; n < 2; ++n) gv[bj][n] = *(const f32x4*)(gv_ + col0 + bj * HALF + n * 4);
#pragma unroll
        for (int ai = 0; ai < 2; ++ai)
#pragma unroll
            for (int m = 0; m < 4; ++m) { const size_t off = (size_t)(u.pm * BM + ai * HALF + wr * 64 + m * 16 + fr) * D + col0;
#pragma unroll
                for (int bj = 0; bj < 2; ++bj)
#pragma unroll
                    for (int n = 0; n < 2; ++n) { f32x4 o = gv[bj][n] * acc[ai][bj][m][n]; const size_t e = off + bj * HALF + n * 4;
                        if (u.ks == 0) { o += *(const f32x4*)(rs + e); *(f32x4*)(X + e) = o; } else { *(f32x4*)(P1 + e) = o; } } }
    }
};
struct EpiGlu {
    static constexpr bool PERM = true;
    float* X; const float* gate;
    __device__ __forceinline__ void operator()(const f32x4 (&acc)[2][2][4][2], const Unit& u, int wr, int wc, int fr, int fq) const {
        const int vec = u.pm < 16 ? 0 : (u.pm < 24 ? 1 : 2);
        const float* gv_ = gate + vec * 6144;
        const int col0 = u.pn * HALF + wc * 32 + 8 * fq;
        f32x4 gv[2];
#pragma unroll
        for (int n = 0; n < 2; ++n) gv[n] = *(const f32x4*)(gv_ + col0 + n * 4);
#pragma unroll
        for (int ai = 0; ai < 2; ++ai)
#pragma unroll
            for (int m = 0; m < 4; ++m) { const size_t off = (size_t)(u.pm * BM + ai * HALF + wr * 64 + m * 16 + fr) * D + col0;
#pragma unroll
                for (int n = 0; n < 2; ++n) { const f32x4 a = acc[ai][0][m][n], b = acc[ai][1][m][n]; f32x4 o;
#pragma unroll
                    for (int j = 0; j < 4; ++j) o[j] = a[j] / (1.f + __expf(-b[j]));
                    const size_t e = off + n * 4; *(f32x4*)(X + e) = *(const f32x4*)(X + e) + gv[n] * o; } }
    }
};
struct EpiQkv {
    static constexpr bool PERM = false;
    bf16_t* QB; bf16_t* KB; bf16_t* VT; float* outK; float* outV; const float* ropec; const float* ropes;
    __device__ __forceinline__ void operator()(const f32x4 (&acc)[2][2][4][2], const Unit& u, int wr, int wc, int fr, int fq) const {
        const bool lat = u.pm >= 16;
#pragma unroll
        for (int ai = 0; ai < 2; ++ai)
#pragma unroll
            for (int m = 0; m < 4; ++m) {
                const int row = u.pm * BM + ai * HALF + wr * 64 + m * 16 + fr;
                f32x4 cs = {1.f, 1.f, 1.f, 1.f}, sn = {0.f, 0.f, 0.f, 0.f};
                if (lat && u.pn < 5) { const int tp = row & 2047; cs = *(const f32x4*)(ropec + tp * 32 + (wc & 1) * 16 + 4 * fq); sn = *(const f32x4*)(ropes + tp * 32 + (wc & 1) * 16 + 4 * fq); }
#pragma unroll
                for (int bj = 0; bj < 2; ++bj) {
                    f32x4 x1 = acc[ai][bj][m][0], x2 = acc[ai][bj][m][1];
                    const int cl = bj * HALF + wc * 32 + 4 * fq;
                    if (u.pn < 5) {
                        f32x4 y1 = x1 * cs - x2 * sn, y2 = x1 * sn + x2 * cs;
                        if (u.pn < 4) { y1 = y1 * (0.125f * 1.44269504089f); y2 = y2 * (0.125f * 1.44269504089f); }
                        bf16_t* dst = (u.pn < 4) ? (QB + (size_t)row * D + u.pn * BM + cl) : (KB + (size_t)row * 256 + cl);
                        u32x2 w1, w2; w1.x = pk2(y1[0], y1[1]); w1.y = pk2(y1[2], y1[3]); w2.x = pk2(y2[0], y2[1]); w2.y = pk2(y2[2], y2[3]);
                        *(u32x2*)dst = w1; *(u32x2*)(dst + 16) = w2;
                        if (u.pn == 4 && !lat) { *(f32x4*)(outK + (size_t)row * 256 + cl) = x1; *(f32x4*)(outK + (size_t)row * 256 + cl + 16) = x2; }
                    } else {
#pragma unroll
                        for (int j = 0; j < 4; ++j) { VT[(size_t)(cl + j) * KROWS + row] = (bf16_t)(pk2(x1[j], 0.f) & 0xffffu); VT[(size_t)(cl + 16 + j) * KROWS + row] = (bf16_t)(pk2(x2[j], 0.f) & 0xffffu); }
                        if (!lat) { *(f32x4*)(outV + (size_t)row * 256 + cl) = x1; *(f32x4*)(outV + (size_t)row * 256 + cl + 16) = x2; }
                    }
                }
            }
    }
};
}

DI void transpose_item(const float* W, int K, int N, bf16_t* WT, int k0, int n0, int drow0, LAS float* scr, int lane) {
#pragma unroll 8
    for (int i = 0; i < 32; ++i) { const int kk = 2 * i + (lane >> 5); scr[kk * 33 + (lane & 31)] = W[(size_t)(k0 + kk) * N + n0 + (lane & 31)]; }
    asm volatile("" ::: "memory");
    const int c = lane & 7;
#pragma unroll
    for (int j = 0; j < 4; ++j) { const int n = (lane >> 3) + 8 * j; const LAS float* s = scr + (8 * c) * 33 + n;
        u32x4 o; o.x = pk2(s[0 * 33], s[1 * 33]); o.y = pk2(s[2 * 33], s[3 * 33]); o.z = pk2(s[4 * 33], s[5 * 33]); o.w = pk2(s[6 * 33], s[7 * 33]);
        *(u32x4*)(WT + (size_t)(drow0 + n) * K + k0 + 8 * c) = o; }
    asm volatile("" ::: "memory");
}
DI void transpose_mat(const float* W, int K, int N, bf16_t* WT, int item, LAS float* scr, int lane, int glu  ) {
    const int nblk = N / 32, kb = item / nblk, nb = item % nblk, n0 = 32 * nb;
    int drow0 = n0;
    if (glu) drow0 = 256 * (n0 >> 7) + (n0 & 127) + (glu == 2 ? 128 : 0);
    transpose_item(W, K, N, WT, 64 * kb, n0, drow0, scr, lane);
}

DI void prep_phase(const Params& P, LAS unsigned char* lds) {
    const int tid = threadIdx.x, wid = tid >> 6, lane = tid & 63, G = gridDim.x, bid = blockIdx.x;
    unsigned char* ws = P.ws;
    if (bid < 192) {
        LAS float* sl = (LAS float*)lds;
        LAS float* red = (LAS float*)(lds + 12288);
        for (int e = tid; e < 3072; e += 512) { const int v = e >> 10, k = e & 1023; const float x = (v == 0) ? P.in[6][k] : P.in[5][(v - 1) * 1024 + k]; sl[e] = x / (1.f + __expf(-x)); }
        __syncthreads();
        const int l = bid / 96, n0 = (bid % 96) * 64, cq = lane & 15, kr = lane >> 4;
        const float* wm = P.in[9] + (size_t)l * 1024 * 6144 + n0 + 4 * cq;
        f32x4 a0 = {0.f, 0.f, 0.f, 0.f}, a1 = a0, a2 = a0;
#pragma unroll 8
        for (int i = 0; i < 32; ++i) { const int k = 128 * wid + 4 * i + kr; const f32x4 w = *(const f32x4*)(wm + (size_t)k * 6144);
            a0 += w * sl[k]; a1 += w * sl[1024 + k]; a2 += w * sl[2048 + k]; }
#pragma unroll
        for (int j = 0; j < 4; ++j) { a0[j] += __shfl_xor(a0[j], 16); a0[j] += __shfl_xor(a0[j], 32); a1[j] += __shfl_xor(a1[j], 16); a1[j] += __shfl_xor(a1[j], 32); a2[j] += __shfl_xor(a2[j], 16); a2[j] += __shfl_xor(a2[j], 32); }
        if (kr == 0) { *(LAS f32x4*)(red + (wid * 3 + 0) * 64 + 4 * cq) = a0; *(LAS f32x4*)(red + (wid * 3 + 1) * 64 + 4 * cq) = a1; *(LAS f32x4*)(red + (wid * 3 + 2) * 64 + 4 * cq) = a2; }
        __syncthreads();
        if (tid < 192) { const int v = tid >> 6, cc = tid & 63; float s = P.in[10][l * 6144 + n0 + cc];
#pragma unroll
            for (int w = 0; w < 8; ++w) s += red[(w * 3 + v) * 64 + cc];
            ((float*)(ws + WS_MOD))[(l * 3 + v) * 6144 + n0 + cc] = s; }
    }
    {
        LAS float* scr = (LAS float*)(lds + 32768 + wid * 8704);
        const int gw = bid * 8 + wid, NGW = G * 8;
        constexpr int I_QKV = 16 * 48, I_O = 16 * 32, I_G = 16 * 32, I_1 = 16 * 128, I_2 = 64 * 32;
        constexpr int NIT = I_QKV + I_O + 2 * I_G + 2 * I_1 + 2 * I_2;
        for (int it = gw; it < NIT; it += NGW) {
            int r = it;
            if (r < I_QKV) { transpose_mat(P.in[11], 1024, 1536, (bf16_t*)(ws + WS_WQKV), r, scr, lane, 0); continue; } r -= I_QKV;
            if (r < I_O) { transpose_mat(P.in[12], 1024, 1024, (bf16_t*)(ws + WS_WO), r, scr, lane, 0); continue; } r -= I_O;
            if (r < I_G) { transpose_mat(P.in[22], 1024, 1024, (bf16_t*)(ws + WS_WGLU), r, scr, lane, 1); continue; } r -= I_G;
            if (r < I_G) { transpose_mat(P.in[23], 1024, 1024, (bf16_t*)(ws + WS_WGLU), r, scr, lane, 2); continue; } r -= I_G;
            if (r < 2 * I_1) { const int l = r / I_1; transpose_mat(P.in[24] + (size_t)l * D * FF, 1024, 4096, (bf16_t*)(ws + WS_W1) + (size_t)l * D * FF, r % I_1, scr, lane, 0); continue; } r -= 2 * I_1;
            { const int l = r / I_2; transpose_mat(P.in[25] + (size_t)l * D * FF, 4096, 1024, (bf16_t*)(ws + WS_W2) + (size_t)l * D * FF, r % I_2, scr, lane, 0); }
        }
    }
    const int gt = bid * 512 + tid, NGT = G * 512;
    for (int e = gt; e < 2 * 256 * 256; e += NGT) {
        const int tok = e >> 8, c = e & 255;
        ((bf16_t*)(ws + WS_KB))[(size_t)(T + tok) * 256 + c] = (bf16_t)(pk2(P.in[2][e], 0.f) & 0xffffu);
    }
    for (int e = gt; e < 2 * 256 * 256; e += NGT) {
        const int c = e >> 9, tok = e & 511;
        ((bf16_t*)(ws + WS_VT))[(size_t)c * KROWS + T + tok] = (bf16_t)(pk2(P.in[3][tok * 256 + c], 0.f) & 0xffffu);
    }
    for (int e = gt; e < 2048 * 32; e += NGT) {
        const int tp = e >> 5, k = e & 31, f = k & 15; const float pos = (k >> 4) ? (float)(tp & 63) : (float)(tp >> 6);
        const float freq = powf(10000.f, -(float)f / 16.f); const float ang = pos * freq;
        ((float*)(ws + WS_ROPE))[e] = cosf(ang); ((float*)(ws + WS_ROPE))[2048 * 32 + e] = sinf(ang);
    }
    for (int e = gt; e < 2 * 64 * 64; e += NGT) {
        const int dg = e >> 6, p = e & 63;
        const float dt = expf(P.in[16][dg]), lre = P.in[14][e], lim = P.in[15][e];
        const float mag = expf(lre * dt), ang = lim * dt; const float are = mag * cosf(ang), aim = mag * sinf(ang);
        const float den = lre * lre + lim * lim, nre = are - 1.f, nim = aim;
        const float fre = (nre * lre + nim * lim) / den, fim = (nim * lre - nre * lim) / den;
        ((float*)(ws + WS_ABAR))[e * 2] = are; ((float*)(ws + WS_ABAR))[e * 2 + 1] = aim;
        bf16_t* bbm = (bf16_t*)(ws + WS_BBM) + (size_t)dg * 128 * 16; bf16_t* ccm = (bf16_t*)(ws + WS_CCM) + (size_t)dg * 16 * 128;
        for (int c = 0; c < 16; ++c) {
            const float br = P.in[17][(size_t)e * 16 + c], bi = P.in[18][(size_t)e * 16 + c];
            bbm[p * 16 + c] = (bf16_t)(pk2(fre * br - fim * bi, 0.f) & 0xffffu);
            bbm[(64 + p) * 16 + c] = (bf16_t)(pk2(fre * bi + fim * br, 0.f) & 0xffffu);
            const float cr = P.in[19][((size_t)dg * 16 + c) * 64 + p], ci = P.in[20][((size_t)dg * 16 + c) * 64 + p];
            const int k = 4 * (p & 31) + 2 * (p >> 5);
            ccm[c * 128 + k] = (bf16_t)(pk2(cr, 0.f) & 0xffffu); ccm[c * 128 + k + 1] = (bf16_t)(pk2(-ci, 0.f) & 0xffffu);
        }
    }
}

template <int MODE>
DI void norm_phase(const Params& P, const float* gain, const float* modl, int sh_off, int sc_off) {
    const int tid = threadIdx.x, wid = tid >> 6, lane = tid & 63;
    float* X = (float*)(P.ws + WS_X); const float* P1 = (const float*)(P.ws + WS_P1); bf16_t* HB = (bf16_t*)(P.ws + WS_HB);
    for (int row = blockIdx.x * 8 + wid; row < T; row += gridDim.x * 8) {
        const float* src = (MODE == 0) ? (row < TCTX ? P.in[0] + (size_t)row * D : P.in[1] + (size_t)(row - TCTX) * D) : X + (size_t)row * D;
        f32x4 v[4]; float ss = 0.f;
#pragma unroll
        for (int j = 0; j < 4; ++j) { v[j] = *(const f32x4*)(src + 4 * lane + 256 * j);
            if (MODE >= 2) { v[j] += *(const f32x4*)(P1 + (size_t)row * D + 4 * lane + 256 * j); if (MODE == 2) *(f32x4*)(X + (size_t)row * D + 4 * lane + 256 * j) = v[j]; }
            ss += (v[j][0] * v[j][0] + v[j][1] * v[j][1]) + (v[j][2] * v[j][2] + v[j][3] * v[j][3]); }
        const float rinv = rsqrtf(wave_sum(ss) * (1.f / D) + 1e-6f);
        if (MODE == 3) {
#pragma unroll
            for (int j = 0; j < 4; ++j) { const f32x4 g = *(const f32x4*)(gain + 4 * lane + 256 * j); *(f32x4*)(P.out + (size_t)row * D + 4 * lane + 256 * j) = v[j] * rinv * g; }
        } else {
            const int vec = row < TCTX ? 0 : (row < TCTX + LLAT ? 1 : 2); const float* mv = modl + vec * 6144;
#pragma unroll
            for (int j = 0; j < 4; ++j) { const int c = 4 * lane + 256 * j; const f32x4 g = *(const f32x4*)(gain + c), sc = *(const f32x4*)(mv + sc_off + c), sh = *(const f32x4*)(mv + sh_off + c);
                const f32x4 h = (v[j] * rinv * g) * (sc + 1.f) + sh; u32x2 w; w.x = pk2(h[0], h[1]); w.y = pk2(h[2], h[3]); *(u32x2*)(HB + (size_t)row * D + c) = w; }
        }
    }
}

DI void attn_phase(const Params& P, LAS unsigned char* lds) {
    const int tid = threadIdx.x, wid = tid >> 6, lane = tid & 63, r = lane & 15, g4 = lane >> 4;
    const bf16_t* QB = (const bf16_t*)(P.ws + WS_QB); const bf16_t* KB = (const bf16_t*)(P.ws + WS_KB); const bf16_t* VT = (const bf16_t*)(P.ws + WS_VT); bf16_t* OB = (bf16_t*)(P.ws + WS_OB);
    const float LOG2E = 1.44269504089f;
    const int lrow = tid >> 3, lch = tid & 7;
    for (int u = blockIdx.x; u < 1024; u += gridDim.x) {
        int h, tok0, win0, nwin, ctx0, ipos0; bool lat;
        if (u < 512) { const int b = u >> 5; h = (u >> 1) & 15; const int n = u & 1; tok0 = 256 * b + 128 * n; win0 = 0; nwin = 0; ctx0 = 256 * b; lat = false; ipos0 = 0; }
        else { const int v = u - 512, b = v >> 8; h = (v >> 4) & 15; const int n = v & 15; const int tb = TCTX + LLAT * b; tok0 = tb + 128 * n;
            const int j0 = (128 * n - 128) < 0 ? 0 : (128 * n - 128), j1 = (128 * n + 256) > LLAT ? LLAT : (128 * n + 256);
            win0 = tb + j0; nwin = (j1 - j0) >> 6; ctx0 = T + 256 * b; lat = true; ipos0 = 128 * n - j0; }
        const int kvh = h >> 2, ntile = nwin + 4;
        const bf16_t* qp = QB + (size_t)(tok0 + 16 * wid + r) * D + h * 64 + 8 * g4;
        const bf16x8 qb0 = *(const bf16x8*)qp, qb1 = *(const bf16x8*)(qp + 32);
        float m_run = P.in[13][h] * LOG2E, l_run = (g4 == 0) ? 1.f : 0.f;
        f32x4 o[4];
#pragma unroll
        for (int dt = 0; dt < 4; ++dt) o[dt] = (f32x4){0.f, 0.f, 0.f, 0.f};
        const int iq = ipos0 + 16 * wid + r;
        u32x4 kreg, vreg;
        { const int tk = (0 < nwin) ? win0 : ctx0;
          kreg = *(const u32x4*)(KB + (size_t)(tk + lrow) * 256 + kvh * 64 + lch * 8); vreg = *(const u32x4*)(VT + (size_t)(kvh * 64 + lrow) * KROWS + tk + lch * 8); }
        *(LAS u32x4*)(lds + lrow * 144 + lch * 16) = kreg; *(LAS u32x4*)(lds + 9216 + lrow * 144 + lch * 16) = vreg;
        __syncthreads();
        for (int t = 0; t < ntile; ++t) {
            LAS unsigned char* Kb = lds + (t & 1) * 18432; LAS unsigned char* Vb = Kb + 9216;
            if (t + 1 < ntile) { const int tk = (t + 1 < nwin) ? win0 + 64 * (t + 1) : ctx0 + 64 * (t + 1 - nwin);
                kreg = *(const u32x4*)(KB + (size_t)(tk + lrow) * 256 + kvh * 64 + lch * 8); vreg = *(const u32x4*)(VT + (size_t)(kvh * 64 + lrow) * KROWS + tk + lch * 8); }
            int cls = 0;
            if (lat && t < nwin) { const int iq0 = ipos0 + 16 * wid, dmin = 64 * t - (iq0 + 15), dmax = 64 * t + 63 - iq0; cls = (dmax < -128 || dmin > 128) ? 2 : ((dmin >= -128 && dmax <= 128) ? 0 : 1); }
            if (cls != 2) {
            f32x4 s[4];
#pragma unroll
            for (int kt = 0; kt < 4; ++kt) {
                const bf16x8 a0 = *(const LAS bf16x8*)(Kb + (16 * kt + r) * 144 + g4 * 16), a1 = *(const LAS bf16x8*)(Kb + (16 * kt + r) * 144 + 64 + g4 * 16);
                f32x4 z = {0.f, 0.f, 0.f, 0.f};
                z = __builtin_amdgcn_mfma_f32_16x16x32_bf16(a0, qb0, z, 0, 0, 0);
                s[kt] = __builtin_amdgcn_mfma_f32_16x16x32_bf16(a1, qb1, z, 0, 0, 0);
            }
            float mx = -3.0e38f;
            if (cls == 1) {
#pragma unroll
                for (int kt = 0; kt < 4; ++kt)
#pragma unroll
                    for (int i = 0; i < 4; ++i) { const int dj = 64 * t + 16 * kt + 4 * g4 + i - iq; if (dj > 128 || dj < -128) s[kt][i] = -1.0e30f; }
            }
#pragma unroll
            for (int kt = 0; kt < 4; ++kt)
#pragma unroll
                for (int i = 0; i < 4; ++i) mx = fmaxf(mx, s[kt][i]);
            mx = fmaxf(mx, __shfl_xor(mx, 16)); mx = fmaxf(mx, __shfl_xor(mx, 32));
            const float mnew = fmaxf(m_run, mx), alpha = __builtin_amdgcn_exp2f(m_run - mnew); m_run = mnew;
            float ls = 0.f;
#pragma unroll
            for (int kt = 0; kt < 4; ++kt)
#pragma unroll
                for (int i = 0; i < 4; ++i) { const float p = __builtin_amdgcn_exp2f(s[kt][i] - mnew); s[kt][i] = p; ls += p; }
            l_run = l_run * alpha + ls;
#pragma unroll
            for (int dt = 0; dt < 4; ++dt) o[dt] *= alpha;
            u32x4 pw01, pw23;
            pw01.x = pk2(s[0][0], s[0][1]); pw01.y = pk2(s[0][2], s[0][3]); pw01.z = pk2(s[1][0], s[1][1]); pw01.w = pk2(s[1][2], s[1][3]);
            pw23.x = pk2(s[2][0], s[2][1]); pw23.y = pk2(s[2][2], s[2][3]); pw23.z = pk2(s[3][0], s[3][1]); pw23.w = pk2(s[3][2], s[3][3]);
            const bf16x8 pb01 = __builtin_bit_cast(bf16x8, pw01), pb23 = __builtin_bit_cast(bf16x8, pw23);
#pragma unroll
            for (int dt = 0; dt < 4; ++dt) {
                const LAS unsigned char* vr = Vb + (16 * dt + r) * 144 + g4 * 8;
                u32x4 va; const u32x2 l0 = *(const LAS u32x2*)(vr), h0 = *(const LAS u32x2*)(vr + 32), l1 = *(const LAS u32x2*)(vr + 64), h1 = *(const LAS u32x2*)(vr + 96);
                va.x = l0.x; va.y = l0.y; va.z = h0.x; va.w = h0.y;
                o[dt] = __builtin_amdgcn_mfma_f32_16x16x32_bf16(__builtin_bit_cast(bf16x8, va), pb01, o[dt], 0, 0, 0);
                va.x = l1.x; va.y = l1.y; va.z = h1.x; va.w = h1.y;
                o[dt] = __builtin_amdgcn_mfma_f32_16x16x32_bf16(__builtin_bit_cast(bf16x8, va), pb23, o[dt], 0, 0, 0);
            }
            }
            if (t + 1 < ntile) { LAS unsigned char* Kn = lds + ((t + 1) & 1) * 18432; *(LAS u32x4*)(Kn + lrow * 144 + lch * 16) = kreg; *(LAS u32x4*)(Kn + 9216 + lrow * 144 + lch * 16) = vreg; }
            __syncthreads();
        }
        float l = l_run; l += __shfl_xor(l, 16); l += __shfl_xor(l, 32);
        const float inv = 1.f / l;
        bf16_t* op = OB + (size_t)(tok0 + 16 * wid + r) * D + h * 64 + 4 * g4;
#pragma unroll
        for (int dt = 0; dt < 4; ++dt) { u32x2 w; w.x = pk2(o[dt][0] * inv, o[dt][1] * inv); w.y = pk2(o[dt][2] * inv, o[dt][3] * inv); *(u32x2*)(op + 16 * dt) = w; }
    }
}

constexpr size_t WS_E = 232 * MiB;
struct SsmItem { int g, k, nchunk, seqX, tokX, tokY; bool lat; };
DI SsmItem ssm_item(int gw) {
    SsmItem it; int pi;
    if (gridDim.x == 256) { const int bid = gw & 255, wid = gw >> 8; it.g = (bid & 7) * 8 + ((bid >> 3) & 7); pi = wid * 4 + (bid >> 6); }
    else { it.g = gw & 63; pi = gw >> 6; }
    if (pi < 16) { const int sp = pi >> 1; it.k = pi & 1; it.nchunk = 2; it.seqX = 2 * sp; it.tokX = 512 * sp + 128 * it.k; it.tokY = it.tokX + 256; it.lat = false; }
    else { it.k = pi - 16; it.nchunk = 16; it.seqX = 16; it.tokX = TCTX + 128 * it.k; it.tokY = it.tokX + LLAT; it.lat = true; }
    return it;
}
DI size_t ssm_eidx(int dir, int seq, int chunk, int g) { return ((((size_t)dir * 18 + seq) * 16 + chunk) * 64 + g) * 128; }

#define SSM_SCAN_STEP(i, WRITE_S) { const float nr0 = ar0 * sr0 - ai0 * si0 + acc[0][i], ni0 = ar0 * si0 + ai0 * sr0 + acc[2][i]; \
        const float nr1 = ar1 * sr1 - ai1 * si1 + acc[1][i], ni1 = ar1 * si1 + ai1 * sr1 + acc[3][i]; \
        sr0 = nr0; si0 = ni0; sr1 = nr1; si1 = ni1; \
        if (WRITE_S) { u32x2 w; w.x = pk2(nr0, ni0); w.y = pk2(nr1, ni1); *(LAS u32x2*)(S + (16 * h + (i)) * 272 + p * 8) = w; } }

DI void ssm_pass1(const Params& P) {
    const int tid = threadIdx.x, wid = tid >> 6, lane = tid & 63, p = lane & 31, h = lane >> 5;
    const int gw = wid * gridDim.x + blockIdx.x;
    if (gw >= 2048) return;
    const SsmItem it = ssm_item(gw);
    const bf16_t* HB = (const bf16_t*)(P.ws + WS_HB);
    float* E = (float*)(P.ws + WS_E);
    const int hh = (p >> 2) & 1, ii = 4 * (p >> 3) + (p & 3);
    const bf16_t* ubase = HB + (size_t)((hh ? it.tokY : it.tokX) + ii) * D + 16 * it.g + 8 * h;
    bf16x8 a[8];
#pragma unroll
    for (int t = 0; t < 8; ++t) a[t] = *(const bf16x8*)(ubase + (size_t)(16 * t) * D);
    LAS unsigned char* S = nullptr;
#pragma unroll
    for (int dir = 0; dir < 2; ++dir) {
        const int dg = dir * 64 + it.g;
        const float* ab = (const float*)(P.ws + WS_ABAR) + (size_t)dg * 128;
        const float ar0 = ab[2 * p], ai0 = ab[2 * p + 1], ar1 = ab[2 * (p + 32)], ai1 = ab[2 * (p + 32) + 1];
        bf16x8 bbq[4];
#pragma unroll
        for (int q = 0; q < 4; ++q) bbq[q] = *(const bf16x8*)((const bf16_t*)(P.ws + WS_BBM) + ((size_t)dg * 128 + q * 32 + p) * 16 + 8 * h);
        float sr0 = 0.f, si0 = 0.f, sr1 = 0.f, si1 = 0.f;
#pragma unroll
        for (int tt = 0; tt < 8; ++tt) {
            const int ti = dir ? 7 - tt : tt;
            f32x16 acc[4];
#pragma unroll
            for (int q = 0; q < 4; ++q) { f32x16 z;
#pragma unroll
                for (int i = 0; i < 16; ++i) z[i] = 0.f;
                acc[q] = __builtin_amdgcn_mfma_f32_32x32x16_bf16(a[ti], bbq[q], z, 0, 0, 0); }
            if (dir == 0) {
#pragma unroll
                for (int i = 0; i < 16; ++i) SSM_SCAN_STEP(i, false)
            } else {
#pragma unroll
                for (int i = 15; i >= 0; --i) SSM_SCAN_STEP(i, false)
            }
        }
        float* e = E + ssm_eidx(dir, it.seqX + h, it.k, it.g);
        e[p] = sr0; e[p + 32] = sr1; e[64 + p] = si0; e[64 + p + 32] = si1;
    }
}

template <int DIR>
DI void ssm_dir(const Params& P, const SsmItem& it, LAS unsigned char* S, f32x4 (&st)[8][2], int lane) {
    const int p = lane & 31, h = lane >> 5, c16 = lane & 15, g4 = lane >> 4;
    const int dg = DIR * 64 + it.g;
    const float* ab = (const float*)(P.ws + WS_ABAR) + (size_t)dg * 128;
    const float ar0 = ab[2 * p], ai0 = ab[2 * p + 1], ar1 = ab[2 * (p + 32)], ai1 = ab[2 * (p + 32) + 1];
    bf16x8 bbq[4], ccb[4];
#pragma unroll
    for (int q = 0; q < 4; ++q) bbq[q] = *(const bf16x8*)((const bf16_t*)(P.ws + WS_BBM) + ((size_t)dg * 128 + q * 32 + p) * 16 + 8 * h);
#pragma unroll
    for (int ks = 0; ks < 4; ++ks) ccb[ks] = *(const bf16x8*)((const bf16_t*)(P.ws + WS_CCM) + ((size_t)dg * 16 + c16) * 128 + 32 * ks + 8 * g4);
    const bf16_t* HB = (const bf16_t*)(P.ws + WS_HB);
    float sr0 = 0.f, si0 = 0.f, sr1 = 0.f, si1 = 0.f;
    const int seq = it.seqX + h;
    if (it.lat) { const float* s0 = P.in[4] + ((size_t)(h * 2 + DIR) * 2) * 4096 + it.g * 64; sr0 = s0[p]; sr1 = s0[p + 32]; si0 = s0[4096 + p]; si1 = s0[4096 + p + 32]; }
    {
        const float* E = (const float*)(P.ws + WS_E);
        const int nj = DIR ? (it.nchunk - 1 - it.k) : it.k;
        float er0[15], er1[15], ei0[15], ei1[15];
#pragma unroll
        for (int jj = 0; jj < 15; ++jj) { int j = DIR ? (it.nchunk - 1 - jj) : jj; j = j < 0 ? 0 : j; j = j > it.nchunk - 1 ? it.nchunk - 1 : j;
            const float* e = E + ssm_eidx(DIR, seq, j, it.g); er0[jj] = e[p]; er1[jj] = e[p + 32]; ei0[jj] = e[64 + p]; ei1[jj] = e[64 + p + 32]; }
        float pr0 = ar0, pi0 = ai0, pr1 = ar1, pi1 = ai1;
#pragma unroll
        for (int q = 0; q < 7; ++q) { const float t0 = pr0 * pr0 - pi0 * pi0, t1 = 2.f * pr0 * pi0, t2 = pr1 * pr1 - pi1 * pi1, t3 = 2.f * pr1 * pi1; pr0 = t0; pi0 = t1; pr1 = t2; pi1 = t3; }
#pragma unroll
        for (int jj = 0; jj < 15; ++jj) {
            const float n0 = pr0 * sr0 - pi0 * si0 + er0[jj], m0 = pr0 * si0 + pi0 * sr0 + ei0[jj], n1 = pr1 * sr1 - pi1 * si1 + er1[jj], m1 = pr1 * si1 + pi1 * sr1 + ei1[jj];
            if (jj < nj) { sr0 = n0; si0 = m0; sr1 = n1; si1 = m1; }
        }
    }
    bf16_t* YB = (bf16_t*)(P.ws + WS_QB);
    bf16x8 dd;
    { const float dsk = P.in[21][16 * it.g + c16]; const unsigned short db = (unsigned short)(pk2(dsk, 0.f) & 0xffffu);
#pragma unroll
      for (int j = 0; j < 8; ++j) dd[j] = (g4 < 2 && (8 * g4 + j) == c16) ? (short)db : (short)0; }
    const int hh = (p >> 2) & 1, ii = 4 * (p >> 3) + (p & 3);
    const bf16_t* ubase = HB + (size_t)((hh ? it.tokY : it.tokX) + ii) * D + 16 * it.g + 8 * h;
    const bf16_t* uaX = HB + (size_t)(it.tokX + c16) * D + 16 * it.g + 8 * (g4 & 1);
    const bf16_t* uaY = HB + (size_t)(it.tokY + c16) * D + 16 * it.g + 8 * (g4 & 1);
    const bf16x8 zero8 = {0, 0, 0, 0, 0, 0, 0, 0};
    bf16x8 a_n = *(const bf16x8*)(ubase + (size_t)(DIR ? 112 : 0) * D), ux_n = zero8, uy_n = zero8;
    if (DIR == 0 && g4 < 2) { ux_n = *(const bf16x8*)(uaX); uy_n = *(const bf16x8*)(uaY); }
    for (int tt = 0; tt < 8; ++tt) {
        const int ti = DIR ? 7 - tt : tt;
        const bf16x8 a = a_n, ux = ux_n, uy = uy_n;
        if (tt < 7) { const int tn = DIR ? ti - 1 : ti + 1; a_n = *(const bf16x8*)(ubase + (size_t)(16 * tn) * D);
            if (DIR == 0 && g4 < 2) { ux_n = *(const bf16x8*)(uaX + (size_t)(16 * tn) * D); uy_n = *(const bf16x8*)(uaY + (size_t)(16 * tn) * D); } }
        f32x16 acc[4];
#pragma unroll
        for (int q = 0; q < 4; ++q) { f32x16 z;
#pragma unroll
            for (int i = 0; i < 16; ++i) z[i] = 0.f;
            acc[q] = __builtin_amdgcn_mfma_f32_32x32x16_bf16(a, bbq[q], z, 0, 0, 0); }
        if (DIR == 0) {
#pragma unroll
            for (int i = 0; i < 16; ++i) SSM_SCAN_STEP(i, true)
        } else {
#pragma unroll
            for (int i = 15; i >= 0; --i) SSM_SCAN_STEP(i, true)
        }
        asm volatile("" ::: "memory");
        f32x4 y[2];
        if (DIR) {
            y[0] = st[0][0]; y[1] = st[0][1];
#pragma unroll
            for (int q = 0; q < 7; ++q) { st[q][0] = st[q + 1][0]; st[q][1] = st[q + 1][1]; }
        } else { y[0] = (f32x4){0.f, 0.f, 0.f, 0.f}; y[1] = y[0];
            y[0] = __builtin_amdgcn_mfma_f32_16x16x32_bf16(ux, dd, y[0], 0, 0, 0); y[1] = __builtin_amdgcn_mfma_f32_16x16x32_bf16(uy, dd, y[1], 0, 0, 0); }
#pragma unroll
        for (int mt = 0; mt < 2; ++mt)
#pragma unroll
            for (int ks = 0; ks < 4; ++ks) { const bf16x8 sa = *(const LAS bf16x8*)(S + (16 * mt + c16) * 272 + 64 * ks + 16 * g4);
                y[mt] = __builtin_amdgcn_mfma_f32_16x16x32_bf16(sa, ccb[ks], y[mt], 0, 0, 0); }
        asm volatile("" ::: "memory");
        if (DIR == 0) {
#pragma unroll
            for (int q = 7; q > 0; --q) { st[q][0] = st[q - 1][0]; st[q][1] = st[q - 1][1]; }
            st[0][0] = y[0]; st[0][1] = y[1];
        } else {
#pragma unroll
            for (int mt = 0; mt < 2; ++mt) {
                const size_t base = (size_t)((mt ? it.tokY : it.tokX) + 16 * ti + 4 * g4) * D + 16 * it.g + c16;
#pragma unroll
                for (int i = 0; i < 4; ++i) { const float x = y[mt][i]; const float z = 1.5957691216f * (x + 0.044715f * x * x * x);
                    YB[base + (size_t)i * D] = (bf16_t)(pk2(x * __builtin_amdgcn_rcpf(1.f + __expf(-z)), 0.f) & 0xffffu); }
            }
        }
    }
    if (!it.lat && ((DIR == 0 && it.k == it.nchunk - 1) || (DIR == 1 && it.k == 0))) {
        float* so = P.out + OUT_S + ((size_t)seq * 2 + DIR) * 2 * 4096 + it.g * 64;
        so[p] = sr0; so[p + 32] = sr1; so[4096 + p] = si0; so[4096 + p + 32] = si1; }
}

DI void ssm_pass3(const Params& P, LAS unsigned char* lds) {
    const int tid = threadIdx.x, wid = tid >> 6, lane = tid & 63;
    const int gw = wid * gridDim.x + blockIdx.x;
    if (gw >= 2048) return;
    const SsmItem it = ssm_item(gw);
    LAS unsigned char* S = lds + wid * 8704;
    f32x4 st[8][2];
#pragma unroll
    for (int q = 0; q < 8; ++q) { st[q][0] = (f32x4){0.f, 0.f, 0.f, 0.f}; st[q][1] = st[q][0]; }
    ssm_dir<0>(P, it, S, st, lane);
    ssm_dir<1>(P, it, S, st, lane);
}
#undef SSM_SCAN_STEP

#define XB_TMO      128
#define XB_XCNT(j)  (256  + 64 * (j))
#define XB_XSUB(j)  (1280 + 64 * (j))
#define XB_XGEN(j)  (2304 + 64 * (j))
#define XB_TOP      3328
#define XB_TOPGEN   3392
#define XCD_BAR_WORDS 3456
#define XB_SPIN_CAP (1u << 18)
DI unsigned xb_ld(unsigned* p)              { return __hip_atomic_load(p, __ATOMIC_RELAXED, __HIP_MEMORY_SCOPE_AGENT); }
DI unsigned xb_add(unsigned* p, unsigned v) { return __hip_atomic_fetch_add(p, v, __ATOMIC_RELAXED, __HIP_MEMORY_SCOPE_AGENT); }
DI unsigned xb_xcc_id() { return (unsigned)__builtin_amdgcn_s_getreg((3 << 11) | 20) & 0xFu; }
#define XB_SPIN(cond, bar) do { unsigned _sp = 0; while (cond) { __builtin_amdgcn_s_sleep(1); \
    if ((++_sp & 255u) == 0u) { if (xb_ld(&(bar)[XB_TMO])) break; if (_sp > XB_SPIN_CAP) { atomicAdd(&(bar)[XB_TMO], 1u); break; } } } } while (0)
struct XcdBarrier { unsigned* bar; unsigned x; volatile LAS unsigned* st; };
DI XcdBarrier xcd_barrier_post(unsigned* bar, volatile LAS unsigned* st) {
    XcdBarrier b; b.bar = bar; b.x = xb_xcc_id(); b.st = st;
    if (threadIdx.x == 0) (void)xb_add(&bar[XB_XCNT(b.x)], 1u);
    return b;
}
DI void xcd_barrier_complete(unsigned* bar, unsigned x, unsigned& nloc, unsigned& nx) {
    const unsigned G = gridDim.x * gridDim.y * gridDim.z;
    unsigned sum, cnt, mine, sp = 0u;
    for (;;) {
        sum = 0u; cnt = 0u; mine = 0u;
#pragma unroll
        for (unsigned j = 0; j < 16; ++j) { const unsigned c = xb_ld(&bar[XB_XCNT(j)]); sum += c; cnt += (c > 0u) ? 1u : 0u; mine = (j == x) ? c : mine; }
        if (sum == G) break;
        __builtin_amdgcn_s_sleep(1);
        if ((++sp & 255u) == 0u) { if (xb_ld(&bar[XB_TMO])) break; if (sp > XB_SPIN_CAP) { atomicAdd(&bar[XB_TMO], 1u); break; } }
    }
    nloc = mine > 0u ? mine : 1u; nx = cnt > 0u ? cnt : 1u;
}
DI void xcd_barrier(const XcdBarrier& b) {
    asm volatile("s_waitcnt vmcnt(0)" ::: "memory");
    __syncthreads();
    if (threadIdx.x == 0) {
        unsigned* bar = b.bar;
        __builtin_amdgcn_s_waitcnt(0);
        unsigned nloc = b.st[0], nx = b.st[1];
        if (nloc == 0u) { xcd_barrier_complete(bar, b.x, nloc, nx); b.st[0] = nloc; b.st[1] = nx; }
        const unsigned old = xb_add(&bar[XB_XSUB(b.x)], 1u);
        const unsigned gen = old / nloc;
        if (old + 1u == (gen + 1u) * nloc) {
            __builtin_amdgcn_fence(__ATOMIC_RELEASE, "agent");
            asm volatile("s_waitcnt vmcnt(0)" ::: "memory");
            const unsigned og = xb_add(&bar[XB_TOP], 1u);
            const unsigned tg = og / nx;
            if (og + 1u == (tg + 1u) * nx) xb_add(&bar[XB_TOPGEN], 1u);
            else XB_SPIN(xb_ld(&bar[XB_TOPGEN]) == tg, bar);
            __builtin_amdgcn_fence(__ATOMIC_ACQUIRE, "agent");
            xb_add(&bar[XB_XGEN(b.x)], 1u);
            asm volatile("s_waitcnt vmcnt(0)" ::: "memory");
        } else {
            XB_SPIN(xb_ld(&bar[XB_XGEN(b.x)]) == gen, bar);
            __builtin_amdgcn_fence(__ATOMIC_ACQUIRE, "agent");
            asm volatile("s_waitcnt vmcnt(0)" ::: "memory");
        }
    }
    __syncthreads();
}

constexpr int NPHASE = 16;
#ifndef REPMASK
#define REPMASK 0
#endif
#ifndef EXTRA_SYNCS
#define EXTRA_SYNCS 0
#endif
constexpr int LDS_BYTES = 147456;
__global__ void __launch_bounds__(512, 2) fwd_kernel(Params P) {
    extern __shared__ __attribute__((aligned(16))) unsigned char lds_raw[];
    LAS unsigned char* lds = (LAS unsigned char*)lds_raw;
    cg::grid_group grid = cg::this_grid();
    unsigned char* ws = P.ws;
    const float* MOD = (const float*)(ws + WS_MOD);
    const int lo = P.ph_lo, hi = P.ph_hi, G = gridDim.x;
    volatile LAS unsigned* MISC = (volatile LAS unsigned*)(lds + 131072);
    if (threadIdx.x < 64) MISC[threadIdx.x] = 0u;
    __syncthreads();
    XcdBarrier bar = xcd_barrier_post((unsigned*)ws, MISC + 8);
    if (hi < 0) grid.sync();
#define IN(k) (lo <= (k) && (k) < hi)
#define SYNC(k) do { if (IN(k) && IN((k) + 1)) { xcd_barrier(bar); } } while (0)
#define PHASE(k, ...) do { if (IN(k)) { __VA_ARGS__; if ((REPMASK >> (k)) & 1) { xcd_barrier(bar); __VA_ARGS__; } } SYNC(k); } while (0)
#define GEMM_QKV { pg8::Gemm g{(const bf16_t*)(ws + WS_HB), (const bf16_t*)(ws + WS_WQKV), D, D}; pg8::StaticOrder S; S.init(T, NQKV, 1, G, blockIdx.x); \
        pg8::EpiQkv E{(bf16_t*)(ws + WS_QB), (bf16_t*)(ws + WS_KB), (bf16_t*)(ws + WS_VT), P.out + OUT_K, P.out + OUT_V, (const float*)(ws + WS_ROPE), (const float*)(ws + WS_ROPE) + 2048 * 32}; \
        pg8::gemm_phase(lds, g, S, E); }
#define GEMM_WO { pg8::Gemm g{(const bf16_t*)(ws + WS_OB), (const bf16_t*)(ws + WS_WO), D, D / 2}; pg8::StaticOrder S; S.init(T, D, 2, G, blockIdx.x); \
        pg8::EpiResid E{P.in[0], P.in[1] - (size_t)TCTX * D, (float*)(ws + WS_X), (float*)(ws + WS_P1), MOD + 2048}; \
        pg8::gemm_phase(lds, g, S, E); }
#define GEMM_MLP1(l) { pg8::Gemm g{(const bf16_t*)(ws + WS_HB), (const bf16_t*)(ws + WS_W1) + (size_t)(l) * D * FF, D, D}; pg8::StaticOrder S; S.init(T, FF, 1, G, blockIdx.x); \
        pg8::EpiRelu2 E{(bf16_t*)(ws + WS_AB), FF}; pg8::gemm_phase(lds, g, S, E); }
#define GEMM_MLP2(l) { pg8::Gemm g{(const bf16_t*)(ws + WS_AB), (const bf16_t*)(ws + WS_W2) + (size_t)(l) * D * FF, FF, FF / 2}; pg8::StaticOrder S; S.init(T, D, 2, G, blockIdx.x); \
        pg8::EpiResid E{(const float*)(ws + WS_X), (const float*)(ws + WS_X), (float*)(ws + WS_X), (float*)(ws + WS_P1), MOD + (l) * 3 * 6144 + 5120}; \
        pg8::gemm_phase(lds, g, S, E); }
#define GEMM_GLU { pg8::Gemm g{(const bf16_t*)(ws + WS_QB), (const bf16_t*)(ws + WS_WGLU), D, D}; pg8::StaticOrder S; S.init(T, 2 * D, 1, G, blockIdx.x); \
        pg8::EpiGlu E{(float*)(ws + WS_X), MOD + 3 * 6144 + 2048}; pg8::gemm_phase(lds, g, S, E); }
    PHASE(0, prep_phase(P, lds));
    for (int x = 0; x < EXTRA_SYNCS; ++x) xcd_barrier(bar);
    PHASE(1, norm_phase<0>(P, P.in[7], MOD, 0, 1024));
    PHASE(2, GEMM_QKV);
    PHASE(3, attn_phase(P, lds));
    PHASE(4, GEMM_WO);
    PHASE(5, norm_phase<2>(P, P.in[8], MOD, 3072, 4096));
    PHASE(6, GEMM_MLP1(0));
    PHASE(7, GEMM_MLP2(0));
    PHASE(8, norm_phase<2>(P, P.in[7] + D, MOD + 3 * 6144, 0, 1024));
    PHASE(9, ssm_pass1(P));
    PHASE(10, ssm_pass3(P, lds));
    PHASE(11, GEMM_GLU);
    PHASE(12, norm_phase<1>(P, P.in[8] + D, MOD + 3 * 6144, 3072, 4096));
    PHASE(13, GEMM_MLP1(1));
    PHASE(14, GEMM_MLP2(1));
    PHASE(15, norm_phase<3>(P, P.in[26], MOD, 0, 0));
#undef IN
}

#ifndef MK_MULTI
#define MK_MULTI 0
#endif
extern "C" void kernel_launch(void* const* d_in, const int* in_sizes, int n_in, void* d_out, int out_size, void* d_ws, size_t ws_size, hipStream_t stream) {
    static int grid = 0;
    if (grid == 0) {
        int dev = 0, cus = 0, per_cu = 0;
        hipGetDevice(&dev);
        hipDeviceGetAttribute(&cus, hipDeviceAttributeMultiprocessorCount, dev);
        hipFuncSetAttribute((const void*)fwd_kernel, hipFuncAttributeMaxDynamicSharedMemorySize, LDS_BYTES);
        hipOccupancyMaxActiveBlocksPerMultiprocessor(&per_cu, (const void*)fwd_kernel, 512, LDS_BYTES);
        if (per_cu < 1) { fprintf(stderr, "occupancy query gave %d\n", per_cu); per_cu = 1; }
        if (per_cu > 1) per_cu = 1;
        grid = cus * per_cu;
        if (grid > 256) grid = 256;
    }
    (void)hipMemsetAsync(d_ws, 0, 16384, stream);
    Params p{};
    for (int i = 0; i < 27; ++i) p.in[i] = (const float*)d_in[i];
    p.out = (float*)d_out; p.ws = (unsigned char*)d_ws;
#if MK_MULTI
    for (int k = 0; k < NPHASE; ++k) { p.ph_lo = k; p.ph_hi = k + 1; hipLaunchKernelGGL(fwd_kernel, dim3(grid), dim3(512), LDS_BYTES, stream, p); }
#else
    p.ph_lo = 0; p.ph_hi = NPHASE;
    void* args[] = {&p};
    hipError_t e = hipLaunchCooperativeKernel((const void*)fwd_kernel, dim3(grid), dim3(512), args, LDS_BYTES, stream);
    if (e != hipSuccess) fprintf(stderr, "cooperative launch failed: %s (grid %d)\n", hipGetErrorString(e), grid);
#endif
}
```

```cpp
#include <hip/hip_runtime.h>
#include <hip/hip_cooperative_groups.h>
#include <cstdio>
#include <cstdint>
namespace cg = cooperative_groups;

#define LAS __attribute__((address_space(3)))
typedef unsigned short bf16_t;
typedef short bf16x8 __attribute__((ext_vector_type(8)));
typedef float f32x4 __attribute__((ext_vector_type(4)));
typedef float f32x16 __attribute__((ext_vector_type(16)));
typedef float f32x2 __attribute__((ext_vector_type(2)));
typedef unsigned u32x4 __attribute__((ext_vector_type(4)));
typedef unsigned u32x2 __attribute__((ext_vector_type(2)));
typedef __bf16 bf16x2v __attribute__((ext_vector_type(2)));
#define DI __device__ __forceinline__

DI unsigned pk2(float a, float b) { f32x2 v = {a, b}; bf16x2v r = __builtin_convertvector(v, bf16x2v); return __builtin_bit_cast(unsigned, r); }
DI float bf2f(unsigned short u) { return __builtin_bit_cast(float, (unsigned)u << 16); }
DI float wave_sum(float v) {
#pragma unroll
    for (int o = 1; o < 64; o <<= 1) v += __shfl_xor(v, o);
    return v;
}

constexpr int T = 8192, D = 1024, FF = 4096, NQKV = 1536, TCTX = 4096, LLAT = 2048;
constexpr int KROWS = 8704;
constexpr size_t MiB = 1u << 20;
constexpr size_t WS_MOD = 1 * MiB;
constexpr size_t WS_ABAR = 2 * MiB;
constexpr size_t WS_BBM = 2 * MiB + 128 * 1024;
constexpr size_t WS_CCM = 2 * MiB + 640 * 1024;
constexpr size_t WS_ROPE = 3 * MiB + 256 * 1024;
constexpr size_t WS_WQKV = 4 * MiB, WS_WO = 7 * MiB, WS_WGLU = 9 * MiB, WS_W1 = 13 * MiB, WS_W2 = 29 * MiB;
constexpr size_t WS_KB = 45 * MiB, WS_VT = 50 * MiB;
constexpr size_t WS_HB = 56 * MiB, WS_QB = 72 * MiB, WS_OB = 88 * MiB, WS_X = 104 * MiB, WS_P1 = 136 * MiB, WS_AB = 168 * MiB;
constexpr size_t WS_YP = 168 * MiB;
constexpr int OUT_K = 8388608, OUT_V = 8388608 + 1048576, OUT_S = 8388608 + 2 * 1048576;

struct Params { const float* in[27]; float* out; unsigned char* ws; int ph_lo, ph_hi; };

namespace pg8 {
constexpr int BM = 256, BK = 64, HALF = 128, HTB = HALF * BK * 2, STAGE_BYTES = 8 * HTB, NXCD = 8, WGM = 8;
__host__ __device__ __forceinline__ int lds_byte(int r, int c) { const int st = (r >> 4) * 2 + (c >> 5), rr = r & 15, cc = c & 31, ob = rr * 64 + cc * 2; return st * 1024 + (ob ^ (((ob >> 9) & 1) << 5)); }
__host__ __device__ __forceinline__ void stage_rc(int b, int& R, int& C) { const int st = b / 1024, sb = b % 1024, swz = sb ^ (((sb >> 9) & 1) << 5); R = (st >> 1) * 16 + swz / 64; C = (st & 1) * 32 + (swz % 64) / 2; }
__host__ __device__ __forceinline__ int perm32(int rho) { const int n = rho >> 4, i = rho & 15; return 8 * (i >> 2) + 4 * n + (i & 3); }

struct Unit { int pm, pn, ks; };
struct Gemm { const bf16_t* A; const bf16_t* Bt; int ld, Kloop; };

struct StaticOrder {
    int nM, nN, nNv, nwg, G, c;
    __device__ void init(int M, int N, int split, int G_, int c_) { nM = M / BM; nN = N / BM; nNv = nN * split; nwg = nM * nNv; G = G_; c = c_; }
    __device__ bool next(int i, Unit& u) const {
        const long L = (long)i * G + c; if (L >= nwg) return false;
        int wgid = (int)L; { const int q = nwg / NXCD, r = nwg % NXCD, xcd = wgid % NXCD, off = wgid / NXCD; wgid = (xcd < r ? xcd * (q + 1) : r * (q + 1) + (xcd - r) * q) + off; }
        const int nig = WGM * nNv, gid = wgid / nig, fm = gid * WGM, gsz = (nM - fm) < WGM ? (nM - fm) : WGM;
        u.pm = fm + ((wgid % nig) % gsz); const int pv = (wgid % nig) / gsz; u.pn = pv % nN; u.ks = pv / nN; return true;
    }
};

template <class Epi>
__device__ __forceinline__ void gemm_phase(LAS unsigned char* lds, const Gemm g, const StaticOrder& S, const Epi& E) {
    const int tid = threadIdx.x, wid = __builtin_amdgcn_readfirstlane(tid >> 6), lane = tid & 63, wr = wid >> 2, wc = wid & 3, fr = lane & 15, fq = lane >> 4;
    const int ld = g.ld, nt = g.Kloop / BK;
    unsigned voffA[2], voffB[2];
#pragma unroll
    for (int i = 0; i < 2; ++i) { int R, C; stage_rc(tid * 16 + i * 8192, R, C); const int Rb = Epi::PERM ? ((R & ~31) + perm32(R & 31)) : R;
        voffA[i] = (unsigned)(R * ld + C) * 2u; voffB[i] = (unsigned)(Rb * ld + C) * 2u; }
    const size_t kstep = (size_t)(BK * 2);
    const size_t hstep = (size_t)HALF * ld * 2;
    const size_t tstep = 2 * hstep;
    const size_t kso = (size_t)g.Kloop * 2;
    const unsigned ldsw = (unsigned)wid * 1024u;
    const int aoff = lds_byte(wr * 64 + fr, fq * 8), boff = lds_byte(wc * 32 + fr, fq * 8);
#define PG8_SA(b, h) (((b) * 2 + (h)) * HTB)
#define PG8_SB(b, h) ((4 + (b) * 2 + (h)) * HTB)
#define PG8_STAGE(bufoff, gbase, voff) do { _Pragma("unroll") for (int _i = 0; _i < 2; ++_i) \
        __builtin_amdgcn_global_load_lds((const unsigned*)((const char*)(gbase) + (voff)[_i]), (LAS unsigned*)(lds + (bufoff) + ldsw + _i * 8192), 16, 0, 0); } while (0)
#define PG8_LDA(dst, b, h) do { _Pragma("unroll") for (int m = 0; m < 4; ++m) _Pragma("unroll") for (int k = 0; k < 2; ++k) dst[m][k] = *(const LAS bf16x8*)(lds + PG8_SA(b, h) + aoff + m * 2048 + k * 1024); } while (0)
#define PG8_LDB(dst, b, h) do { _Pragma("unroll") for (int n = 0; n < 2; ++n) _Pragma("unroll") for (int k = 0; k < 2; ++k) dst[n][k] = *(const LAS bf16x8*)(lds + PG8_SB(b, h) + boff + n * 2048 + k * 1024); } while (0)
#define PG8_MMA(ai, bj, At, Bt) do { __builtin_amdgcn_s_setprio(1); _Pragma("unroll") for (int m = 0; m < 4; ++m) _Pragma("unroll") for (int n = 0; n < 2; ++n) _Pragma("unroll") for (int k = 0; k < 2; ++k) \
        acc[ai][bj][m][n] = __builtin_amdgcn_mfma_f32_16x16x32_bf16(Bt[n][k], At[m][k], acc[ai][bj][m][n], 0, 0, 0); __builtin_amdgcn_s_setprio(0); } while (0)
#define PG8_WAIT_V(n) asm volatile("s_waitcnt vmcnt(" #n ")" ::: "memory")
#define PG8_WAIT_L(n) asm volatile("s_waitcnt lgkmcnt(" #n ")" ::: "memory")
#define PG8_BAR __builtin_amdgcn_s_barrier()
#define PG8_SCHED __builtin_amdgcn_sched_barrier(0)
#define PG8_UA(u) ((const char*)g.A + (size_t)(u).pm * tstep + (size_t)(u).ks * kso)
#define PG8_UB(u) ((const char*)g.Bt + (size_t)(u).pn * tstep + (size_t)(u).ks * kso)
    Unit cur, nxt; int ui = 0;
    if (!S.next(0, cur)) return;
    f32x4 acc[2][2][4][2];
#pragma unroll
    for (int a = 0; a < 2; ++a)
#pragma unroll
        for (int b = 0; b < 2; ++b)
#pragma unroll
            for (int m = 0; m < 4; ++m)
#pragma unroll
                for (int n = 0; n < 2; ++n) acc[a][b][m][n] = (f32x4){0.f, 0.f, 0.f, 0.f};
    bf16x8 At[4][2], B0[2][2], B1[2][2];
    const char* cA = PG8_UA(cur); const char* cB = PG8_UB(cur);
    PG8_STAGE(PG8_SB(0, 0), cB, voffB); PG8_STAGE(PG8_SB(0, 1), cB + hstep, voffB); PG8_STAGE(PG8_SA(0, 0), cA, voffA); PG8_STAGE(PG8_SA(0, 1), cA + hstep, voffA);
    if (wr == 1) PG8_BAR;
    PG8_WAIT_V(2); PG8_BAR;
    PG8_STAGE(PG8_SB(1, 0), cB + kstep, voffB); PG8_STAGE(PG8_SA(1, 0), cA + kstep, voffA); PG8_STAGE(PG8_SB(1, 1), cB + hstep + kstep, voffB);
    PG8_WAIT_V(6); PG8_BAR;
    for (;;) {
        const bool has_next = S.next(ui + 1, nxt);
        const char* nA = has_next ? PG8_UA(nxt) : cA; const char* nB = has_next ? PG8_UB(nxt) : cB;
        for (int t = 0; t < nt; t += 2) {
            const bool last = (t == nt - 2);
            const char* a1 = cA + (size_t)(t + 1) * kstep;
            const char* a2 = last ? nA : cA + (size_t)(t + 2) * kstep; const char* b2 = last ? nB : cB + (size_t)(t + 2) * kstep;
            const char* a3 = a2 + kstep; const char* b3 = b2 + kstep;
            PG8_LDB(B0, 0, 0); PG8_LDB(B1, 0, 1); PG8_SCHED; PG8_LDA(At, 0, 0); PG8_STAGE(PG8_SA(1, 1), a1 + hstep, voffA);
            PG8_WAIT_V(8); PG8_WAIT_L(0); PG8_BAR; PG8_MMA(0, 0, At, B0); PG8_MMA(0, 1, At, B1); PG8_BAR; PG8_SCHED;
            PG8_LDA(At, 0, 1); PG8_STAGE(PG8_SB(0, 0), b2, voffB); PG8_STAGE(PG8_SB(0, 1), b2 + hstep, voffB); PG8_STAGE(PG8_SA(0, 0), a2, voffA);
            PG8_WAIT_V(8); PG8_WAIT_L(0); PG8_BAR; PG8_MMA(1, 0, At, B0); PG8_MMA(1, 1, At, B1); PG8_BAR; PG8_SCHED;
            PG8_LDB(B0, 1, 0); PG8_LDB(B1, 1, 1); PG8_SCHED; PG8_LDA(At, 1, 0); PG8_STAGE(PG8_SA(0, 1), a2 + hstep, voffA);
            PG8_WAIT_V(8); PG8_WAIT_L(0); PG8_BAR; PG8_MMA(0, 0, At, B0); PG8_MMA(0, 1, At, B1); PG8_BAR; PG8_SCHED;
            PG8_LDA(At, 1, 1); PG8_STAGE(PG8_SB(1, 0), b3, voffB); PG8_STAGE(PG8_SB(1, 1), b3 + hstep, voffB); PG8_STAGE(PG8_SA(1, 0), a3, voffA);
            PG8_WAIT_V(8); PG8_WAIT_L(0); PG8_BAR; PG8_MMA(1, 0, At, B0); PG8_MMA(1, 1, At, B1); PG8_BAR; PG8_SCHED;
        }
        if (wr == 0) PG8_BAR;
        E(acc, cur, wr, wc, fr, fq);
        if (!has_next) break;
#pragma unroll
        for (int a = 0; a < 2; ++a)
#pragma unroll
            for (int b = 0; b < 2; ++b)
#pragma unroll
                for (int m = 0; m < 4; ++m)
#pragma unroll
                    for (int n = 0; n < 2; ++n) acc[a][b][m][n] = (f32x4){0.f, 0.f, 0.f, 0.f};
        cur = nxt; cA = nA; cB = nB; ++ui;
        if (wr == 1) PG8_BAR;
    }
    PG8_WAIT_V(0);
    PG8_BAR;
#undef PG8_SA
#undef PG8_SB
#undef PG8_STAGE
#undef PG8_LDA
#undef PG8_LDB
#undef PG8_MMA
#undef PG8_WAIT_V
#undef PG8_WAIT_L
#undef PG8_BAR
#undef PG8_SCHED
#undef PG8_UA
#undef PG8_UB
}

struct EpiRelu2 {
    static constexpr bool PERM = true;
    bf16_t* O; int ldc;
    __device__ __forceinline__ void operator()(const f32x4 (&acc)[2][2][4][2], const Unit& u, int wr, int wc, int fr, int fq) const {
        const int row0 = u.pm * BM + wr * 64 + fr, col0 = u.pn * BM + wc * 32 + 8 * fq;
#pragma unroll
        for (int ai = 0; ai < 2; ++ai)
#pragma unroll
            for (int m = 0; m < 4; ++m) { bf16_t* rowp = O + (size_t)(row0 + ai * HALF + m * 16) * ldc + col0;
#pragma unroll
                for (int bj = 0; bj < 2; ++bj) { f32x4 v0 = acc[ai][bj][m][0], v1 = acc[ai][bj][m][1];
#pragma unroll
                    for (int j = 0; j < 4; ++j) { const float a = fmaxf(v0[j], 0.f), b = fmaxf(v1[j], 0.f); v0[j] = a * a; v1[j] = b * b; }
                    u32x4 w; w.x = pk2(v0[0], v0[1]); w.y = pk2(v0[2], v0[3]); w.z = pk2(v1[0], v1[1]); w.w = pk2(v1[2], v1[3]);
                    *(u32x4*)(rowp + bj * HALF) = w; } }
    }
};
struct EpiResid {
    static constexpr bool PERM = true;
    const float* res0; const float* res1; float* X; bf16_t* P1; const float* gate; const bf16_t* Pin;
    __device__ __forceinline__ void operator()(const f32x4 (&acc)[2][2][4][2], const Unit& u, int wr, int wc, int fr, int fq) const {
        const int vec = u.pm < 16 ? 0 : (u.pm < 24 ? 1 : 2);
        const float* gv_ = gate + vec * 6144; const float* rs = u.pm < 16 ? res0 : res1;
        const int col0 = u.pn * BM + wc * 32 + 8 * fq;
        f32x4 gv[2][2];
#pragma unroll
        for (int bj = 0; bj < 2; ++bj)
#pragma unroll
            for (int n = 0; n < 2; ++n) gv[bj][n] = *(const f32x4*)(gv_ + col0 + bj * HALF + n * 4);
#pragma unroll
        for (int ai = 0; ai < 2; ++ai)
#pragma unroll
            for (int m = 0; m < 4; ++m) { const size_t off = (size_t)(u.pm * BM + ai * HALF + wr * 64 + m * 16 + fr) * D + col0;
#pragma unroll
                for (int bj = 0; bj < 2; ++bj) {
                    const size_t e = off + bj * HALF;
                    f32x4 o0 = gv[bj][0] * acc[ai][bj][m][0], o1 = gv[bj][1] * acc[ai][bj][m][1];
                    if (u.ks == 0) { o0 += *(const f32x4*)(rs + e); o1 += *(const f32x4*)(rs + e + 4);
                        if (Pin) { const u32x4 pw = *(const u32x4*)(Pin + e);
                            o0[0] += __builtin_bit_cast(float, pw.x << 16); o0[1] += __builtin_bit_cast(float, pw.x & 0xffff0000u); o0[2] += __builtin_bit_cast(float, pw.y << 16); o0[3] += __builtin_bit_cast(float, pw.y & 0xffff0000u);
                            o1[0] += __builtin_bit_cast(float, pw.z << 16); o1[1] += __builtin_bit_cast(float, pw.z & 0xffff0000u); o1[2] += __builtin_bit_cast(float, pw.w << 16); o1[3] += __builtin_bit_cast(float, pw.w & 0xffff0000u); }
                        *(f32x4*)(X + e) = o0; *(f32x4*)(X + e + 4) = o1; }
                    else { u32x4 w; w.x = pk2(o0[0], o0[1]); w.y = pk2(o0[2], o0[3]); w.z = pk2(o1[0], o1[1]); w.w = pk2(o1[2], o1[3]); *(u32x4*)(P1 + e) = w; } } }
    }
};
struct EpiGlu {
    static constexpr bool PERM = true;
    float* X; const float* gate; const bf16_t* Pin;
    __device__ __forceinline__ void operator()(const f32x4 (&acc)[2][2][4][2], const Unit& u, int wr, int wc, int fr, int fq) const {
        const int vec = u.pm < 16 ? 0 : (u.pm < 24 ? 1 : 2);
        const float* gv_ = gate + vec * 6144;
        const int col0 = u.pn * HALF + wc * 32 + 8 * fq;
        f32x4 gv[2];
#pragma unroll
        for (int n = 0; n < 2; ++n) gv[n] = *(const f32x4*)(gv_ + col0 + n * 4);
#pragma unroll
        for (int ai = 0; ai < 2; ++ai)
#pragma unroll
            for (int m = 0; m < 4; ++m) { const size_t off = (size_t)(u.pm * BM + ai * HALF + wr * 64 + m * 16 + fr) * D + col0;
#pragma unroll
                for (int n = 0; n < 2; ++n) { const f32x4 a = acc[ai][0][m][n], b = acc[ai][1][m][n]; f32x4 o;
#pragma unroll
                    for (int j = 0; j < 4; ++j) o[j] = a[j] / (1.f + __expf(-b[j]));
                    const size_t e = off + n * 4; f32x4 xo = *(const f32x4*)(X + e) + gv[n] * o;
                    { const u32x2 pw = *(const u32x2*)(Pin + e); xo[0] += __builtin_bit_cast(float, pw.x << 16); xo[1] += __builtin_bit_cast(float, pw.x & 0xffff0000u); xo[2] += __builtin_bit_cast(float, pw.y << 16); xo[3] += __builtin_bit_cast(float, pw.y & 0xffff0000u); }
                    *(f32x4*)(X + e) = xo; } }
    }
};
struct EpiQkv {
    static constexpr bool PERM = false;
    bf16_t* QB; bf16_t* KB; bf16_t* VT; float* outK; float* outV; const float* ropec; const float* ropes;
    __device__ __forceinline__ void operator()(const f32x4 (&acc)[2][2][4][2], const Unit& u, int wr, int wc, int fr, int fq) const {
        const bool lat = u.pm >= 16;
#pragma unroll
        for (int ai = 0; ai < 2; ++ai)
#pragma unroll
            for (int m = 0; m < 4; ++m) {
                const int row = u.pm * BM + ai * HALF + wr * 64 + m * 16 + fr;
                f32x4 cs = {1.f, 1.f, 1.f, 1.f}, sn = {0.f, 0.f, 0.f, 0.f};
                if (lat && u.pn < 5) { const int tp = row & 2047; cs = *(const f32x4*)(ropec + tp * 32 + (wc & 1) * 16 + 4 * fq); sn = *(const f32x4*)(ropes + tp * 32 + (wc & 1) * 16 + 4 * fq); }
#pragma unroll
                for (int bj = 0; bj < 2; ++bj) {
                    f32x4 x1 = acc[ai][bj][m][0], x2 = acc[ai][bj][m][1];
                    const int cl = bj * HALF + wc * 32 + 4 * fq;
                    if (u.pn < 5) {
                        f32x4 y1 = x1 * cs - x2 * sn, y2 = x1 * sn + x2 * cs;
                        if (u.pn < 4) { y1 = y1 * (0.125f * 1.44269504089f); y2 = y2 * (0.125f * 1.44269504089f); }
                        bf16_t* dst = (u.pn < 4) ? (QB + (size_t)row * D + u.pn * BM + cl) : (KB + (size_t)row * 256 + cl);
                        u32x2 w1, w2; w1.x = pk2(y1[0], y1[1]); w1.y = pk2(y1[2], y1[3]); w2.x = pk2(y2[0], y2[1]); w2.y = pk2(y2[2], y2[3]);
                        *(u32x2*)dst = w1; *(u32x2*)(dst + 16) = w2;
                        if (u.pn == 4 && !lat) { *(f32x4*)(outK + (size_t)row * 256 + cl) = x1; *(f32x4*)(outK + (size_t)row * 256 + cl + 16) = x2; }
                    } else {
#pragma unroll
                        for (int j = 0; j < 4; ++j) { VT[(size_t)(cl + j) * KROWS + row] = (bf16_t)(pk2(x1[j], 0.f) & 0xffffu); VT[(size_t)(cl + 16 + j) * KROWS + row] = (bf16_t)(pk2(x2[j], 0.f) & 0xffffu); }
                        if (!lat) { *(f32x4*)(outV + (size_t)row * 256 + cl) = x1; *(f32x4*)(outV + (size_t)row * 256 + cl + 16) = x2; }
                    }
                }
            }
    }
};
}

DI void transpose_item(const float* W, int K, int N, bf16_t* WT, int k0, int n0, int drow0, LAS float* scr, int lane) {
#pragma unroll 8
    for (int i = 0; i < 32; ++i) { const int kk = 2 * i + (lane >> 5); scr[kk * 33 + (lane & 31)] = W[(size_t)(k0 + kk) * N + n0 + (lane & 31)]; }
    asm volatile("" ::: "memory");
    const int c = lane & 7;
#pragma unroll
    for (int j = 0; j < 4; ++j) { const int n = (lane >> 3) + 8 * j; const LAS float* s = scr + (8 * c) * 33 + n;
        u32x4 o; o.x = pk2(s[0 * 33], s[1 * 33]); o.y = pk2(s[2 * 33], s[3 * 33]); o.z = pk2(s[4 * 33], s[5 * 33]); o.w = pk2(s[6 * 33], s[7 * 33]);
        *(u32x4*)(WT + (size_t)(drow0 + n) * K + k0 + 8 * c) = o; }
    asm volatile("" ::: "memory");
}
DI void transpose_mat(const float* W, int K, int N, bf16_t* WT, int item, LAS float* scr, int lane, int glu  ) {
    const int nblk = N / 32, kb = item / nblk, nb = item % nblk, n0 = 32 * nb;
    int drow0 = n0;
    if (glu) drow0 = 256 * (n0 >> 7) + (n0 & 127) + (glu == 2 ? 128 : 0);
    transpose_item(W, K, N, WT, 64 * kb, n0, drow0, scr, lane);
}

DI void prep_phase(const Params& P, LAS unsigned char* lds) {
    const int tid = threadIdx.x, wid = tid >> 6, lane = tid & 63, G = gridDim.x, bid = blockIdx.x;
    unsigned char* ws = P.ws;
    if (bid < 192) {
        LAS float* sl = (LAS float*)lds;
        LAS float* red = (LAS float*)(lds + 12288);
        for (int e = tid; e < 3072; e += 512) { const int v = e >> 10, k = e & 1023; const float x = (v == 0) ? P.in[6][k] : P.in[5][(v - 1) * 1024 + k]; sl[e] = x / (1.f + __expf(-x)); }
        __syncthreads();
        const int l = bid / 96, n0 = (bid % 96) * 64, cq = lane & 15, kr = lane >> 4;
        const float* wm = P.in[9] + (size_t)l * 1024 * 6144 + n0 + 4 * cq;
        f32x4 a0 = {0.f, 0.f, 0.f, 0.f}, a1 = a0, a2 = a0;
#pragma unroll
        for (int hb = 0; hb < 2; ++hb) { f32x4 wv[16];
#pragma unroll
            for (int i = 0; i < 16; ++i) wv[i] = *(const f32x4*)(wm + (size_t)(128 * wid + 4 * (16 * hb + i) + kr) * 6144);
#pragma unroll
            for (int i = 0; i < 16; ++i) { const int k = 128 * wid + 4 * (16 * hb + i) + kr; a0 += wv[i] * sl[k]; a1 += wv[i] * sl[1024 + k]; a2 += wv[i] * sl[2048 + k]; } }
#pragma unroll
        for (int j = 0; j < 4; ++j) { a0[j] += __shfl_xor(a0[j], 16); a0[j] += __shfl_xor(a0[j], 32); a1[j] += __shfl_xor(a1[j], 16); a1[j] += __shfl_xor(a1[j], 32); a2[j] += __shfl_xor(a2[j], 16); a2[j] += __shfl_xor(a2[j], 32); }
        if (kr == 0) { *(LAS f32x4*)(red + (wid * 3 + 0) * 64 + 4 * cq) = a0; *(LAS f32x4*)(red + (wid * 3 + 1) * 64 + 4 * cq) = a1; *(LAS f32x4*)(red + (wid * 3 + 2) * 64 + 4 * cq) = a2; }
        __syncthreads();
        if (tid < 192) { const int v = tid >> 6, cc = tid & 63; float s = P.in[10][l * 6144 + n0 + cc];
#pragma unroll
            for (int w = 0; w < 8; ++w) s += red[(w * 3 + v) * 64 + cc];
            ((float*)(ws + WS_MOD))[(l * 3 + v) * 6144 + n0 + cc] = s; }
    }
    {
        LAS float* scr = (LAS float*)(lds + 32768 + wid * 8704);
        const int gw = bid * 8 + wid, NGW = G * 8;
        constexpr int I_QKV = 16 * 48, I_O = 16 * 32, I_G = 16 * 32, I_1 = 16 * 128, I_2 = 64 * 32;
        constexpr int NIT = I_QKV + I_O + 2 * I_G + 2 * I_1 + 2 * I_2;
        for (int it = gw; it < NIT; it += NGW) {
            int r = it;
            if (r < I_QKV) { transpose_mat(P.in[11], 1024, 1536, (bf16_t*)(ws + WS_WQKV), r, scr, lane, 0); continue; } r -= I_QKV;
            if (r < I_O) { transpose_mat(P.in[12], 1024, 1024, (bf16_t*)(ws + WS_WO), r, scr, lane, 0); continue; } r -= I_O;
            if (r < I_G) { transpose_mat(P.in[22], 1024, 1024, (bf16_t*)(ws + WS_WGLU), r, scr, lane, 1); continue; } r -= I_G;
            if (r < I_G) { transpose_mat(P.in[23], 1024, 1024, (bf16_t*)(ws + WS_WGLU), r, scr, lane, 2); continue; } r -= I_G;
            if (r < 2 * I_1) { const int l = r / I_1; transpose_mat(P.in[24] + (size_t)l * D * FF, 1024, 4096, (bf16_t*)(ws + WS_W1) + (size_t)l * D * FF, r % I_1, scr, lane, 0); continue; } r -= 2 * I_1;
            { const int l = r / I_2; transpose_mat(P.in[25] + (size_t)l * D * FF, 4096, 1024, (bf16_t*)(ws + WS_W2) + (size_t)l * D * FF, r % I_2, scr, lane, 0); }
        }
    }
    const int gt = bid * 512 + tid, NGT = G * 512;
    for (int e = gt; e < 2 * 256 * 256; e += NGT) {
        const int tok = e >> 8, c = e & 255;
        ((bf16_t*)(ws + WS_KB))[(size_t)(T + tok) * 256 + c] = (bf16_t)(pk2(P.in[2][e], 0.f) & 0xffffu);
    }
    for (int e = gt; e < 2 * 256 * 256; e += NGT) {
        const int c = e >> 9, tok = e & 511;
        ((bf16_t*)(ws + WS_VT))[(size_t)c * KROWS + T + tok] = (bf16_t)(pk2(P.in[3][tok * 256 + c], 0.f) & 0xffffu);
    }
    for (int e = gt; e < 2048 * 32; e += NGT) {
        const int tp = e >> 5, k = e & 31, f = k & 15; const float pos = (k >> 4) ? (float)(tp & 63) : (float)(tp >> 6);
        const float freq = powf(10000.f, -(float)f / 16.f); const float ang = pos * freq;
        ((float*)(ws + WS_ROPE))[e] = cosf(ang); ((float*)(ws + WS_ROPE))[2048 * 32 + e] = sinf(ang);
    }
    for (int idx = gt; idx < 2 * 64 * 64 * 16; idx += NGT) {
        const int e = idx >> 4, c = idx & 15, dg = e >> 6, p = e & 63;
        const float dt = expf(P.in[16][dg]), lre = P.in[14][e], lim = P.in[15][e];
        const float mag = expf(lre * dt), ang = lim * dt; const float are = mag * cosf(ang), aim = mag * sinf(ang);
        const float den = lre * lre + lim * lim, nre = are - 1.f, nim = aim;
        const float fre = (nre * lre + nim * lim) / den, fim = (nim * lre - nre * lim) / den;
        if (c == 0) { ((float*)(ws + WS_ABAR))[e * 2] = are; ((float*)(ws + WS_ABAR))[e * 2 + 1] = aim; }
        bf16_t* bbm = (bf16_t*)(ws + WS_BBM) + (size_t)dg * 128 * 16; bf16_t* ccm = (bf16_t*)(ws + WS_CCM) + (size_t)dg * 16 * 128;
        const float br = P.in[17][idx], bi = P.in[18][idx];
        bbm[p * 16 + c] = (bf16_t)(pk2(fre * br - fim * bi, 0.f) & 0xffffu);
        bbm[(64 + p) * 16 + c] = (bf16_t)(pk2(fre * bi + fim * br, 0.f) & 0xffffu);
        const float cr = P.in[19][((size_t)dg * 16 + c) * 64 + p], ci = P.in[20][((size_t)dg * 16 + c) * 64 + p];
        const int k = 4 * (p & 31) + 2 * (p >> 5);
        ccm[c * 128 + k] = (bf16_t)(pk2(cr, 0.f) & 0xffffu); ccm[c * 128 + k + 1] = (bf16_t)(pk2(-ci, 0.f) & 0xffffu);
    }
}

template <int MODE>
DI void norm_phase(const Params& P, const float* gain, const float* modl, int sh_off, int sc_off, const bf16_t* P1) {
    const int tid = threadIdx.x, wid = tid >> 6, lane = tid & 63;
    float* X = (float*)(P.ws + WS_X); bf16_t* HB = (bf16_t*)(P.ws + WS_HB);
    for (int row = blockIdx.x * 8 + wid; row < T; row += gridDim.x * 8) {
        const float* src = (MODE == 0) ? (row < TCTX ? P.in[0] + (size_t)row * D : P.in[1] + (size_t)(row - TCTX) * D) : X + (size_t)row * D;
        f32x4 v[4]; float ss = 0.f;
#pragma unroll
        for (int j = 0; j < 4; ++j) { v[j] = *(const f32x4*)(src + 4 * lane + 256 * j);
            if (MODE >= 2) { const u32x2 pw = *(const u32x2*)(P1 + (size_t)row * D + 4 * lane + 256 * j);
                v[j][0] += __builtin_bit_cast(float, pw.x << 16); v[j][1] += __builtin_bit_cast(float, pw.x & 0xffff0000u); v[j][2] += __builtin_bit_cast(float, pw.y << 16); v[j][3] += __builtin_bit_cast(float, pw.y & 0xffff0000u);
                }
            ss += (v[j][0] * v[j][0] + v[j][1] * v[j][1]) + (v[j][2] * v[j][2] + v[j][3] * v[j][3]); }
        const float rinv = rsqrtf(wave_sum(ss) * (1.f / D) + 1e-6f);
        if (MODE == 3) {
#pragma unroll
            for (int j = 0; j < 4; ++j) { const f32x4 g = *(const f32x4*)(gain + 4 * lane + 256 * j); *(f32x4*)(P.out + (size_t)row * D + 4 * lane + 256 * j) = v[j] * rinv * g; }
        } else {
            const int vec = row < TCTX ? 0 : (row < TCTX + LLAT ? 1 : 2); const float* mv = modl + vec * 6144;
#pragma unroll
            for (int j = 0; j < 4; ++j) { const int c = 4 * lane + 256 * j; const f32x4 g = *(const f32x4*)(gain + c), sc = *(const f32x4*)(mv + sc_off + c), sh = *(const f32x4*)(mv + sh_off + c);
                const f32x4 h = (v[j] * rinv * g) * (sc + 1.f) + sh; u32x2 w; w.x = pk2(h[0], h[1]); w.y = pk2(h[2], h[3]); *(u32x2*)(HB + (size_t)row * D + c) = w; }
        }
    }
}

DI void attn_phase(const Params& P, LAS unsigned char* lds) {
    const int tid = threadIdx.x, wid = tid >> 6, lane = tid & 63, r = lane & 15, g4 = lane >> 4;
    const bf16_t* QB = (const bf16_t*)(P.ws + WS_QB); const bf16_t* KB = (const bf16_t*)(P.ws + WS_KB); const bf16_t* VT = (const bf16_t*)(P.ws + WS_VT); bf16_t* OB = (bf16_t*)(P.ws + WS_OB);
    const float LOG2E = 1.44269504089f;
    const int lrow = tid >> 3, lch = tid & 7;
    for (int u = blockIdx.x; u < 1024; u += gridDim.x) {
        int h, tok0, win0, nwin, ctx0, ipos0; bool lat;
        if (u < 512) { const int b = u >> 5; h = (u >> 1) & 15; const int n = u & 1; tok0 = 256 * b + 128 * n; win0 = 0; nwin = 0; ctx0 = 256 * b; lat = false; ipos0 = 0; }
        else { const int v = u - 512, b = v >> 8; h = (v >> 4) & 15; const int n = v & 15; const int tb = TCTX + LLAT * b; tok0 = tb + 128 * n;
            const int j0 = (128 * n - 128) < 0 ? 0 : (128 * n - 128), j1 = (128 * n + 256) > LLAT ? LLAT : (128 * n + 256);
            win0 = tb + j0; nwin = (j1 - j0) >> 6; ctx0 = T + 256 * b; lat = true; ipos0 = 128 * n - j0; }
        const int kvh = h >> 2, ntile = nwin + 4;
        const bf16_t* qp = QB + (size_t)(tok0 + 16 * wid + r) * D + h * 64 + 8 * g4;
        const bf16x8 qb0 = *(const bf16x8*)qp, qb1 = *(const bf16x8*)(qp + 32);
        float m_run = P.in[13][h] * LOG2E, l_run = (g4 == 0) ? 1.f : 0.f;
        f32x4 o[4];
#pragma unroll
        for (int dt = 0; dt < 4; ++dt) o[dt] = (f32x4){0.f, 0.f, 0.f, 0.f};
        const int iq = ipos0 + 16 * wid + r;
        u32x4 kreg, vreg;
        { const int tk = (0 < nwin) ? win0 : ctx0;
          kreg = *(const u32x4*)(KB + (size_t)(tk + lrow) * 256 + kvh * 64 + lch * 8); vreg = *(const u32x4*)(VT + (size_t)(kvh * 64 + lrow) * KROWS + tk + lch * 8); }
        *(LAS u32x4*)(lds + lrow * 144 + lch * 16) = kreg; *(LAS u32x4*)(lds + 9216 + lrow * 144 + lch * 16) = vreg;
        __syncthreads();
        for (int t = 0; t < ntile; ++t) {
            LAS unsigned char* Kb = lds + (t & 1) * 18432; LAS unsigned char* Vb = Kb + 9216;
            if (t + 1 < ntile) { const int tk = (t + 1 < nwin) ? win0 + 64 * (t + 1) : ctx0 + 64 * (t + 1 - nwin);
                kreg = *(const u32x4*)(KB + (size_t)(tk + lrow) * 256 + kvh * 64 + lch * 8); vreg = *(const u32x4*)(VT + (size_t)(kvh * 64 + lrow) * KROWS + tk + lch * 8); }
            int cls = 0;
            if (lat && t < nwin) { const int iq0 = ipos0 + 16 * wid, dmin = 64 * t - (iq0 + 15), dmax = 64 * t + 63 - iq0; cls = (dmax < -128 || dmin > 128) ? 2 : ((dmin >= -128 && dmax <= 128) ? 0 : 1); }
            if (cls != 2) {
            f32x4 s[4];
#pragma unroll
            for (int kt = 0; kt < 4; ++kt) {
                const bf16x8 a0 = *(const LAS bf16x8*)(Kb + (16 * kt + r) * 144 + g4 * 16), a1 = *(const LAS bf16x8*)(Kb + (16 * kt + r) * 144 + 64 + g4 * 16);
                f32x4 z = {0.f, 0.f, 0.f, 0.f};
                z = __builtin_amdgcn_mfma_f32_16x16x32_bf16(a0, qb0, z, 0, 0, 0);
                s[kt] = __builtin_amdgcn_mfma_f32_16x16x32_bf16(a1, qb1, z, 0, 0, 0);
            }
            float mx = -3.0e38f;
            if (cls == 1) {
#pragma unroll
                for (int kt = 0; kt < 4; ++kt)
#pragma unroll
                    for (int i = 0; i < 4; ++i) { const int dj = 64 * t + 16 * kt + 4 * g4 + i - iq; if (dj > 128 || dj < -128) s[kt][i] = -1.0e30f; }
            }
#pragma unroll
            for (int kt = 0; kt < 4; ++kt)
#pragma unroll
                for (int i = 0; i < 4; ++i) mx = fmaxf(mx, s[kt][i]);
            mx = fmaxf(mx, __shfl_xor(mx, 16)); mx = fmaxf(mx, __shfl_xor(mx, 32));
            const float mnew = fmaxf(m_run, mx), alpha = __builtin_amdgcn_exp2f(m_run - mnew); m_run = mnew;
            float ls = 0.f;
#pragma unroll
            for (int kt = 0; kt < 4; ++kt)
#pragma unroll
                for (int i = 0; i < 4; ++i) { const float p = __builtin_amdgcn_exp2f(s[kt][i] - mnew); s[kt][i] = p; ls += p; }
            l_run = l_run * alpha + ls;
#pragma unroll
            for (int dt = 0; dt < 4; ++dt) o[dt] *= alpha;
            u32x4 pw01, pw23;
            pw01.x = pk2(s[0][0], s[0][1]); pw01.y = pk2(s[0][2], s[0][3]); pw01.z = pk2(s[1][0], s[1][1]); pw01.w = pk2(s[1][2], s[1][3]);
            pw23.x = pk2(s[2][0], s[2][1]); pw23.y = pk2(s[2][2], s[2][3]); pw23.z = pk2(s[3][0], s[3][1]); pw23.w = pk2(s[3][2], s[3][3]);
            const bf16x8 pb01 = __builtin_bit_cast(bf16x8, pw01), pb23 = __builtin_bit_cast(bf16x8, pw23);
#pragma unroll
            for (int dt = 0; dt < 4; ++dt) {
                const LAS unsigned char* vr = Vb + (16 * dt + r) * 144 + g4 * 8;
                u32x4 va; const u32x2 l0 = *(const LAS u32x2*)(vr), h0 = *(const LAS u32x2*)(vr + 32), l1 = *(const LAS u32x2*)(vr + 64), h1 = *(const LAS u32x2*)(vr + 96);
                va.x = l0.x; va.y = l0.y; va.z = h0.x; va.w = h0.y;
                o[dt] = __builtin_amdgcn_mfma_f32_16x16x32_bf16(__builtin_bit_cast(bf16x8, va), pb01, o[dt], 0, 0, 0);
                va.x = l1.x; va.y = l1.y; va.z = h1.x; va.w = h1.y;
                o[dt] = __builtin_amdgcn_mfma_f32_16x16x32_bf16(__builtin_bit_cast(bf16x8, va), pb23, o[dt], 0, 0, 0);
            }
            }
            if (t + 1 < ntile) { LAS unsigned char* Kn = lds + ((t + 1) & 1) * 18432; *(LAS u32x4*)(Kn + lrow * 144 + lch * 16) = kreg; *(LAS u32x4*)(Kn + 9216 + lrow * 144 + lch * 16) = vreg; }
            __syncthreads();
        }
        float l = l_run; l += __shfl_xor(l, 16); l += __shfl_xor(l, 32);
        const float inv = 1.f / l;
        bf16_t* op = OB + (size_t)(tok0 + 16 * wid + r) * D + h * 64 + 4 * g4;
#pragma unroll
        for (int dt = 0; dt < 4; ++dt) { u32x2 w; w.x = pk2(o[dt][0] * inv, o[dt][1] * inv); w.y = pk2(o[dt][2] * inv, o[dt][3] * inv); *(u32x2*)(op + 16 * dt) = w; }
    }
}

constexpr size_t WS_E = 232 * MiB;
struct SsmItem { int g, k, nchunk, seqX, tokX, tokY; bool lat; };
DI SsmItem ssm_item(int gw) {
    SsmItem it; int pi;
    if (gridDim.x == 256) { const int bid = gw & 255, wid = gw >> 8; it.g = (bid & 7) * 8 + ((bid >> 3) & 7); pi = wid * 4 + (bid >> 6); }
    else { it.g = gw & 63; pi = gw >> 6; }
    if (pi < 16) { const int sp = pi >> 1; it.k = pi & 1; it.nchunk = 2; it.seqX = 2 * sp; it.tokX = 512 * sp + 128 * it.k; it.tokY = it.tokX + 256; it.lat = false; }
    else { it.k = pi - 16; it.nchunk = 16; it.seqX = 16; it.tokX = TCTX + 128 * it.k; it.tokY = it.tokX + LLAT; it.lat = true; }
    return it;
}
DI size_t ssm_eidx(int dir, int seq, int chunk, int g) { return ((((size_t)dir * 18 + seq) * 16 + chunk) * 64 + g) * 128; }

#define SSM_SCAN_STEP(i, WRITE_S) { const float nr0 = ar0 * sr0 - ai0 * si0 + acc[0][i], ni0 = ar0 * si0 + ai0 * sr0 + acc[2][i]; \
        const float nr1 = ar1 * sr1 - ai1 * si1 + acc[1][i], ni1 = ar1 * si1 + ai1 * sr1 + acc[3][i]; \
        sr0 = nr0; si0 = ni0; sr1 = nr1; si1 = ni1; \
        if (WRITE_S) { u32x2 w; w.x = pk2(nr0, ni0); w.y = pk2(nr1, ni1); *(LAS u32x2*)(S + (16 * h + (i)) * 272 + p * 8) = w; } }

DI void ssm_pass1(const Params& P) {
    const int tid = threadIdx.x, wid = tid >> 6, lane = tid & 63, p = lane & 31, h = lane >> 5;
    const int gw = wid * gridDim.x + blockIdx.x;
    if (gw >= 2048) return;
    const SsmItem it = ssm_item(gw);
    const bf16_t* HB = (const bf16_t*)(P.ws + WS_HB);
    float* E = (float*)(P.ws + WS_E);
    const int hh = (p >> 2) & 1, ii = 4 * (p >> 3) + (p & 3);
    const bf16_t* ubase = HB + (size_t)((hh ? it.tokY : it.tokX) + ii) * D + 16 * it.g + 8 * h;
    bf16x8 a[8];
#pragma unroll
    for (int t = 0; t < 8; ++t) a[t] = *(const bf16x8*)(ubase + (size_t)(16 * t) * D);
    LAS unsigned char* S = nullptr;
#pragma unroll
    for (int dir = 0; dir < 2; ++dir) {
        const int dg = dir * 64 + it.g;
        const float* ab = (const float*)(P.ws + WS_ABAR) + (size_t)dg * 128;
        const float ar0 = ab[2 * p], ai0 = ab[2 * p + 1], ar1 = ab[2 * (p + 32)], ai1 = ab[2 * (p + 32) + 1];
        bf16x8 bbq[4];
#pragma unroll
        for (int q = 0; q < 4; ++q) bbq[q] = *(const bf16x8*)((const bf16_t*)(P.ws + WS_BBM) + ((size_t)dg * 128 + q * 32 + p) * 16 + 8 * h);
        float sr0 = 0.f, si0 = 0.f, sr1 = 0.f, si1 = 0.f;
#pragma unroll
        for (int tt = 0; tt < 8; ++tt) {
            const int ti = dir ? 7 - tt : tt;
            f32x16 acc[4];
#pragma unroll
            for (int q = 0; q < 4; ++q) { f32x16 z;
#pragma unroll
                for (int i = 0; i < 16; ++i) z[i] = 0.f;
                acc[q] = __builtin_amdgcn_mfma_f32_32x32x16_bf16(a[ti], bbq[q], z, 0, 0, 0); }
            if (dir == 0) {
#pragma unroll
                for (int i = 0; i < 16; ++i) SSM_SCAN_STEP(i, false)
            } else {
#pragma unroll
                for (int i = 15; i >= 0; --i) SSM_SCAN_STEP(i, false)
            }
        }
        float* e = E + ssm_eidx(dir, it.seqX + h, it.k, it.g);
        e[p] = sr0; e[p + 32] = sr1; e[64 + p] = si0; e[64 + p + 32] = si1;
    }
}

template <int DIR>
DI void ssm_dir(const Params& P, const SsmItem& it, LAS unsigned char* S, f32x4 (&st)[8][2], int lane) {
    const int p = lane & 31, h = lane >> 5, c16 = lane & 15, g4 = lane >> 4;
    const int dg = DIR * 64 + it.g;
    const float* ab = (const float*)(P.ws + WS_ABAR) + (size_t)dg * 128;
    const float ar0 = ab[2 * p], ai0 = ab[2 * p + 1], ar1 = ab[2 * (p + 32)], ai1 = ab[2 * (p + 32) + 1];
    bf16x8 bbq[4], ccb[4];
#pragma unroll
    for (int q = 0; q < 4; ++q) bbq[q] = *(const bf16x8*)((const bf16_t*)(P.ws + WS_BBM) + ((size_t)dg * 128 + q * 32 + p) * 16 + 8 * h);
#pragma unroll
    for (int ks = 0; ks < 4; ++ks) ccb[ks] = *(const bf16x8*)((const bf16_t*)(P.ws + WS_CCM) + ((size_t)dg * 16 + c16) * 128 + 32 * ks + 8 * g4);
    const bf16_t* HB = (const bf16_t*)(P.ws + WS_HB);
    float sr0 = 0.f, si0 = 0.f, sr1 = 0.f, si1 = 0.f;
    const int seq = it.seqX + h;
    if (it.lat) { const float* s0 = P.in[4] + ((size_t)(h * 2 + DIR) * 2) * 4096 + it.g * 64; sr0 = s0[p]; sr1 = s0[p + 32]; si0 = s0[4096 + p]; si1 = s0[4096 + p + 32]; }
    {
        const float* E = (const float*)(P.ws + WS_E);
        const int nj = DIR ? (it.nchunk - 1 - it.k) : it.k;
        float er0[15], er1[15], ei0[15], ei1[15];
#pragma unroll
        for (int jj = 0; jj < 15; ++jj) { int j = DIR ? (it.nchunk - 1 - jj) : jj; j = j < 0 ? 0 : j; j = j > it.nchunk - 1 ? it.nchunk - 1 : j;
            const float* e = E + ssm_eidx(DIR, seq, j, it.g); er0[jj] = e[p]; er1[jj] = e[p + 32]; ei0[jj] = e[64 + p]; ei1[jj] = e[64 + p + 32]; }
        float pr0 = ar0, pi0 = ai0, pr1 = ar1, pi1 = ai1;
#pragma unroll
        for (int q = 0; q < 7; ++q) { const float t0 = pr0 * pr0 - pi0 * pi0, t1 = 2.f * pr0 * pi0, t2 = pr1 * pr1 - pi1 * pi1, t3 = 2.f * pr1 * pi1; pr0 = t0; pi0 = t1; pr1 = t2; pi1 = t3; }
#pragma unroll
        for (int jj = 0; jj < 15; ++jj) {
            const float n0 = pr0 * sr0 - pi0 * si0 + er0[jj], m0 = pr0 * si0 + pi0 * sr0 + ei0[jj], n1 = pr1 * sr1 - pi1 * si1 + er1[jj], m1 = pr1 * si1 + pi1 * sr1 + ei1[jj];
            if (jj < nj) { sr0 = n0; si0 = m0; sr1 = n1; si1 = m1; }
        }
    }
    bf16_t* YB = (bf16_t*)(P.ws + WS_QB);
    bf16x8 dd;
    { const float dsk = P.in[21][16 * it.g + c16]; const unsigned short db = (unsigned short)(pk2(dsk, 0.f) & 0xffffu);
#pragma unroll
      for (int j = 0; j < 8; ++j) dd[j] = (g4 < 2 && (8 * g4 + j) == c16) ? (short)db : (short)0; }
    const int hh = (p >> 2) & 1, ii = 4 * (p >> 3) + (p & 3);
    const bf16_t* ubase = HB + (size_t)((hh ? it.tokY : it.tokX) + ii) * D + 16 * it.g + 8 * h;
    const bf16_t* uaX = HB + (size_t)(it.tokX + c16) * D + 16 * it.g + 8 * (g4 & 1);
    const bf16_t* uaY = HB + (size_t)(it.tokY + c16) * D + 16 * it.g + 8 * (g4 & 1);
    const bf16x8 zero8 = {0, 0, 0, 0, 0, 0, 0, 0};
    bf16x8 a_n = *(const bf16x8*)(ubase + (size_t)(DIR ? 112 : 0) * D), ux_n = zero8, uy_n = zero8;
    if (DIR == 0 && g4 < 2) { ux_n = *(const bf16x8*)(uaX); uy_n = *(const bf16x8*)(uaY); }
    for (int tt = 0; tt < 8; ++tt) {
        const int ti = DIR ? 7 - tt : tt;
        const bf16x8 a = a_n, ux = ux_n, uy = uy_n;
        if (tt < 7) { const int tn = DIR ? ti - 1 : ti + 1; a_n = *(const bf16x8*)(ubase + (size_t)(16 * tn) * D);
            if (DIR == 0 && g4 < 2) { ux_n = *(const bf16x8*)(uaX + (size_t)(16 * tn) * D); uy_n = *(const bf16x8*)(uaY + (size_t)(16 * tn) * D); } }
        f32x16 acc[4];
#pragma unroll
        for (int q = 0; q < 4; ++q) { f32x16 z;
#pragma unroll
            for (int i = 0; i < 16; ++i) z[i] = 0.f;
            acc[q] = __builtin_amdgcn_mfma_f32_32x32x16_bf16(a, bbq[q], z, 0, 0, 0); }
        if (DIR == 0) {
#pragma unroll
            for (int i = 0; i < 16; ++i) SSM_SCAN_STEP(i, true)
        } else {
#pragma unroll
            for (int i = 15; i >= 0; --i) SSM_SCAN_STEP(i, true)
        }
        asm volatile("" ::: "memory");
        f32x4 y[2];
        if (DIR) {
            y[0] = st[0][0]; y[1] = st[0][1];
#pragma unroll
            for (int q = 0; q < 7; ++q) { st[q][0] = st[q + 1][0]; st[q][1] = st[q + 1][1]; }
        } else { y[0] = (f32x4){0.f, 0.f, 0.f, 0.f}; y[1] = y[0];
            y[0] = __builtin_amdgcn_mfma_f32_16x16x32_bf16(ux, dd, y[0], 0, 0, 0); y[1] = __builtin_amdgcn_mfma_f32_16x16x32_bf16(uy, dd, y[1], 0, 0, 0); }
#pragma unroll
        for (int mt = 0; mt < 2; ++mt)
#pragma unroll
            for (int ks = 0; ks < 4; ++ks) { const bf16x8 sa = *(const LAS bf16x8*)(S + (16 * mt + c16) * 272 + 64 * ks + 16 * g4);
                y[mt] = __builtin_amdgcn_mfma_f32_16x16x32_bf16(sa, ccb[ks], y[mt], 0, 0, 0); }
        asm volatile("" ::: "memory");
        if (DIR == 0) {
#pragma unroll
            for (int q = 7; q > 0; --q) { st[q][0] = st[q - 1][0]; st[q][1] = st[q - 1][1]; }
            st[0][0] = y[0]; st[0][1] = y[1];
        } else {
#pragma unroll
            for (int mt = 0; mt < 2; ++mt) {
                const size_t base = (size_t)((mt ? it.tokY : it.tokX) + 16 * ti + 4 * g4) * D + 16 * it.g + c16;
#pragma unroll
                for (int i = 0; i < 4; ++i) { const float x = y[mt][i]; const float z = 1.5957691216f * (x + 0.044715f * x * x * x);
                    YB[base + (size_t)i * D] = (bf16_t)(pk2(x * __builtin_amdgcn_rcpf(1.f + __expf(-z)), 0.f) & 0xffffu); }
            }
        }
    }
    if (!it.lat && ((DIR == 0 && it.k == it.nchunk - 1) || (DIR == 1 && it.k == 0))) {
        float* so = P.out + OUT_S + ((size_t)seq * 2 + DIR) * 2 * 4096 + it.g * 64;
        so[p] = sr0; so[p + 32] = sr1; so[4096 + p] = si0; so[4096 + p + 32] = si1; }
}

DI void ssm_pass3(const Params& P, LAS unsigned char* lds) {
    const int tid = threadIdx.x, wid = tid >> 6, lane = tid & 63;
    const int gw = wid * gridDim.x + blockIdx.x;
    if (gw >= 2048) return;
    const SsmItem it = ssm_item(gw);
    LAS unsigned char* S = lds + wid * 8704;
    f32x4 st[8][2];
#pragma unroll
    for (int q = 0; q < 8; ++q) { st[q][0] = (f32x4){0.f, 0.f, 0.f, 0.f}; st[q][1] = st[q][0]; }
    ssm_dir<0>(P, it, S, st, lane);
    ssm_dir<1>(P, it, S, st, lane);
}
#undef SSM_SCAN_STEP

#define XB_TMO      128
#define XB_XCNT(j)  (256  + 64 * (j))
#define XB_XSUB(j)  (1280 + 64 * (j))
#define XB_XGEN(j)  (2304 + 64 * (j))
#define XB_TOP      3328
#define XB_TOPGEN   3392
#define XCD_BAR_WORDS 3456
#define XB_SPIN_CAP (1u << 18)
DI unsigned xb_ld(unsigned* p)              { return __hip_atomic_load(p, __ATOMIC_RELAXED, __HIP_MEMORY_SCOPE_AGENT); }
DI unsigned xb_add(unsigned* p, unsigned v) { return __hip_atomic_fetch_add(p, v, __ATOMIC_RELAXED, __HIP_MEMORY_SCOPE_AGENT); }
DI unsigned xb_xcc_id() { return (unsigned)__builtin_amdgcn_s_getreg((3 << 11) | 20) & 0xFu; }
#define XB_SPIN(cond, bar) do { unsigned _sp = 0; while (cond) { __builtin_amdgcn_s_sleep(1); \
    if ((++_sp & 255u) == 0u) { if (xb_ld(&(bar)[XB_TMO])) break; if (_sp > XB_SPIN_CAP) { atomicAdd(&(bar)[XB_TMO], 1u); break; } } } } while (0)
struct XcdBarrier { unsigned* bar; unsigned x; volatile LAS unsigned* st; };
DI XcdBarrier xcd_barrier_post(unsigned* bar, volatile LAS unsigned* st) {
    XcdBarrier b; b.bar = bar; b.x = xb_xcc_id(); b.st = st;
    if (threadIdx.x == 0) (void)xb_add(&bar[XB_XCNT(b.x)], 1u);
    return b;
}
DI void xcd_barrier_complete(unsigned* bar, unsigned x, unsigned& nloc, unsigned& nx) {
    const unsigned G = gridDim.x * gridDim.y * gridDim.z;
    unsigned sum, cnt, mine, sp = 0u;
    for (;;) {
        sum = 0u; cnt = 0u; mine = 0u;
#pragma unroll
        for (unsigned j = 0; j < 16; ++j) { const unsigned c = xb_ld(&bar[XB_XCNT(j)]); sum += c; cnt += (c > 0u) ? 1u : 0u; mine = (j == x) ? c : mine; }
        if (sum == G) break;
        __builtin_amdgcn_s_sleep(1);
        if ((++sp & 255u) == 0u) { if (xb_ld(&bar[XB_TMO])) break; if (sp > XB_SPIN_CAP) { atomicAdd(&bar[XB_TMO], 1u); break; } }
    }
    nloc = mine > 0u ? mine : 1u; nx = cnt > 0u ? cnt : 1u;
}
DI void xcd_barrier(const XcdBarrier& b) {
    asm volatile("s_waitcnt vmcnt(0)" ::: "memory");
    __syncthreads();
    if (threadIdx.x == 0) {
        unsigned* bar = b.bar;
        __builtin_amdgcn_s_waitcnt(0);
        unsigned nloc = b.st[0], nx = b.st[1];
        if (nloc == 0u) { xcd_barrier_complete(bar, b.x, nloc, nx); b.st[0] = nloc; b.st[1] = nx; }
        const unsigned old = xb_add(&bar[XB_XSUB(b.x)], 1u);
        const unsigned gen = old / nloc;
        if (old + 1u == (gen + 1u) * nloc) {
            __builtin_amdgcn_fence(__ATOMIC_RELEASE, "agent");
            asm volatile("s_waitcnt vmcnt(0)" ::: "memory");
            const unsigned og = xb_add(&bar[XB_TOP], 1u);
            const unsigned tg = og / nx;
            if (og + 1u == (tg + 1u) * nx) xb_add(&bar[XB_TOPGEN], 1u);
            else XB_SPIN(xb_ld(&bar[XB_TOPGEN]) == tg, bar);
            __builtin_amdgcn_fence(__ATOMIC_ACQUIRE, "agent");
            xb_add(&bar[XB_XGEN(b.x)], 1u);
            asm volatile("s_waitcnt vmcnt(0)" ::: "memory");
        } else {
            XB_SPIN(xb_ld(&bar[XB_XGEN(b.x)]) == gen, bar);
            __builtin_amdgcn_fence(__ATOMIC_ACQUIRE, "agent");
            asm volatile("s_waitcnt vmcnt(0)" ::: "memory");
        }
    }
    __syncthreads();
}

constexpr int NPHASE = 16;
#ifndef REPMASK
#define REPMASK 0
#endif
#ifndef EXTRA_SYNCS
#define EXTRA_SYNCS 0
#endif
constexpr int LDS_BYTES = 147456;
__global__ void __launch_bounds__(512, 2) fwd_kernel(Params P) {
    extern __shared__ __attribute__((aligned(16))) unsigned char lds_raw[];
    LAS unsigned char* lds = (LAS unsigned char*)lds_raw;
    cg::grid_group grid = cg::this_grid();
    unsigned char* ws = P.ws;
    const float* MOD = (const float*)(ws + WS_MOD);
    const int lo = P.ph_lo, hi = P.ph_hi, G = gridDim.x;
    volatile LAS unsigned* MISC = (volatile LAS unsigned*)(lds + 131072);
    if (threadIdx.x < 64) MISC[threadIdx.x] = 0u;
    __syncthreads();
    XcdBarrier bar = xcd_barrier_post((unsigned*)ws, MISC + 8);
    if (hi < 0) grid.sync();
#define IN(k) (lo <= (k) && (k) < hi)
#define SYNC(k) do { if (IN(k) && IN((k) + 1)) { xcd_barrier(bar); } } while (0)
#define PHASE(k, ...) do { if (IN(k)) { __VA_ARGS__; if ((REPMASK >> (k)) & 1) { xcd_barrier(bar); __VA_ARGS__; } } SYNC(k); } while (0)
#define GEMM_QKV { pg8::Gemm g{(const bf16_t*)(ws + WS_HB), (const bf16_t*)(ws + WS_WQKV), D, D}; pg8::StaticOrder S; S.init(T, NQKV, 1, G, blockIdx.x); \
        pg8::EpiQkv E{(bf16_t*)(ws + WS_QB), (bf16_t*)(ws + WS_KB), (bf16_t*)(ws + WS_VT), P.out + OUT_K, P.out + OUT_V, (const float*)(ws + WS_ROPE), (const float*)(ws + WS_ROPE) + 2048 * 32}; \
        pg8::gemm_phase(lds, g, S, E); }
#define GEMM_WO { pg8::Gemm g{(const bf16_t*)(ws + WS_OB), (const bf16_t*)(ws + WS_WO), D, D / 2}; pg8::StaticOrder S; S.init(T, D, 2, G, blockIdx.x); \
        pg8::EpiResid E{P.in[0], P.in[1] - (size_t)TCTX * D, (float*)(ws + WS_X), P1A, MOD + 2048, nullptr}; \
        pg8::gemm_phase(lds, g, S, E); }
#define GEMM_MLP1(l) { pg8::Gemm g{(const bf16_t*)(ws + WS_HB), (const bf16_t*)(ws + WS_W1) + (size_t)(l) * D * FF, D, D}; pg8::StaticOrder S; S.init(T, FF, 1, G, blockIdx.x); \
        pg8::EpiRelu2 E{(bf16_t*)(ws + WS_AB), FF}; pg8::gemm_phase(lds, g, S, E); }
#define GEMM_MLP2(l) { pg8::Gemm g{(const bf16_t*)(ws + WS_AB), (const bf16_t*)(ws + WS_W2) + (size_t)(l) * D * FF, FF, FF / 2}; pg8::StaticOrder S; S.init(T, D, 2, G, blockIdx.x); \
        pg8::EpiResid E{(const float*)(ws + WS_X), (const float*)(ws + WS_X), (float*)(ws + WS_X), (l) ? P1A : P1B, MOD + (l) * 3 * 6144 + 5120, (l) ? (const bf16_t*)nullptr : (const bf16_t*)P1A}; \
        pg8::gemm_phase(lds, g, S, E); }
#define GEMM_GLU { pg8::Gemm g{(const bf16_t*)(ws + WS_QB), (const bf16_t*)(ws + WS_WGLU), D, D}; pg8::StaticOrder S; S.init(T, 2 * D, 1, G, blockIdx.x); \
        pg8::EpiGlu E{(float*)(ws + WS_X), MOD + 3 * 6144 + 2048, P1B}; pg8::gemm_phase(lds, g, S, E); }
    PHASE(0, prep_phase(P, lds));
    for (int x = 0; x < EXTRA_SYNCS; ++x) xcd_barrier(bar);
    bf16_t* const P1A = (bf16_t*)(ws + WS_P1); bf16_t* const P1B = P1A + (size_t)T * D;
    PHASE(1, norm_phase<0>(P, P.in[7], MOD, 0, 1024, nullptr));
    PHASE(2, GEMM_QKV);
    PHASE(3, attn_phase(P, lds));
    PHASE(4, GEMM_WO);
    PHASE(5, norm_phase<2>(P, P.in[8], MOD, 3072, 4096, P1A));
    PHASE(6, GEMM_MLP1(0));
    PHASE(7, GEMM_MLP2(0));
    PHASE(8, norm_phase<2>(P, P.in[7] + D, MOD + 3 * 6144, 0, 1024, P1B));
    PHASE(9, ssm_pass1(P));
    PHASE(10, ssm_pass3(P, lds));
    PHASE(11, GEMM_GLU);
    PHASE(12, norm_phase<1>(P, P.in[8] + D, MOD + 3 * 6144, 3072, 4096, nullptr));
    PHASE(13, GEMM_MLP1(1));
    PHASE(14, GEMM_MLP2(1));
    PHASE(15, norm_phase<3>(P, P.in[26], MOD, 0, 0, P1A));
#undef IN
}

#ifndef MK_MULTI
#define MK_MULTI 0
#endif
extern "C" void kernel_launch(void* const* d_in, const int* in_sizes, int n_in, void* d_out, int out_size, void* d_ws, size_t ws_size, hipStream_t stream) {
    static int grid = 0;
    if (grid == 0) {
        int dev = 0, cus = 0, per_cu = 0;
        hipGetDevice(&dev);
        hipDeviceGetAttribute(&cus, hipDeviceAttributeMultiprocessorCount, dev);
        hipFuncSetAttribute((const void*)fwd_kernel, hipFuncAttributeMaxDynamicSharedMemorySize, LDS_BYTES);
        hipOccupancyMaxActiveBlocksPerMultiprocessor(&per_cu, (const void*)fwd_kernel, 512, LDS_BYTES);
        if (per_cu < 1) { fprintf(stderr, "occupancy query gave %d\n", per_cu); per_cu = 1; }
        if (per_cu > 1) per_cu = 1;
        grid = cus * per_cu;
        if (grid > 256) grid = 256;
    }
    (void)hipMemsetAsync(d_ws, 0, 16384, stream);
    Params p{};
    for (int i = 0; i < 27; ++i) p.in[i] = (const float*)d_in[i];
    p.out = (float*)d_out; p.ws = (unsigned char*)d_ws;
#if MK_MULTI
    for (int k = 0; k < NPHASE; ++k) { p.ph_lo = k; p.ph_hi = k + 1; hipLaunchKernelGGL(fwd_kernel, dim3(grid), dim3(512), LDS_BYTES, stream, p); }
#else
    p.ph_lo = 0; p.ph_hi = NPHASE;
    void* args[] = {&p};
    hipError_t e = hipLaunchCooperativeKernel((const void*)fwd_kernel, dim3(grid), dim3(512), args, LDS_BYTES, stream);
    if (e != hipSuccess) fprintf(stderr, "cooperative launch failed: %s (grid %d)\n", hipGetErrorString(e), grid);
#endif
}
```

```cpp
#include <hip/hip_runtime.h>
#include <hip/hip_cooperative_groups.h>
#include <cstdio>
#include <cstdint>
namespace cg = cooperative_groups;

#define LAS __attribute__((address_space(3)))
typedef unsigned short bf16_t;
typedef short bf16x8 __attribute__((ext_vector_type(8)));
typedef float f32x4 __attribute__((ext_vector_type(4)));
typedef float f32x16 __attribute__((ext_vector_type(16)));
typedef float f32x2 __attribute__((ext_vector_type(2)));
typedef unsigned u32x4 __attribute__((ext_vector_type(4)));
typedef unsigned u32x2 __attribute__((ext_vector_type(2)));
typedef __bf16 bf16x2v __attribute__((ext_vector_type(2)));
#define DI __device__ __forceinline__

DI unsigned pk2(float a, float b) { f32x2 v = {a, b}; bf16x2v r = __builtin_convertvector(v, bf16x2v); return __builtin_bit_cast(unsigned, r); }
DI float bf2f(unsigned short u) { return __builtin_bit_cast(float, (unsigned)u << 16); }
DI float wave_sum(float v) {
#pragma unroll
    for (int o = 1; o < 64; o <<= 1) v += __shfl_xor(v, o);
    return v;
}

constexpr int T = 8192, D = 1024, FF = 4096, NQKV = 1536, TCTX = 4096, LLAT = 2048;
constexpr int KROWS = 8704;
constexpr size_t MiB = 1u << 20;
constexpr size_t WS_MOD = 1 * MiB;
constexpr size_t WS_ABAR = 2 * MiB;
constexpr size_t WS_BBM = 2 * MiB + 128 * 1024;
constexpr size_t WS_CCM = 2 * MiB + 640 * 1024;
constexpr size_t WS_ROPE = 3 * MiB + 256 * 1024;
constexpr size_t WS_WQKV = 4 * MiB, WS_WO = 7 * MiB, WS_WGLU = 9 * MiB, WS_W1 = 13 * MiB, WS_W2 = 29 * MiB;
constexpr size_t WS_KB = 45 * MiB, WS_VT = 50 * MiB;
constexpr size_t WS_HB = 56 * MiB, WS_QB = 72 * MiB, WS_OB = 88 * MiB, WS_X = 104 * MiB, WS_P1 = 136 * MiB, WS_AB = 168 * MiB;
constexpr size_t WS_YP = 168 * MiB;
constexpr int OUT_K = 8388608, OUT_V = 8388608 + 1048576, OUT_S = 8388608 + 2 * 1048576;

struct Params { const float* in[27]; float* out; unsigned char* ws; int ph_lo, ph_hi; };

namespace pg8 {
constexpr int BM = 256, BK = 64, HALF = 128, HTB = HALF * BK * 2, STAGE_BYTES = 8 * HTB, NXCD = 8, WGM = 8;
__host__ __device__ __forceinline__ int lds_byte(int r, int c) { const int st = (r >> 4) * 2 + (c >> 5), rr = r & 15, cc = c & 31, ob = rr * 64 + cc * 2; return st * 1024 + (ob ^ (((ob >> 9) & 1) << 5)); }
__host__ __device__ __forceinline__ void stage_rc(int b, int& R, int& C) { const int st = b / 1024, sb = b % 1024, swz = sb ^ (((sb >> 9) & 1) << 5); R = (st >> 1) * 16 + swz / 64; C = (st & 1) * 32 + (swz % 64) / 2; }
__host__ __device__ __forceinline__ int perm32(int rho) { const int n = rho >> 4, i = rho & 15; return 8 * (i >> 2) + 4 * n + (i & 3); }

struct Unit { int pm, pn, ks; };
struct Gemm { const bf16_t* A; const bf16_t* Bt; int ld, Kloop; };

struct StaticOrder {
    int nM, nN, nNv, nwg, G, c;
    __device__ void init(int M, int N, int split, int G_, int c_) { nM = M / BM; nN = N / BM; nNv = nN * split; nwg = nM * nNv; G = G_; c = c_; }
    __device__ bool next(int i, Unit& u) const {
        const long L = (long)i * G + c; if (L >= nwg) return false;
        int wgid = (int)L; { const int q = nwg / NXCD, r = nwg % NXCD, xcd = wgid % NXCD, off = wgid / NXCD; wgid = (xcd < r ? xcd * (q + 1) : r * (q + 1) + (xcd - r) * q) + off; }
        const int nig = WGM * nNv, gid = wgid / nig, fm = gid * WGM, gsz = (nM - fm) < WGM ? (nM - fm) : WGM;
        u.pm = fm + ((wgid % nig) % gsz); const int pv = (wgid % nig) / gsz; u.pn = pv % nN; u.ks = pv / nN; return true;
    }
};

template <class Epi>
__device__ __forceinline__ void gemm_phase(LAS unsigned char* lds, const Gemm g, const StaticOrder& S, const Epi& E) {
    const int tid = threadIdx.x, wid = __builtin_amdgcn_readfirstlane(tid >> 6), lane = tid & 63, wr = wid >> 2, wc = wid & 3, fr = lane & 15, fq = lane >> 4;
    const int ld = g.ld, nt = g.Kloop / BK;
    unsigned voffA[2], voffB[2];
#pragma unroll
    for (int i = 0; i < 2; ++i) { int R, C; stage_rc(tid * 16 + i * 8192, R, C); const int Rb = Epi::PERM ? ((R & ~31) + perm32(R & 31)) : R;
        voffA[i] = (unsigned)(R * ld + C) * 2u; voffB[i] = (unsigned)(Rb * ld + C) * 2u; }
    const size_t kstep = (size_t)(BK * 2);
    const size_t hstep = (size_t)HALF * ld * 2;
    const size_t tstep = 2 * hstep;
    const size_t kso = (size_t)g.Kloop * 2;
    const unsigned ldsw = (unsigned)wid * 1024u;
    const int aoff = lds_byte(wr * 64 + fr, fq * 8), boff = lds_byte(wc * 32 + fr, fq * 8);
#define PG8_SA(b, h) (((b) * 2 + (h)) * HTB)
#define PG8_SB(b, h) ((4 + (b) * 2 + (h)) * HTB)
#define PG8_STAGE(bufoff, gbase, voff) do { _Pragma("unroll") for (int _i = 0; _i < 2; ++_i) \
        __builtin_amdgcn_global_load_lds((const unsigned*)((const char*)(gbase) + (voff)[_i]), (LAS unsigned*)(lds + (bufoff) + ldsw + _i * 8192), 16, 0, 0); } while (0)
#define PG8_LDA(dst, b, h) do { _Pragma("unroll") for (int m = 0; m < 4; ++m) _Pragma("unroll") for (int k = 0; k < 2; ++k) dst[m][k] = *(const LAS bf16x8*)(lds + PG8_SA(b, h) + aoff + m * 2048 + k * 1024); } while (0)
#define PG8_LDB(dst, b, h) do { _Pragma("unroll") for (int n = 0; n < 2; ++n) _Pragma("unroll") for (int k = 0; k < 2; ++k) dst[n][k] = *(const LAS bf16x8*)(lds + PG8_SB(b, h) + boff + n * 2048 + k * 1024); } while (0)
#define PG8_MMA(ai, bj, At, Bt) do { __builtin_amdgcn_s_setprio(1); _Pragma("unroll") for (int m = 0; m < 4; ++m) _Pragma("unroll") for (int n = 0; n < 2; ++n) _Pragma("unroll") for (int k = 0; k < 2; ++k) \
        acc[ai][bj][m][n] = __builtin_amdgcn_mfma_f32_16x16x32_bf16(Bt[n][k], At[m][k], acc[ai][bj][m][n], 0, 0, 0); __builtin_amdgcn_s_setprio(0); } while (0)
#define PG8_WAIT_V(n) asm volatile("s_waitcnt vmcnt(" #n ")" ::: "memory")
#define PG8_WAIT_L(n) asm volatile("s_waitcnt lgkmcnt(" #n ")" ::: "memory")
#define PG8_BAR __builtin_amdgcn_s_barrier()
#define PG8_SCHED __builtin_amdgcn_sched_barrier(0)
#define PG8_UA(u) ((const char*)g.A + (size_t)(u).pm * tstep + (size_t)(u).ks * kso)
#define PG8_UB(u) ((const char*)g.Bt + (size_t)(u).pn * tstep + (size_t)(u).ks * kso)
    Unit cur, nxt; int ui = 0;
    if (!S.next(0, cur)) return;
    f32x4 acc[2][2][4][2];
#pragma unroll
    for (int a = 0; a < 2; ++a)
#pragma unroll
        for (int b = 0; b < 2; ++b)
#pragma unroll
            for (int m = 0; m < 4; ++m)
#pragma unroll
                for (int n = 0; n < 2; ++n) acc[a][b][m][n] = (f32x4){0.f, 0.f, 0.f, 0.f};
    bf16x8 At[4][2], B0[2][2], B1[2][2];
    const char* cA = PG8_UA(cur); const char* cB = PG8_UB(cur);
    PG8_STAGE(PG8_SB(0, 0), cB, voffB); PG8_STAGE(PG8_SB(0, 1), cB + hstep, voffB); PG8_STAGE(PG8_SA(0, 0), cA, voffA); PG8_STAGE(PG8_SA(0, 1), cA + hstep, voffA);
    if (wr == 1) PG8_BAR;
    PG8_WAIT_V(2); PG8_BAR;
    PG8_STAGE(PG8_SB(1, 0), cB + kstep, voffB); PG8_STAGE(PG8_SA(1, 0), cA + kstep, voffA); PG8_STAGE(PG8_SB(1, 1), cB + hstep + kstep, voffB);
    PG8_WAIT_V(6); PG8_BAR;
    for (;;) {
        const bool has_next = S.next(ui + 1, nxt);
        const char* nA = has_next ? PG8_UA(nxt) : cA; const char* nB = has_next ? PG8_UB(nxt) : cB;
        for (int t = 0; t < nt; t += 2) {
            const bool last = (t == nt - 2);
            const char* a1 = cA + (size_t)(t + 1) * kstep;
            const char* a2 = last ? nA : cA + (size_t)(t + 2) * kstep; const char* b2 = last ? nB : cB + (size_t)(t + 2) * kstep;
            const char* a3 = a2 + kstep; const char* b3 = b2 + kstep;
            PG8_LDB(B0, 0, 0); PG8_LDB(B1, 0, 1); PG8_SCHED; PG8_LDA(At, 0, 0); PG8_STAGE(PG8_SA(1, 1), a1 + hstep, voffA);
            PG8_WAIT_V(8); PG8_WAIT_L(0); PG8_BAR; PG8_MMA(0, 0, At, B0); PG8_MMA(0, 1, At, B1); PG8_BAR; PG8_SCHED;
            PG8_LDA(At, 0, 1); PG8_STAGE(PG8_SB(0, 0), b2, voffB); PG8_STAGE(PG8_SB(0, 1), b2 + hstep, voffB); PG8_STAGE(PG8_SA(0, 0), a2, voffA);
            PG8_WAIT_V(8); PG8_WAIT_L(0); PG8_BAR; PG8_MMA(1, 0, At, B0); PG8_MMA(1, 1, At, B1); PG8_BAR; PG8_SCHED;
            PG8_LDB(B0, 1, 0); PG8_LDB(B1, 1, 1); PG8_SCHED; PG8_LDA(At, 1, 0); PG8_STAGE(PG8_SA(0, 1), a2 + hstep, voffA);
            PG8_WAIT_V(8); PG8_WAIT_L(0); PG8_BAR; PG8_MMA(0, 0, At, B0); PG8_MMA(0, 1, At, B1); PG8_BAR; PG8_SCHED;
            PG8_LDA(At, 1, 1); PG8_STAGE(PG8_SB(1, 0), b3, voffB); PG8_STAGE(PG8_SB(1, 1), b3 + hstep, voffB); PG8_STAGE(PG8_SA(1, 0), a3, voffA);
            PG8_WAIT_V(8); PG8_WAIT_L(0); PG8_BAR; PG8_MMA(1, 0, At, B0); PG8_MMA(1, 1, At, B1); PG8_BAR; PG8_SCHED;
        }
        if (wr == 0) PG8_BAR;
        E(acc, cur, wr, wc, fr, fq);
        if (!has_next) break;
#pragma unroll
        for (int a = 0; a < 2; ++a)
#pragma unroll
            for (int b = 0; b < 2; ++b)
#pragma unroll
                for (int m = 0; m < 4; ++m)
#pragma unroll
                    for (int n = 0; n < 2; ++n) acc[a][b][m][n] = (f32x4){0.f, 0.f, 0.f, 0.f};
        cur = nxt; cA = nA; cB = nB; ++ui;
        if (wr == 1) PG8_BAR;
    }
    PG8_WAIT_V(0);
    PG8_BAR;
#undef PG8_SA
#undef PG8_SB
#undef PG8_STAGE
#undef PG8_LDA
#undef PG8_LDB
#undef PG8_MMA
#undef PG8_WAIT_V
#undef PG8_WAIT_L
#undef PG8_BAR
#undef PG8_SCHED
#undef PG8_UA
#undef PG8_UB
}

struct EpiRelu2 {
    static constexpr bool PERM = true;
    bf16_t* O; int ldc;
    __device__ __forceinline__ void operator()(const f32x4 (&acc)[2][2][4][2], const Unit& u, int wr, int wc, int fr, int fq) const {
        const int row0 = u.pm * BM + wr * 64 + fr, col0 = u.pn * BM + wc * 32 + 8 * fq;
#pragma unroll
        for (int ai = 0; ai < 2; ++ai)
#pragma unroll
            for (int m = 0; m < 4; ++m) { bf16_t* rowp = O + (size_t)(row0 + ai * HALF + m * 16) * ldc + col0;
#pragma unroll
                for (int bj = 0; bj < 2; ++bj) { f32x4 v0 = acc[ai][bj][m][0], v1 = acc[ai][bj][m][1];
#pragma unroll
                    for (int j = 0; j < 4; ++j) { const float a = fmaxf(v0[j], 0.f), b = fmaxf(v1[j], 0.f); v0[j] = a * a; v1[j] = b * b; }
                    u32x4 w; w.x = pk2(v0[0], v0[1]); w.y = pk2(v0[2], v0[3]); w.z = pk2(v1[0], v1[1]); w.w = pk2(v1[2], v1[3]);
                    *(u32x4*)(rowp + bj * HALF) = w; } }
    }
};
struct EpiResid {
    static constexpr bool PERM = true;
    const float* res0; const float* res1; float* X; bf16_t* P1; const float* gate; const bf16_t* Pin;
    __device__ __forceinline__ void operator()(const f32x4 (&acc)[2][2][4][2], const Unit& u, int wr, int wc, int fr, int fq) const {
        const int vec = u.pm < 16 ? 0 : (u.pm < 24 ? 1 : 2);
        const float* gv_ = gate + vec * 6144; const float* rs = u.pm < 16 ? res0 : res1;
        const int col0 = u.pn * BM + wc * 32 + 8 * fq;
        f32x4 gv[2][2];
#pragma unroll
        for (int bj = 0; bj < 2; ++bj)
#pragma unroll
            for (int n = 0; n < 2; ++n) gv[bj][n] = *(const f32x4*)(gv_ + col0 + bj * HALF + n * 4);
#pragma unroll
        for (int ai = 0; ai < 2; ++ai)
#pragma unroll
            for (int m = 0; m < 4; ++m) { const size_t off = (size_t)(u.pm * BM + ai * HALF + wr * 64 + m * 16 + fr) * D + col0;
#pragma unroll
                for (int bj = 0; bj < 2; ++bj) {
                    const size_t e = off + bj * HALF;
                    f32x4 o0 = gv[bj][0] * acc[ai][bj][m][0], o1 = gv[bj][1] * acc[ai][bj][m][1];
                    if (u.ks == 0) { o0 += *(const f32x4*)(rs + e); o1 += *(const f32x4*)(rs + e + 4);
                        if (Pin) { const u32x4 pw = *(const u32x4*)(Pin + e);
                            o0[0] += __builtin_bit_cast(float, pw.x << 16); o0[1] += __builtin_bit_cast(float, pw.x & 0xffff0000u); o0[2] += __builtin_bit_cast(float, pw.y << 16); o0[3] += __builtin_bit_cast(float, pw.y & 0xffff0000u);
                            o1[0] += __builtin_bit_cast(float, pw.z << 16); o1[1] += __builtin_bit_cast(float, pw.z & 0xffff0000u); o1[2] += __builtin_bit_cast(float, pw.w << 16); o1[3] += __builtin_bit_cast(float, pw.w & 0xffff0000u); }
                        *(f32x4*)(X + e) = o0; *(f32x4*)(X + e + 4) = o1; }
                    else { u32x4 w; w.x = pk2(o0[0], o0[1]); w.y = pk2(o0[2], o0[3]); w.z = pk2(o1[0], o1[1]); w.w = pk2(o1[2], o1[3]); *(u32x4*)(P1 + e) = w; } } }
    }
};
struct EpiGlu {
    static constexpr bool PERM = true;
    float* X; const float* gate; const bf16_t* Pin;
    __device__ __forceinline__ void operator()(const f32x4 (&acc)[2][2][4][2], const Unit& u, int wr, int wc, int fr, int fq) const {
        const int vec = u.pm < 16 ? 0 : (u.pm < 24 ? 1 : 2);
        const float* gv_ = gate + vec * 6144;
        const int col0 = u.pn * HALF + wc * 32 + 8 * fq;
        f32x4 gv[2];
#pragma unroll
        for (int n = 0; n < 2; ++n) gv[n] = *(const f32x4*)(gv_ + col0 + n * 4);
#pragma unroll
        for (int ai = 0; ai < 2; ++ai)
#pragma unroll
            for (int m = 0; m < 4; ++m) { const size_t off = (size_t)(u.pm * BM + ai * HALF + wr * 64 + m * 16 + fr) * D + col0;
#pragma unroll
                for (int n = 0; n < 2; ++n) { const f32x4 a = acc[ai][0][m][n], b = acc[ai][1][m][n]; f32x4 o;
#pragma unroll
                    for (int j = 0; j < 4; ++j) o[j] = a[j] / (1.f + __expf(-b[j]));
                    const size_t e = off + n * 4; f32x4 xo = *(const f32x4*)(X + e) + gv[n] * o;
                    { const u32x2 pw = *(const u32x2*)(Pin + e); xo[0] += __builtin_bit_cast(float, pw.x << 16); xo[1] += __builtin_bit_cast(float, pw.x & 0xffff0000u); xo[2] += __builtin_bit_cast(float, pw.y << 16); xo[3] += __builtin_bit_cast(float, pw.y & 0xffff0000u); }
                    *(f32x4*)(X + e) = xo; } }
    }
};
struct EpiQkv {
    static constexpr bool PERM = false;
    bf16_t* QB; bf16_t* KB; bf16_t* VT; float* outK; float* outV; const float* ropec; const float* ropes;
    __device__ __forceinline__ void operator()(const f32x4 (&acc)[2][2][4][2], const Unit& u, int wr, int wc, int fr, int fq) const {
        const bool lat = u.pm >= 16;
#pragma unroll
        for (int ai = 0; ai < 2; ++ai)
#pragma unroll
            for (int m = 0; m < 4; ++m) {
                const int row = u.pm * BM + ai * HALF + wr * 64 + m * 16 + fr;
                f32x4 cs = {1.f, 1.f, 1.f, 1.f}, sn = {0.f, 0.f, 0.f, 0.f};
                if (lat && u.pn < 5) { const int tp = row & 2047; cs = *(const f32x4*)(ropec + tp * 32 + (wc & 1) * 16 + 4 * fq); sn = *(const f32x4*)(ropes + tp * 32 + (wc & 1) * 16 + 4 * fq); }
#pragma unroll
                for (int bj = 0; bj < 2; ++bj) {
                    f32x4 x1 = acc[ai][bj][m][0], x2 = acc[ai][bj][m][1];
                    const int cl = bj * HALF + wc * 32 + 4 * fq;
                    if (u.pn < 5) {
                        f32x4 y1 = x1 * cs - x2 * sn, y2 = x1 * sn + x2 * cs;
                        if (u.pn < 4) { y1 = y1 * (0.125f * 1.44269504089f); y2 = y2 * (0.125f * 1.44269504089f); }
                        bf16_t* dst = (u.pn < 4) ? (QB + (size_t)row * D + u.pn * BM + cl) : (KB + (size_t)row * 256 + cl);
                        u32x2 w1, w2; w1.x = pk2(y1[0], y1[1]); w1.y = pk2(y1[2], y1[3]); w2.x = pk2(y2[0], y2[1]); w2.y = pk2(y2[2], y2[3]);
                        *(u32x2*)dst = w1; *(u32x2*)(dst + 16) = w2;
                        if (u.pn == 4 && !lat) { *(f32x4*)(outK + (size_t)row * 256 + cl) = x1; *(f32x4*)(outK + (size_t)row * 256 + cl + 16) = x2; }
                    } else {
#pragma unroll
                        for (int j = 0; j < 4; ++j) { VT[(size_t)(cl + j) * KROWS + row] = (bf16_t)(pk2(x1[j], 0.f) & 0xffffu); VT[(size_t)(cl + 16 + j) * KROWS + row] = (bf16_t)(pk2(x2[j], 0.f) & 0xffffu); }
                        if (!lat) { *(f32x4*)(outV + (size_t)row * 256 + cl) = x1; *(f32x4*)(outV + (size_t)row * 256 + cl + 16) = x2; }
                    }
                }
            }
    }
};
}

DI void transpose_item(const float* W, int K, int N, bf16_t* WT, int k0, int n0, int drow0, LAS float* scr, int lane) {
#pragma unroll 8
    for (int i = 0; i < 32; ++i) { const int kk = 2 * i + (lane >> 5); scr[kk * 33 + (lane & 31)] = W[(size_t)(k0 + kk) * N + n0 + (lane & 31)]; }
    asm volatile("" ::: "memory");
    const int c = lane & 7;
#pragma unroll
    for (int j = 0; j < 4; ++j) { const int n = (lane >> 3) + 8 * j; const LAS float* s = scr + (8 * c) * 33 + n;
        u32x4 o; o.x = pk2(s[0 * 33], s[1 * 33]); o.y = pk2(s[2 * 33], s[3 * 33]); o.z = pk2(s[4 * 33], s[5 * 33]); o.w = pk2(s[6 * 33], s[7 * 33]);
        *(u32x4*)(WT + (size_t)(drow0 + n) * K + k0 + 8 * c) = o; }
    asm volatile("" ::: "memory");
}
DI void transpose_mat(const float* W, int K, int N, bf16_t* WT, int item, LAS float* scr, int lane, int glu  ) {
    const int nblk = N / 32, kb = item / nblk, nb = item % nblk, n0 = 32 * nb;
    int drow0 = n0;
    if (glu) drow0 = 256 * (n0 >> 7) + (n0 & 127) + (glu == 2 ? 128 : 0);
    transpose_item(W, K, N, WT, 64 * kb, n0, drow0, scr, lane);
}

constexpr int TR_I_QKV = 16 * 48, TR_I_O = 16 * 32, TR_I_G = 16 * 32, TR_I_1 = 16 * 128, TR_I_2 = 64 * 32;
constexpr int TR_NIT = TR_I_QKV + TR_I_O + 2 * TR_I_G + 2 * TR_I_1 + 2 * TR_I_2, TR_MOVED = 2560;
DI void transpose_dispatch(const Params& P, int it, LAS unsigned char* lds, int wid, int lane) {
    unsigned char* ws = P.ws;
    LAS float* scr = (LAS float*)(lds + 32768 + wid * 8704);
    int r = it;
    if (r < TR_I_QKV) { transpose_mat(P.in[11], 1024, 1536, (bf16_t*)(ws + WS_WQKV), r, scr, lane, 0); return; } r -= TR_I_QKV;
    if (r < TR_I_O) { transpose_mat(P.in[12], 1024, 1024, (bf16_t*)(ws + WS_WO), r, scr, lane, 0); return; } r -= TR_I_O;
    if (r < TR_I_G) { transpose_mat(P.in[22], 1024, 1024, (bf16_t*)(ws + WS_WGLU), r, scr, lane, 1); return; } r -= TR_I_G;
    if (r < TR_I_G) { transpose_mat(P.in[23], 1024, 1024, (bf16_t*)(ws + WS_WGLU), r, scr, lane, 2); return; } r -= TR_I_G;
    if (r < 2 * TR_I_1) { const int l = r / TR_I_1; transpose_mat(P.in[24] + (size_t)l * D * FF, 1024, 4096, (bf16_t*)(ws + WS_W1) + (size_t)l * D * FF, r % TR_I_1, scr, lane, 0); return; } r -= 2 * TR_I_1;
    { const int l = r / TR_I_2; transpose_mat(P.in[25] + (size_t)l * D * FF, 4096, 1024, (bf16_t*)(ws + WS_W2) + (size_t)l * D * FF, r % TR_I_2, scr, lane, 0); }
}
DI void transpose_tail(const Params& P, LAS unsigned char* lds) {
    const int G = gridDim.x, bid = blockIdx.x, wid = threadIdx.x >> 6, lane = threadIdx.x & 63;
    if (G <= 192 || bid < 192) return;
    const int iw = (bid - 192) * 8 + wid, NIW = (G - 192) * 8;
    for (int it = TR_NIT - TR_MOVED + iw; it < TR_NIT; it += NIW) transpose_dispatch(P, it, lds, wid, lane);
}

DI void prep_phase(const Params& P, LAS unsigned char* lds) {
    const int tid = threadIdx.x, wid = tid >> 6, lane = tid & 63, G = gridDim.x, bid = blockIdx.x;
    unsigned char* ws = P.ws;
    if (bid < 192) {
        LAS float* sl = (LAS float*)lds;
        LAS float* red = (LAS float*)(lds + 12288);
        for (int e = tid; e < 3072; e += 512) { const int v = e >> 10, k = e & 1023; const float x = (v == 0) ? P.in[6][k] : P.in[5][(v - 1) * 1024 + k]; sl[e] = x / (1.f + __expf(-x)); }
        __syncthreads();
        const int l = bid / 96, n0 = (bid % 96) * 64, cq = lane & 15, kr = lane >> 4;
        const float* wm = P.in[9] + (size_t)l * 1024 * 6144 + n0 + 4 * cq;
        f32x4 a0 = {0.f, 0.f, 0.f, 0.f}, a1 = a0, a2 = a0;
#pragma unroll
        for (int hb = 0; hb < 2; ++hb) { f32x4 wv[16];
#pragma unroll
            for (int i = 0; i < 16; ++i) wv[i] = *(const f32x4*)(wm + (size_t)(128 * wid + 4 * (16 * hb + i) + kr) * 6144);
#pragma unroll
            for (int i = 0; i < 16; ++i) { const int k = 128 * wid + 4 * (16 * hb + i) + kr; a0 += wv[i] * sl[k]; a1 += wv[i] * sl[1024 + k]; a2 += wv[i] * sl[2048 + k]; } }
#pragma unroll
        for (int j = 0; j < 4; ++j) { a0[j] += __shfl_xor(a0[j], 16); a0[j] += __shfl_xor(a0[j], 32); a1[j] += __shfl_xor(a1[j], 16); a1[j] += __shfl_xor(a1[j], 32); a2[j] += __shfl_xor(a2[j], 16); a2[j] += __shfl_xor(a2[j], 32); }
        if (kr == 0) { *(LAS f32x4*)(red + (wid * 3 + 0) * 64 + 4 * cq) = a0; *(LAS f32x4*)(red + (wid * 3 + 1) * 64 + 4 * cq) = a1; *(LAS f32x4*)(red + (wid * 3 + 2) * 64 + 4 * cq) = a2; }
        __syncthreads();
        if (tid < 192) { const int v = tid >> 6, cc = tid & 63; float s = P.in[10][l * 6144 + n0 + cc];
#pragma unroll
            for (int w = 0; w < 8; ++w) s += red[(w * 3 + v) * 64 + cc];
            ((float*)(ws + WS_MOD))[(l * 3 + v) * 6144 + n0 + cc] = s; }
    }
    {
        const int moved = (G > 192) ? TR_MOVED : 0;
        const int gw = bid * 8 + wid, NGW = G * 8;
        for (int it = gw; it < TR_NIT - moved; it += NGW) transpose_dispatch(P, it, lds, wid, lane);
    }
    const int gt = bid * 512 + tid, NGT = G * 512;
    for (int e = gt; e < 2 * 256 * 256; e += NGT) {
        const int tok = e >> 8, c = e & 255;
        ((bf16_t*)(ws + WS_KB))[(size_t)(T + tok) * 256 + c] = (bf16_t)(pk2(P.in[2][e], 0.f) & 0xffffu);
    }
    for (int e = gt; e < 2 * 256 * 256; e += NGT) {
        const int c = e >> 9, tok = e & 511;
        ((bf16_t*)(ws + WS_VT))[(size_t)c * KROWS + T + tok] = (bf16_t)(pk2(P.in[3][tok * 256 + c], 0.f) & 0xffffu);
    }
    for (int e = gt; e < 2048 * 32; e += NGT) {
        const int tp = e >> 5, k = e & 31, f = k & 15; const float pos = (k >> 4) ? (float)(tp & 63) : (float)(tp >> 6);
        const float freq = powf(10000.f, -(float)f / 16.f); const float ang = pos * freq;
        ((float*)(ws + WS_ROPE))[e] = cosf(ang); ((float*)(ws + WS_ROPE))[2048 * 32 + e] = sinf(ang);
    }
    for (int idx = gt; idx < 2 * 64 * 64 * 16; idx += NGT) {
        const int e = idx >> 4, c = idx & 15, dg = e >> 6, p = e & 63;
        const float dt = expf(P.in[16][dg]), lre = P.in[14][e], lim = P.in[15][e];
        const float mag = expf(lre * dt), ang = lim * dt; const float are = mag * cosf(ang), aim = mag * sinf(ang);
        const float den = lre * lre + lim * lim, nre = are - 1.f, nim = aim;
        const float fre = (nre * lre + nim * lim) / den, fim = (nim * lre - nre * lim) / den;
        if (c == 0) { ((float*)(ws + WS_ABAR))[e * 2] = are; ((float*)(ws + WS_ABAR))[e * 2 + 1] = aim; }
        bf16_t* bbm = (bf16_t*)(ws + WS_BBM) + (size_t)dg * 128 * 16; bf16_t* ccm = (bf16_t*)(ws + WS_CCM) + (size_t)dg * 16 * 128;
        const float br = P.in[17][idx], bi = P.in[18][idx];
        bbm[p * 16 + c] = (bf16_t)(pk2(fre * br - fim * bi, 0.f) & 0xffffu);
        bbm[(64 + p) * 16 + c] = (bf16_t)(pk2(fre * bi + fim * br, 0.f) & 0xffffu);
        const float cr = P.in[19][((size_t)dg * 16 + c) * 64 + p], ci = P.in[20][((size_t)dg * 16 + c) * 64 + p];
        const int k = 4 * (p & 31) + 2 * (p >> 5);
        ccm[c * 128 + k] = (bf16_t)(pk2(cr, 0.f) & 0xffffu); ccm[c * 128 + k + 1] = (bf16_t)(pk2(-ci, 0.f) & 0xffffu);
    }
}

template <int MODE>
DI void norm_phase(const Params& P, const float* gain, const float* modl, int sh_off, int sc_off, const bf16_t* P1) {
    const int tid = threadIdx.x, wid = tid >> 6, lane = tid & 63;
    float* X = (float*)(P.ws + WS_X); bf16_t* HB = (bf16_t*)(P.ws + WS_HB);
    for (int row = blockIdx.x * 8 + wid; row < T; row += gridDim.x * 8) {
        const float* src = (MODE == 0) ? (row < TCTX ? P.in[0] + (size_t)row * D : P.in[1] + (size_t)(row - TCTX) * D) : X + (size_t)row * D;
        f32x4 v[4]; float ss = 0.f;
#pragma unroll
        for (int j = 0; j < 4; ++j) { v[j] = *(const f32x4*)(src + 4 * lane + 256 * j);
            if (MODE >= 2) { const u32x2 pw = *(const u32x2*)(P1 + (size_t)row * D + 4 * lane + 256 * j);
                v[j][0] += __builtin_bit_cast(float, pw.x << 16); v[j][1] += __builtin_bit_cast(float, pw.x & 0xffff0000u); v[j][2] += __builtin_bit_cast(float, pw.y << 16); v[j][3] += __builtin_bit_cast(float, pw.y & 0xffff0000u);
                }
            ss += (v[j][0] * v[j][0] + v[j][1] * v[j][1]) + (v[j][2] * v[j][2] + v[j][3] * v[j][3]); }
        const float rinv = rsqrtf(wave_sum(ss) * (1.f / D) + 1e-6f);
        if (MODE == 3) {
#pragma unroll
            for (int j = 0; j < 4; ++j) { const f32x4 g = *(const f32x4*)(gain + 4 * lane + 256 * j); *(f32x4*)(P.out + (size_t)row * D + 4 * lane + 256 * j) = v[j] * rinv * g; }
        } else {
            const int vec = row < TCTX ? 0 : (row < TCTX + LLAT ? 1 : 2); const float* mv = modl + vec * 6144;
#pragma unroll
            for (int j = 0; j < 4; ++j) { const int c = 4 * lane + 256 * j; const f32x4 g = *(const f32x4*)(gain + c), sc = *(const f32x4*)(mv + sc_off + c), sh = *(const f32x4*)(mv + sh_off + c);
                const f32x4 h = (v[j] * rinv * g) * (sc + 1.f) + sh; u32x2 w; w.x = pk2(h[0], h[1]); w.y = pk2(h[2], h[3]); *(u32x2*)(HB + (size_t)row * D + c) = w; }
        }
    }
}

DI void attn_phase(const Params& P, LAS unsigned char* lds) {
    const int tid = threadIdx.x, wid = tid >> 6, lane = tid & 63, r = lane & 15, g4 = lane >> 4;
    const bf16_t* QB = (const bf16_t*)(P.ws + WS_QB); const bf16_t* KB = (const bf16_t*)(P.ws + WS_KB); const bf16_t* VT = (const bf16_t*)(P.ws + WS_VT); bf16_t* OB = (bf16_t*)(P.ws + WS_OB);
    const float LOG2E = 1.44269504089f;
    const int lrow = tid >> 3, lch = tid & 7;
    for (int u = blockIdx.x; u < 1024; u += gridDim.x) {
        int h, tok0, win0, nwin, ctx0, ipos0; bool lat;
        if (u < 512) { const int b = u >> 5; h = (u >> 1) & 15; const int n = u & 1; tok0 = 256 * b + 128 * n; win0 = 0; nwin = 0; ctx0 = 256 * b; lat = false; ipos0 = 0; }
        else { const int v = u - 512, b = v >> 8; h = (v >> 4) & 15; const int n = v & 15; const int tb = TCTX + LLAT * b; tok0 = tb + 128 * n;
            const int j0 = (128 * n - 128) < 0 ? 0 : (128 * n - 128), j1 = (128 * n + 256) > LLAT ? LLAT : (128 * n + 256);
            win0 = tb + j0; nwin = (j1 - j0) >> 6; ctx0 = T + 256 * b; lat = true; ipos0 = 128 * n - j0; }
        const int kvh = h >> 2, ntile = nwin + 4;
        const bf16_t* qp = QB + (size_t)(tok0 + 16 * wid + r) * D + h * 64 + 8 * g4;
        const bf16x8 qb0 = *(const bf16x8*)qp, qb1 = *(const bf16x8*)(qp + 32);
        float m_run = P.in[13][h] * LOG2E, l_run = (g4 == 0) ? 1.f : 0.f;
        f32x4 o[4];
#pragma unroll
        for (int dt = 0; dt < 4; ++dt) o[dt] = (f32x4){0.f, 0.f, 0.f, 0.f};
        const int iq = ipos0 + 16 * wid + r;
        u32x4 kreg, vreg;
        { const int tk = (0 < nwin) ? win0 : ctx0;
          kreg = *(const u32x4*)(KB + (size_t)(tk + lrow) * 256 + kvh * 64 + lch * 8); vreg = *(const u32x4*)(VT + (size_t)(kvh * 64 + lrow) * KROWS + tk + lch * 8); }
        *(LAS u32x4*)(lds + lrow * 144 + lch * 16) = kreg; *(LAS u32x4*)(lds + 9216 + lrow * 144 + lch * 16) = vreg;
        __syncthreads();
        for (int t = 0; t < ntile; ++t) {
            LAS unsigned char* Kb = lds + (t & 1) * 18432; LAS unsigned char* Vb = Kb + 9216;
            if (t + 1 < ntile) { const int tk = (t + 1 < nwin) ? win0 + 64 * (t + 1) : ctx0 + 64 * (t + 1 - nwin);
                kreg = *(const u32x4*)(KB + (size_t)(tk + lrow) * 256 + kvh * 64 + lch * 8); vreg = *(const u32x4*)(VT + (size_t)(kvh * 64 + lrow) * KROWS + tk + lch * 8); }
            int cls = 0;
            if (lat && t < nwin) { const int iq0 = ipos0 + 16 * wid, dmin = 64 * t - (iq0 + 15), dmax = 64 * t + 63 - iq0; cls = (dmax < -128 || dmin > 128) ? 2 : ((dmin >= -128 && dmax <= 128) ? 0 : 1); }
            if (cls != 2) {
            f32x4 s[4];
#pragma unroll
            for (int kt = 0; kt < 4; ++kt) {
                const bf16x8 a0 = *(const LAS bf16x8*)(Kb + (16 * kt + r) * 144 + g4 * 16), a1 = *(const LAS bf16x8*)(Kb + (16 * kt + r) * 144 + 64 + g4 * 16);
                f32x4 z = {0.f, 0.f, 0.f, 0.f};
                z = __builtin_amdgcn_mfma_f32_16x16x32_bf16(a0, qb0, z, 0, 0, 0);
                s[kt] = __builtin_amdgcn_mfma_f32_16x16x32_bf16(a1, qb1, z, 0, 0, 0);
            }
            float mx = -3.0e38f;
            if (cls == 1) {
#pragma unroll
                for (int kt = 0; kt < 4; ++kt)
#pragma unroll
                    for (int i = 0; i < 4; ++i) { const int dj = 64 * t + 16 * kt + 4 * g4 + i - iq; if (dj > 128 || dj < -128) s[kt][i] = -1.0e30f; }
            }
#pragma unroll
            for (int kt = 0; kt < 4; ++kt)
#pragma unroll
                for (int i = 0; i < 4; ++i) mx = fmaxf(mx, s[kt][i]);
            mx = fmaxf(mx, __shfl_xor(mx, 16)); mx = fmaxf(mx, __shfl_xor(mx, 32));
            const float mnew = fmaxf(m_run, mx), alpha = __builtin_amdgcn_exp2f(m_run - mnew); m_run = mnew;
            float ls = 0.f;
#pragma unroll
            for (int kt = 0; kt < 4; ++kt)
#pragma unroll
                for (int i = 0; i < 4; ++i) { const float p = __builtin_amdgcn_exp2f(s[kt][i] - mnew); s[kt][i] = p; ls += p; }
            l_run = l_run * alpha + ls;
#pragma unroll
            for (int dt = 0; dt < 4; ++dt) o[dt] *= alpha;
            u32x4 pw01, pw23;
            pw01.x = pk2(s[0][0], s[0][1]); pw01.y = pk2(s[0][2], s[0][3]); pw01.z = pk2(s[1][0], s[1][1]); pw01.w = pk2(s[1][2], s[1][3]);
            pw23.x = pk2(s[2][0], s[2][1]); pw23.y = pk2(s[2][2], s[2][3]); pw23.z = pk2(s[3][0], s[3][1]); pw23.w = pk2(s[3][2], s[3][3]);
            const bf16x8 pb01 = __builtin_bit_cast(bf16x8, pw01), pb23 = __builtin_bit_cast(bf16x8, pw23);
#pragma unroll
            for (int dt = 0; dt < 4; ++dt) {
                const LAS unsigned char* vr = Vb + (16 * dt + r) * 144 + g4 * 8;
                u32x4 va; const u32x2 l0 = *(const LAS u32x2*)(vr), h0 = *(const LAS u32x2*)(vr + 32), l1 = *(const LAS u32x2*)(vr + 64), h1 = *(const LAS u32x2*)(vr + 96);
                va.x = l0.x; va.y = l0.y; va.z = h0.x; va.w = h0.y;
                o[dt] = __builtin_amdgcn_mfma_f32_16x16x32_bf16(__builtin_bit_cast(bf16x8, va), pb01, o[dt], 0, 0, 0);
                va.x = l1.x; va.y = l1.y; va.z = h1.x; va.w = h1.y;
                o[dt] = __builtin_amdgcn_mfma_f32_16x16x32_bf16(__builtin_bit_cast(bf16x8, va), pb23, o[dt], 0, 0, 0);
            }
            }
            if (t + 1 < ntile) { LAS unsigned char* Kn = lds + ((t + 1) & 1) * 18432; *(LAS u32x4*)(Kn + lrow * 144 + lch * 16) = kreg; *(LAS u32x4*)(Kn + 9216 + lrow * 144 + lch * 16) = vreg; }
            __syncthreads();
        }
        float l = l_run; l += __shfl_xor(l, 16); l += __shfl_xor(l, 32);
        const float inv = 1.f / l;
        bf16_t* op = OB + (size_t)(tok0 + 16 * wid + r) * D + h * 64 + 4 * g4;
#pragma unroll
        for (int dt = 0; dt < 4; ++dt) { u32x2 w; w.x = pk2(o[dt][0] * inv, o[dt][1] * inv); w.y = pk2(o[dt][2] * inv, o[dt][3] * inv); *(u32x2*)(op + 16 * dt) = w; }
    }
}

constexpr size_t WS_E = 232 * MiB;
struct SsmItem { int g, k, nchunk, seqX, tokX, tokY; bool lat; };
DI SsmItem ssm_item(int gw) {
    SsmItem it; int pi;
    if (gridDim.x == 256) { const int bid = gw & 255, wid = gw >> 8; it.g = (bid & 7) * 8 + ((bid >> 3) & 7); pi = wid * 4 + (bid >> 6); }
    else { it.g = gw & 63; pi = gw >> 6; }
    if (pi < 16) { const int sp = pi >> 1; it.k = pi & 1; it.nchunk = 2; it.seqX = 2 * sp; it.tokX = 512 * sp + 128 * it.k; it.tokY = it.tokX + 256; it.lat = false; }
    else { it.k = pi - 16; it.nchunk = 16; it.seqX = 16; it.tokX = TCTX + 128 * it.k; it.tokY = it.tokX + LLAT; it.lat = true; }
    return it;
}
DI size_t ssm_eidx(int dir, int seq, int chunk, int g) { return ((((size_t)dir * 18 + seq) * 16 + chunk) * 64 + g) * 128; }

#define SSM_SCAN_STEP(i, WRITE_S) { const float nr0 = ar0 * sr0 - ai0 * si0 + acc[0][i], ni0 = ar0 * si0 + ai0 * sr0 + acc[2][i]; \
        const float nr1 = ar1 * sr1 - ai1 * si1 + acc[1][i], ni1 = ar1 * si1 + ai1 * sr1 + acc[3][i]; \
        sr0 = nr0; si0 = ni0; sr1 = nr1; si1 = ni1; \
        if (WRITE_S) { u32x2 w; w.x = pk2(nr0, ni0); w.y = pk2(nr1, ni1); *(LAS u32x2*)(S + (16 * h + (i)) * 272 + p * 8) = w; } }

DI void ssm_pass1(const Params& P) {
    const int tid = threadIdx.x, wid = tid >> 6, lane = tid & 63, p = lane & 31, h = lane >> 5;
    const int gw = wid * gridDim.x + blockIdx.x;
    if (gw >= 2048) return;
    const SsmItem it = ssm_item(gw);
    const bf16_t* HB = (const bf16_t*)(P.ws + WS_HB);
    float* E = (float*)(P.ws + WS_E);
    const int hh = (p >> 2) & 1, ii = 4 * (p >> 3) + (p & 3);
    const bf16_t* ubase = HB + (size_t)((hh ? it.tokY : it.tokX) + ii) * D + 16 * it.g + 8 * h;
    bf16x8 a[8];
#pragma unroll
    for (int t = 0; t < 8; ++t) a[t] = *(const bf16x8*)(ubase + (size_t)(16 * t) * D);
    LAS unsigned char* S = nullptr;
#pragma unroll
    for (int dir = 0; dir < 2; ++dir) {
        const int dg = dir * 64 + it.g;
        const float* ab = (const float*)(P.ws + WS_ABAR) + (size_t)dg * 128;
        const float ar0 = ab[2 * p], ai0 = ab[2 * p + 1], ar1 = ab[2 * (p + 32)], ai1 = ab[2 * (p + 32) + 1];
        bf16x8 bbq[4];
#pragma unroll
        for (int q = 0; q < 4; ++q) bbq[q] = *(const bf16x8*)((const bf16_t*)(P.ws + WS_BBM) + ((size_t)dg * 128 + q * 32 + p) * 16 + 8 * h);
        float sr0 = 0.f, si0 = 0.f, sr1 = 0.f, si1 = 0.f;
#pragma unroll
        for (int tt = 0; tt < 8; ++tt) {
            const int ti = dir ? 7 - tt : tt;
            f32x16 acc[4];
#pragma unroll
            for (int q = 0; q < 4; ++q) { f32x16 z;
#pragma unroll
                for (int i = 0; i < 16; ++i) z[i] = 0.f;
                acc[q] = __builtin_amdgcn_mfma_f32_32x32x16_bf16(a[ti], bbq[q], z, 0, 0, 0); }
            if (dir == 0) {
#pragma unroll
                for (int i = 0; i < 16; ++i) SSM_SCAN_STEP(i, false)
            } else {
#pragma unroll
                for (int i = 15; i >= 0; --i) SSM_SCAN_STEP(i, false)
            }
        }
        float* e = E + ssm_eidx(dir, it.seqX + h, it.k, it.g);
        e[p] = sr0; e[p + 32] = sr1; e[64 + p] = si0; e[64 + p + 32] = si1;
    }
}

template <int DIR>
DI void ssm_dir(const Params& P, const SsmItem& it, LAS unsigned char* S, f32x4 (&st)[8][2], int lane) {
    const int p = lane & 31, h = lane >> 5, c16 = lane & 15, g4 = lane >> 4;
    const int dg = DIR * 64 + it.g;
    const float* ab = (const float*)(P.ws + WS_ABAR) + (size_t)dg * 128;
    const float ar0 = ab[2 * p], ai0 = ab[2 * p + 1], ar1 = ab[2 * (p + 32)], ai1 = ab[2 * (p + 32) + 1];
    bf16x8 bbq[4], ccb[4];
#pragma unroll
    for (int q = 0; q < 4; ++q) bbq[q] = *(const bf16x8*)((const bf16_t*)(P.ws + WS_BBM) + ((size_t)dg * 128 + q * 32 + p) * 16 + 8 * h);
#pragma unroll
    for (int ks = 0; ks < 4; ++ks) ccb[ks] = *(const bf16x8*)((const bf16_t*)(P.ws + WS_CCM) + ((size_t)dg * 16 + c16) * 128 + 32 * ks + 8 * g4);
    const bf16_t* HB = (const bf16_t*)(P.ws + WS_HB);
    float sr0 = 0.f, si0 = 0.f, sr1 = 0.f, si1 = 0.f;
    const int seq = it.seqX + h;
    if (it.lat) { const float* s0 = P.in[4] + ((size_t)(h * 2 + DIR) * 2) * 4096 + it.g * 64; sr0 = s0[p]; sr1 = s0[p + 32]; si0 = s0[4096 + p]; si1 = s0[4096 + p + 32]; }
    {
        const float* E = (const float*)(P.ws + WS_E);
        const int nj = DIR ? (it.nchunk - 1 - it.k) : it.k;
        float er0[15], er1[15], ei0[15], ei1[15];
#pragma unroll
        for (int jj = 0; jj < 15; ++jj) { int j = DIR ? (it.nchunk - 1 - jj) : jj; j = j < 0 ? 0 : j; j = j > it.nchunk - 1 ? it.nchunk - 1 : j;
            const float* e = E + ssm_eidx(DIR, seq, j, it.g); er0[jj] = e[p]; er1[jj] = e[p + 32]; ei0[jj] = e[64 + p]; ei1[jj] = e[64 + p + 32]; }
        float pr0 = ar0, pi0 = ai0, pr1 = ar1, pi1 = ai1;
#pragma unroll
        for (int q = 0; q < 7; ++q) { const float t0 = pr0 * pr0 - pi0 * pi0, t1 = 2.f * pr0 * pi0, t2 = pr1 * pr1 - pi1 * pi1, t3 = 2.f * pr1 * pi1; pr0 = t0; pi0 = t1; pr1 = t2; pi1 = t3; }
#pragma unroll
        for (int jj = 0; jj < 15; ++jj) {
            const float n0 = pr0 * sr0 - pi0 * si0 + er0[jj], m0 = pr0 * si0 + pi0 * sr0 + ei0[jj], n1 = pr1 * sr1 - pi1 * si1 + er1[jj], m1 = pr1 * si1 + pi1 * sr1 + ei1[jj];
            if (jj < nj) { sr0 = n0; si0 = m0; sr1 = n1; si1 = m1; }
        }
    }
    bf16_t* YB = (bf16_t*)(P.ws + WS_QB);
    bf16x8 dd;
    { const float dsk = P.in[21][16 * it.g + c16]; const unsigned short db = (unsigned short)(pk2(dsk, 0.f) & 0xffffu);
#pragma unroll
      for (int j = 0; j < 8; ++j) dd[j] = (g4 < 2 && (8 * g4 + j) == c16) ? (short)db : (short)0; }
    const int hh = (p >> 2) & 1, ii = 4 * (p >> 3) + (p & 3);
    const bf16_t* ubase = HB + (size_t)((hh ? it.tokY : it.tokX) + ii) * D + 16 * it.g + 8 * h;
    const bf16_t* uaX = HB + (size_t)(it.tokX + c16) * D + 16 * it.g + 8 * (g4 & 1);
    const bf16_t* uaY = HB + (size_t)(it.tokY + c16) * D + 16 * it.g + 8 * (g4 & 1);
    const bf16x8 zero8 = {0, 0, 0, 0, 0, 0, 0, 0};
    bf16x8 a_n = *(const bf16x8*)(ubase + (size_t)(DIR ? 112 : 0) * D), ux_n = zero8, uy_n = zero8;
    if (DIR == 0 && g4 < 2) { ux_n = *(const bf16x8*)(uaX); uy_n = *(const bf16x8*)(uaY); }
    for (int tt = 0; tt < 8; ++tt) {
        const int ti = DIR ? 7 - tt : tt;
        const bf16x8 a = a_n, ux = ux_n, uy = uy_n;
        if (tt < 7) { const int tn = DIR ? ti - 1 : ti + 1; a_n = *(const bf16x8*)(ubase + (size_t)(16 * tn) * D);
            if (DIR == 0 && g4 < 2) { ux_n = *(const bf16x8*)(uaX + (size_t)(16 * tn) * D); uy_n = *(const bf16x8*)(uaY + (size_t)(16 * tn) * D); } }
        f32x16 acc[4];
#pragma unroll
        for (int q = 0; q < 4; ++q) { f32x16 z;
#pragma unroll
            for (int i = 0; i < 16; ++i) z[i] = 0.f;
            acc[q] = __builtin_amdgcn_mfma_f32_32x32x16_bf16(a, bbq[q], z, 0, 0, 0); }
        if (DIR == 0) {
#pragma unroll
            for (int i = 0; i < 16; ++i) SSM_SCAN_STEP(i, true)
        } else {
#pragma unroll
            for (int i = 15; i >= 0; --i) SSM_SCAN_STEP(i, true)
        }
        asm volatile("" ::: "memory");
        f32x4 y[2];
        if (DIR) {
            y[0] = st[0][0]; y[1] = st[0][1];
#pragma unroll
            for (int q = 0; q < 7; ++q) { st[q][0] = st[q + 1][0]; st[q][1] = st[q + 1][1]; }
        } else { y[0] = (f32x4){0.f, 0.f, 0.f, 0.f}; y[1] = y[0];
            y[0] = __builtin_amdgcn_mfma_f32_16x16x32_bf16(ux, dd, y[0], 0, 0, 0); y[1] = __builtin_amdgcn_mfma_f32_16x16x32_bf16(uy, dd, y[1], 0, 0, 0); }
#pragma unroll
        for (int mt = 0; mt < 2; ++mt)
#pragma unroll
            for (int ks = 0; ks < 4; ++ks) { const bf16x8 sa = *(const LAS bf16x8*)(S + (16 * mt + c16) * 272 + 64 * ks + 16 * g4);
                y[mt] = __builtin_amdgcn_mfma_f32_16x16x32_bf16(sa, ccb[ks], y[mt], 0, 0, 0); }
        asm volatile("" ::: "memory");
        if (DIR == 0) {
#pragma unroll
            for (int q = 7; q > 0; --q) { st[q][0] = st[q - 1][0]; st[q][1] = st[q - 1][1]; }
            st[0][0] = y[0]; st[0][1] = y[1];
        } else {
#pragma unroll
            for (int mt = 0; mt < 2; ++mt) {
                const size_t base = (size_t)((mt ? it.tokY : it.tokX) + 16 * ti + 4 * g4) * D + 16 * it.g + c16;
#pragma unroll
                for (int i = 0; i < 4; ++i) { const float x = y[mt][i]; const float z = 1.5957691216f * (x + 0.044715f * x * x * x);
                    YB[base + (size_t)i * D] = (bf16_t)(pk2(x * __builtin_amdgcn_rcpf(1.f + __expf(-z)), 0.f) & 0xffffu); }
            }
        }
    }
    if (!it.lat && ((DIR == 0 && it.k == it.nchunk - 1) || (DIR == 1 && it.k == 0))) {
        float* so = P.out + OUT_S + ((size_t)seq * 2 + DIR) * 2 * 4096 + it.g * 64;
        so[p] = sr0; so[p + 32] = sr1; so[4096 + p] = si0; so[4096 + p + 32] = si1; }
}

DI void ssm_pass3(const Params& P, LAS unsigned char* lds) {
    const int tid = threadIdx.x, wid = tid >> 6, lane = tid & 63;
    const int gw = wid * gridDim.x + blockIdx.x;
    if (gw >= 2048) return;
    const SsmItem it = ssm_item(gw);
    LAS unsigned char* S = lds + wid * 8704;
    f32x4 st[8][2];
#pragma unroll
    for (int q = 0; q < 8; ++q) { st[q][0] = (f32x4){0.f, 0.f, 0.f, 0.f}; st[q][1] = st[q][0]; }
    ssm_dir<0>(P, it, S, st, lane);
    ssm_dir<1>(P, it, S, st, lane);
}
#undef SSM_SCAN_STEP

#define XB_TMO      128
#define XB_XCNT(j)  (256  + 64 * (j))
#define XB_XSUB(j)  (1280 + 64 * (j))
#define XB_XGEN(j)  (2304 + 64 * (j))
#define XB_TOP      3328
#define XB_TOPGEN   3392
#define XCD_BAR_WORDS 3456
#define XB_SPIN_CAP (1u << 18)
DI unsigned xb_ld(unsigned* p)              { return __hip_atomic_load(p, __ATOMIC_RELAXED, __HIP_MEMORY_SCOPE_AGENT); }
DI unsigned xb_add(unsigned* p, unsigned v) { return __hip_atomic_fetch_add(p, v, __ATOMIC_RELAXED, __HIP_MEMORY_SCOPE_AGENT); }
DI unsigned xb_xcc_id() { return (unsigned)__builtin_amdgcn_s_getreg((3 << 11) | 20) & 0xFu; }
#define XB_SPIN(cond, bar) do { unsigned _sp = 0; while (cond) { __builtin_amdgcn_s_sleep(1); \
    if ((++_sp & 255u) == 0u) { if (xb_ld(&(bar)[XB_TMO])) break; if (_sp > XB_SPIN_CAP) { atomicAdd(&(bar)[XB_TMO], 1u); break; } } } } while (0)
struct XcdBarrier { unsigned* bar; unsigned x; volatile LAS unsigned* st; };
DI XcdBarrier xcd_barrier_post(unsigned* bar, volatile LAS unsigned* st) {
    XcdBarrier b; b.bar = bar; b.x = xb_xcc_id(); b.st = st;
    if (threadIdx.x == 0) (void)xb_add(&bar[XB_XCNT(b.x)], 1u);
    return b;
}
DI void xcd_barrier_complete(unsigned* bar, unsigned x, unsigned& nloc, unsigned& nx) {
    const unsigned G = gridDim.x * gridDim.y * gridDim.z;
    unsigned sum, cnt, mine, sp = 0u;
    for (;;) {
        sum = 0u; cnt = 0u; mine = 0u;
#pragma unroll
        for (unsigned j = 0; j < 16; ++j) { const unsigned c = xb_ld(&bar[XB_XCNT(j)]); sum += c; cnt += (c > 0u) ? 1u : 0u; mine = (j == x) ? c : mine; }
        if (sum == G) break;
        __builtin_amdgcn_s_sleep(1);
        if ((++sp & 255u) == 0u) { if (xb_ld(&bar[XB_TMO])) break; if (sp > XB_SPIN_CAP) { atomicAdd(&bar[XB_TMO], 1u); break; } }
    }
    nloc = mine > 0u ? mine : 1u; nx = cnt > 0u ? cnt : 1u;
}
DI void xcd_barrier(const XcdBarrier& b) {
    asm volatile("s_waitcnt vmcnt(0)" ::: "memory");
    __syncthreads();
    if (threadIdx.x == 0) {
        unsigned* bar = b.bar;
        __builtin_amdgcn_s_waitcnt(0);
        unsigned nloc = b.st[0], nx = b.st[1];
        if (nloc == 0u) { xcd_barrier_complete(bar, b.x, nloc, nx); b.st[0] = nloc; b.st[1] = nx; }
        const unsigned old = xb_add(&bar[XB_XSUB(b.x)], 1u);
        const unsigned gen = old / nloc;
        if (old + 1u == (gen + 1u) * nloc) {
            __builtin_amdgcn_fence(__ATOMIC_RELEASE, "agent");
            asm volatile("s_waitcnt vmcnt(0)" ::: "memory");
            const unsigned og = xb_add(&bar[XB_TOP], 1u);
            const unsigned tg = og / nx;
            if (og + 1u == (tg + 1u) * nx) xb_add(&bar[XB_TOPGEN], 1u);
            else XB_SPIN(xb_ld(&bar[XB_TOPGEN]) == tg, bar);
            __builtin_amdgcn_fence(__ATOMIC_ACQUIRE, "agent");
            xb_add(&bar[XB_XGEN(b.x)], 1u);
            asm volatile("s_waitcnt vmcnt(0)" ::: "memory");
        } else {
            XB_SPIN(xb_ld(&bar[XB_XGEN(b.x)]) == gen, bar);
            __builtin_amdgcn_fence(__ATOMIC_ACQUIRE, "agent");
            asm volatile("s_waitcnt vmcnt(0)" ::: "memory");
        }
    }
    __syncthreads();
}

constexpr int NPHASE = 16;
#ifndef REPMASK
#define REPMASK 0
#endif
#ifndef EXTRA_SYNCS
#define EXTRA_SYNCS 0
#endif
constexpr int LDS_BYTES = 147456;
__global__ void __launch_bounds__(512, 2) fwd_kernel(Params P) {
    extern __shared__ __attribute__((aligned(16))) unsigned char lds_raw[];
    LAS unsigned char* lds = (LAS unsigned char*)lds_raw;
    cg::grid_group grid = cg::this_grid();
    unsigned char* ws = P.ws;
    const float* MOD = (const float*)(ws + WS_MOD);
    const int lo = P.ph_lo, hi = P.ph_hi, G = gridDim.x;
    volatile LAS unsigned* MISC = (volatile LAS unsigned*)(lds + 131072);
    if (threadIdx.x < 64) MISC[threadIdx.x] = 0u;
    __syncthreads();
    XcdBarrier bar = xcd_barrier_post((unsigned*)ws, MISC + 8);
    if (hi < 0) grid.sync();
#define IN(k) (lo <= (k) && (k) < hi)
#define SYNC(k) do { if (IN(k) && IN((k) + 1)) { xcd_barrier(bar); } } while (0)
#define PHASE(k, ...) do { if (IN(k)) { __VA_ARGS__; if ((REPMASK >> (k)) & 1) { xcd_barrier(bar); __VA_ARGS__; } } SYNC(k); } while (0)
#define GEMM_QKV { pg8::Gemm g{(const bf16_t*)(ws + WS_HB), (const bf16_t*)(ws + WS_WQKV), D, D}; pg8::StaticOrder S; S.init(T, NQKV, 1, G, blockIdx.x); \
        pg8::EpiQkv E{(bf16_t*)(ws + WS_QB), (bf16_t*)(ws + WS_KB), (bf16_t*)(ws + WS_VT), P.out + OUT_K, P.out + OUT_V, (const float*)(ws + WS_ROPE), (const float*)(ws + WS_ROPE) + 2048 * 32}; \
        pg8::gemm_phase(lds, g, S, E); }
#define GEMM_WO { pg8::Gemm g{(const bf16_t*)(ws + WS_OB), (const bf16_t*)(ws + WS_WO), D, D / 2}; pg8::StaticOrder S; S.init(T, D, 2, G, blockIdx.x); \
        pg8::EpiResid E{P.in[0], P.in[1] - (size_t)TCTX * D, (float*)(ws + WS_X), P1A, MOD + 2048, nullptr}; \
        pg8::gemm_phase(lds, g, S, E); }
#define GEMM_MLP1(l) { pg8::Gemm g{(const bf16_t*)(ws + WS_HB), (const bf16_t*)(ws + WS_W1) + (size_t)(l) * D * FF, D, D}; pg8::StaticOrder S; S.init(T, FF, 1, G, blockIdx.x); \
        pg8::EpiRelu2 E{(bf16_t*)(ws + WS_AB), FF}; pg8::gemm_phase(lds, g, S, E); }
#define GEMM_MLP2(l) { pg8::Gemm g{(const bf16_t*)(ws + WS_AB), (const bf16_t*)(ws + WS_W2) + (size_t)(l) * D * FF, FF, FF / 2}; pg8::StaticOrder S; S.init(T, D, 2, G, blockIdx.x); \
        pg8::EpiResid E{(const float*)(ws + WS_X), (const float*)(ws + WS_X), (float*)(ws + WS_X), (l) ? P1A : P1B, MOD + (l) * 3 * 6144 + 5120, (l) ? (const bf16_t*)nullptr : (const bf16_t*)P1A}; \
        pg8::gemm_phase(lds, g, S, E); }
#define GEMM_GLU { pg8::Gemm g{(const bf16_t*)(ws + WS_QB), (const bf16_t*)(ws + WS_WGLU), D, D}; pg8::StaticOrder S; S.init(T, 2 * D, 1, G, blockIdx.x); \
        pg8::EpiGlu E{(float*)(ws + WS_X), MOD + 3 * 6144 + 2048, P1B}; pg8::gemm_phase(lds, g, S, E); }
    PHASE(0, prep_phase(P, lds));
    for (int x = 0; x < EXTRA_SYNCS; ++x) xcd_barrier(bar);
    bf16_t* const P1A = (bf16_t*)(ws + WS_P1); bf16_t* const P1B = P1A + (size_t)T * D;
    PHASE(1, norm_phase<0>(P, P.in[7], MOD, 0, 1024, nullptr));
    PHASE(2, GEMM_QKV; transpose_tail(P, lds));
    PHASE(3, attn_phase(P, lds));
    PHASE(4, GEMM_WO);
    PHASE(5, norm_phase<2>(P, P.in[8], MOD, 3072, 4096, P1A));
    PHASE(6, GEMM_MLP1(0));
    PHASE(7, GEMM_MLP2(0));
    PHASE(8, norm_phase<2>(P, P.in[7] + D, MOD + 3 * 6144, 0, 1024, P1B));
    PHASE(9, ssm_pass1(P));
    PHASE(10, ssm_pass3(P, lds));
    PHASE(11, GEMM_GLU);
    PHASE(12, norm_phase<1>(P, P.in[8] + D, MOD + 3 * 6144, 3072, 4096, nullptr));
    PHASE(13, GEMM_MLP1(1));
    PHASE(14, GEMM_MLP2(1));
    PHASE(15, norm_phase<3>(P, P.in[26], MOD, 0, 0, P1A));
#undef IN
}

#ifndef MK_MULTI
#define MK_MULTI 0
#endif
extern "C" void kernel_launch(void* const* d_in, const int* in_sizes, int n_in, void* d_out, int out_size, void* d_ws, size_t ws_size, hipStream_t stream) {
    static int grid = 0;
    if (grid == 0) {
        int dev = 0, cus = 0, per_cu = 0;
        hipGetDevice(&dev);
        hipDeviceGetAttribute(&cus, hipDeviceAttributeMultiprocessorCount, dev);
        hipFuncSetAttribute((const void*)fwd_kernel, hipFuncAttributeMaxDynamicSharedMemorySize, LDS_BYTES);
        hipOccupancyMaxActiveBlocksPerMultiprocessor(&per_cu, (const void*)fwd_kernel, 512, LDS_BYTES);
        if (per_cu < 1) { fprintf(stderr, "occupancy query gave %d\n", per_cu); per_cu = 1; }
        if (per_cu > 1) per_cu = 1;
        grid = cus * per_cu;
        if (grid > 256) grid = 256;
    }
    (void)hipMemsetAsync(d_ws, 0, 16384, stream);
    Params p{};
    for (int i = 0; i < 27; ++i) p.in[i] = (const float*)d_in[i];
    p.out = (float*)d_out; p.ws = (unsigned char*)d_ws;
#if MK_MULTI
    for (int k = 0; k < NPHASE; ++k) { p.ph_lo = k; p.ph_hi = k + 1; hipLaunchKernelGGL(fwd_kernel, dim3(grid), dim3(512), LDS_BYTES, stream, p); }
#else
    p.ph_lo = 0; p.ph_hi = NPHASE;
    void* args[] = {&p};
    hipError_t e = hipLaunchCooperativeKernel((const void*)fwd_kernel, dim3(grid), dim3(512), args, LDS_BYTES, stream);
    if (e != hipSuccess) fprintf(stderr, "cooperative launch failed: %s (grid %d)\n", hipGetErrorString(e), grid);
#endif
}
```

```cpp
#include <hip/hip_runtime.h>
#include <hip/hip_cooperative_groups.h>
#include <cstdio>
#include <cstdint>
namespace cg = cooperative_groups;

#define LAS __attribute__((address_space(3)))
typedef unsigned short bf16_t;
typedef short bf16x8 __attribute__((ext_vector_type(8)));
typedef float f32x4 __attribute__((ext_vector_type(4)));
typedef float f32x16 __attribute__((ext_vector_type(16)));
typedef float f32x2 __attribute__((ext_vector_type(2)));
typedef unsigned u32x4 __attribute__((ext_vector_type(4)));
typedef unsigned u32x2 __attribute__((ext_vector_type(2)));
typedef __bf16 bf16x2v __attribute__((ext_vector_type(2)));
#define DI __device__ __forceinline__

DI unsigned pk2(float a, float b) { f32x2 v = {a, b}; bf16x2v r = __builtin_convertvector(v, bf16x2v); return __builtin_bit_cast(unsigned, r); }
DI float bf2f(unsigned short u) { return __builtin_bit_cast(float, (unsigned)u << 16); }
DI float wave_sum(float v) {
#pragma unroll
    for (int o = 1; o < 64; o <<= 1) v += __shfl_xor(v, o);
    return v;
}

constexpr int T = 8192, D = 1024, FF = 4096, NQKV = 1536, TCTX = 4096, LLAT = 2048;
constexpr int KROWS = 8704;
constexpr size_t MiB = 1u << 20;
constexpr size_t WS_MOD = 1 * MiB;
constexpr size_t WS_ABAR = 2 * MiB;
constexpr size_t WS_BBM = 2 * MiB + 128 * 1024;
constexpr size_t WS_CCM = 2 * MiB + 640 * 1024;
constexpr size_t WS_ROPE = 3 * MiB + 256 * 1024;
constexpr size_t WS_WQKV = 4 * MiB, WS_WO = 7 * MiB, WS_WGLU = 9 * MiB, WS_W1 = 13 * MiB, WS_W2 = 29 * MiB;
constexpr size_t WS_KB = 45 * MiB, WS_VT = 50 * MiB;
constexpr size_t WS_HB = 56 * MiB, WS_QB = 72 * MiB, WS_OB = 88 * MiB, WS_X = 104 * MiB, WS_P1 = 136 * MiB, WS_AB = 168 * MiB;
constexpr size_t WS_YP = 168 * MiB;
constexpr int OUT_K = 8388608, OUT_V = 8388608 + 1048576, OUT_S = 8388608 + 2 * 1048576;

struct Params { const float* in[27]; float* out; unsigned char* ws; int ph_lo, ph_hi; };

namespace pg8 {
constexpr int BM = 256, BK = 64, HALF = 128, HTB = HALF * BK * 2, STAGE_BYTES = 8 * HTB, NXCD = 8, WGM = 8;
__host__ __device__ __forceinline__ int lds_byte(int r, int c) { const int st = (r >> 4) * 2 + (c >> 5), rr = r & 15, cc = c & 31, ob = rr * 64 + cc * 2; return st * 1024 + (ob ^ (((ob >> 9) & 1) << 5)); }
__host__ __device__ __forceinline__ void stage_rc(int b, int& R, int& C) { const int st = b / 1024, sb = b % 1024, swz = sb ^ (((sb >> 9) & 1) << 5); R = (st >> 1) * 16 + swz / 64; C = (st & 1) * 32 + (swz % 64) / 2; }
__host__ __device__ __forceinline__ int perm32(int rho) { const int n = rho >> 4, i = rho & 15; return 8 * (i >> 2) + 4 * n + (i & 3); }

struct Unit { int pm, pn, ks; };
struct Gemm { const bf16_t* A; const bf16_t* Bt; int ld, Kloop; };

struct StaticOrder {
    int nM, nN, nNv, nwg, G, c;
    __device__ void init(int M, int N, int split, int G_, int c_) { nM = M / BM; nN = N / BM; nNv = nN * split; nwg = nM * nNv; G = G_; c = c_; }
    __device__ bool next(int i, Unit& u) const {
        const long L = (long)i * G + c; if (L >= nwg) return false;
        int wgid = (int)L; { const int q = nwg / NXCD, r = nwg % NXCD, xcd = wgid % NXCD, off = wgid / NXCD; wgid = (xcd < r ? xcd * (q + 1) : r * (q + 1) + (xcd - r) * q) + off; }
        const int nig = WGM * nNv, gid = wgid / nig, fm = gid * WGM, gsz = (nM - fm) < WGM ? (nM - fm) : WGM;
        u.pm = fm + ((wgid % nig) % gsz); const int pv = (wgid % nig) / gsz; u.pn = pv % nN; u.ks = pv / nN; return true;
    }
};

template <class Epi>
__device__ __forceinline__ void gemm_phase(LAS unsigned char* lds, const Gemm g, const StaticOrder& S, const Epi& E) {
    const int tid = threadIdx.x, wid = __builtin_amdgcn_readfirstlane(tid >> 6), lane = tid & 63, wr = wid >> 2, wc = wid & 3, fr = lane & 15, fq = lane >> 4;
    const int ld = g.ld, nt = g.Kloop / BK;
    unsigned voffA[2], voffB[2];
#pragma unroll
    for (int i = 0; i < 2; ++i) { int R, C; stage_rc(tid * 16 + i * 8192, R, C); const int Rb = Epi::PERM ? ((R & ~31) + perm32(R & 31)) : R;
        voffA[i] = (unsigned)(R * ld + C) * 2u; voffB[i] = (unsigned)(Rb * ld + C) * 2u; }
    const size_t kstep = (size_t)(BK * 2);
    const size_t hstep = (size_t)HALF * ld * 2;
    const size_t tstep = 2 * hstep;
    const size_t kso = (size_t)g.Kloop * 2;
    const unsigned ldsw = (unsigned)wid * 1024u;
    const int aoff = lds_byte(wr * 64 + fr, fq * 8), boff = lds_byte(wc * 32 + fr, fq * 8);
#define PG8_SA(b, h) (((b) * 2 + (h)) * HTB)
#define PG8_SB(b, h) ((4 + (b) * 2 + (h)) * HTB)
#define PG8_STAGE(bufoff, gbase, voff) do { _Pragma("unroll") for (int _i = 0; _i < 2; ++_i) \
        __builtin_amdgcn_global_load_lds((const unsigned*)((const char*)(gbase) + (voff)[_i]), (LAS unsigned*)(lds + (bufoff) + ldsw + _i * 8192), 16, 0, 0); } while (0)
#define PG8_LDA(dst, b, h) do { _Pragma("unroll") for (int m = 0; m < 4; ++m) _Pragma("unroll") for (int k = 0; k < 2; ++k) dst[m][k] = *(const LAS bf16x8*)(lds + PG8_SA(b, h) + aoff + m * 2048 + k * 1024); } while (0)
#define PG8_LDB(dst, b, h) do { _Pragma("unroll") for (int n = 0; n < 2; ++n) _Pragma("unroll") for (int k = 0; k < 2; ++k) dst[n][k] = *(const LAS bf16x8*)(lds + PG8_SB(b, h) + boff + n * 2048 + k * 1024); } while (0)
#define PG8_MMA(ai, bj, At, Bt) do { __builtin_amdgcn_s_setprio(1); _Pragma("unroll") for (int m = 0; m < 4; ++m) _Pragma("unroll") for (int n = 0; n < 2; ++n) _Pragma("unroll") for (int k = 0; k < 2; ++k) \
        acc[ai][bj][m][n] = __builtin_amdgcn_mfma_f32_16x16x32_bf16(Bt[n][k], At[m][k], acc[ai][bj][m][n], 0, 0, 0); __builtin_amdgcn_s_setprio(0); } while (0)
#define PG8_WAIT_V(n) asm volatile("s_waitcnt vmcnt(" #n ")" ::: "memory")
#define PG8_WAIT_L(n) asm volatile("s_waitcnt lgkmcnt(" #n ")" ::: "memory")
#define PG8_BAR __builtin_amdgcn_s_barrier()
#define PG8_SCHED __builtin_amdgcn_sched_barrier(0)
#define PG8_UA(u) ((const char*)g.A + (size_t)(u).pm * tstep + (size_t)(u).ks * kso)
#define PG8_UB(u) ((const char*)g.Bt + (size_t)(u).pn * tstep + (size_t)(u).ks * kso)
    Unit cur, nxt; int ui = 0;
    if (!S.next(0, cur)) return;
    f32x4 acc[2][2][4][2];
#pragma unroll
    for (int a = 0; a < 2; ++a)
#pragma unroll
        for (int b = 0; b < 2; ++b)
#pragma unroll
            for (int m = 0; m < 4; ++m)
#pragma unroll
                for (int n = 0; n < 2; ++n) acc[a][b][m][n] = (f32x4){0.f, 0.f, 0.f, 0.f};
    bf16x8 At[4][2], B0[2][2], B1[2][2];
    const char* cA = PG8_UA(cur); const char* cB = PG8_UB(cur);
    PG8_STAGE(PG8_SB(0, 0), cB, voffB); PG8_STAGE(PG8_SB(0, 1), cB + hstep, voffB); PG8_STAGE(PG8_SA(0, 0), cA, voffA); PG8_STAGE(PG8_SA(0, 1), cA + hstep, voffA);
    if (wr == 1) PG8_BAR;
    PG8_WAIT_V(2); PG8_BAR;
    PG8_STAGE(PG8_SB(1, 0), cB + kstep, voffB); PG8_STAGE(PG8_SA(1, 0), cA + kstep, voffA); PG8_STAGE(PG8_SB(1, 1), cB + hstep + kstep, voffB);
    PG8_WAIT_V(6); PG8_BAR;
    for (;;) {
        const bool has_next = S.next(ui + 1, nxt);
        const char* nA = has_next ? PG8_UA(nxt) : cA; const char* nB = has_next ? PG8_UB(nxt) : cB;
        for (int t = 0; t < nt; t += 2) {
            const bool last = (t == nt - 2);
            const char* a1 = cA + (size_t)(t + 1) * kstep;
            const char* a2 = last ? nA : cA + (size_t)(t + 2) * kstep; const char* b2 = last ? nB : cB + (size_t)(t + 2) * kstep;
            const char* a3 = a2 + kstep; const char* b3 = b2 + kstep;
            PG8_LDB(B0, 0, 0); PG8_LDB(B1, 0, 1); PG8_SCHED; PG8_LDA(At, 0, 0); PG8_STAGE(PG8_SA(1, 1), a1 + hstep, voffA);
            PG8_WAIT_V(8); PG8_WAIT_L(0); PG8_BAR; PG8_MMA(0, 0, At, B0); PG8_MMA(0, 1, At, B1); PG8_BAR; PG8_SCHED;
            PG8_LDA(At, 0, 1); PG8_STAGE(PG8_SB(0, 0), b2, voffB); PG8_STAGE(PG8_SB(0, 1), b2 + hstep, voffB); PG8_STAGE(PG8_SA(0, 0), a2, voffA);
            PG8_WAIT_V(8); PG8_WAIT_L(0); PG8_BAR; PG8_MMA(1, 0, At, B0); PG8_MMA(1, 1, At, B1); PG8_BAR; PG8_SCHED;
            PG8_LDB(B0, 1, 0); PG8_LDB(B1, 1, 1); PG8_SCHED; PG8_LDA(At, 1, 0); PG8_STAGE(PG8_SA(0, 1), a2 + hstep, voffA);
            PG8_WAIT_V(8); PG8_WAIT_L(0); PG8_BAR; PG8_MMA(0, 0, At, B0); PG8_MMA(0, 1, At, B1); PG8_BAR; PG8_SCHED;
            PG8_LDA(At, 1, 1); PG8_STAGE(PG8_SB(1, 0), b3, voffB); PG8_STAGE(PG8_SB(1, 1), b3 + hstep, voffB); PG8_STAGE(PG8_SA(1, 0), a3, voffA);
            PG8_WAIT_V(8); PG8_WAIT_L(0); PG8_BAR; PG8_MMA(1, 0, At, B0); PG8_MMA(1, 1, At, B1); PG8_BAR; PG8_SCHED;
        }
        if (wr == 0) PG8_BAR;
        E(acc, cur, wr, wc, fr, fq);
        if (!has_next) break;
#pragma unroll
        for (int a = 0; a < 2; ++a)
#pragma unroll
            for (int b = 0; b < 2; ++b)
#pragma unroll
                for (int m = 0; m < 4; ++m)
#pragma unroll
                    for (int n = 0; n < 2; ++n) acc[a][b][m][n] = (f32x4){0.f, 0.f, 0.f, 0.f};
        cur = nxt; cA = nA; cB = nB; ++ui;
        if (wr == 1) PG8_BAR;
    }
    PG8_WAIT_V(0);
    PG8_BAR;
#undef PG8_SA
#undef PG8_SB
#undef PG8_STAGE
#undef PG8_LDA
#undef PG8_LDB
#undef PG8_MMA
#undef PG8_WAIT_V
#undef PG8_WAIT_L
#undef PG8_BAR
#undef PG8_SCHED
#undef PG8_UA
#undef PG8_UB
}

struct EpiRelu2 {
    static constexpr bool PERM = true;
    bf16_t* O; int ldc;
    __device__ __forceinline__ void operator()(const f32x4 (&acc)[2][2][4][2], const Unit& u, int wr, int wc, int fr, int fq) const {
        const int row0 = u.pm * BM + wr * 64 + fr, col0 = u.pn * BM + wc * 32 + 8 * fq;
#pragma unroll
        for (int ai = 0; ai < 2; ++ai)
#pragma unroll
            for (int m = 0; m < 4; ++m) { bf16_t* rowp = O + (size_t)(row0 + ai * HALF + m * 16) * ldc + col0;
#pragma unroll
                for (int bj = 0; bj < 2; ++bj) { f32x4 v0 = acc[ai][bj][m][0], v1 = acc[ai][bj][m][1];
#pragma unroll
                    for (int j = 0; j < 4; ++j) { const float a = fmaxf(v0[j], 0.f), b = fmaxf(v1[j], 0.f); v0[j] = a * a; v1[j] = b * b; }
                    u32x4 w; w.x = pk2(v0[0], v0[1]); w.y = pk2(v0[2], v0[3]); w.z = pk2(v1[0], v1[1]); w.w = pk2(v1[2], v1[3]);
                    *(u32x4*)(rowp + bj * HALF) = w; } }
    }
};
struct EpiResid {
    static constexpr bool PERM = true;
    const float* res0; const float* res1; float* X; bf16_t* P1; const float* gate; const bf16_t* Pin;
    __device__ __forceinline__ void operator()(const f32x4 (&acc)[2][2][4][2], const Unit& u, int wr, int wc, int fr, int fq) const {
        const int vec = u.pm < 16 ? 0 : (u.pm < 24 ? 1 : 2);
        const float* gv_ = gate + vec * 6144; const float* rs = u.pm < 16 ? res0 : res1;
        const int col0 = u.pn * BM + wc * 32 + 8 * fq;
        f32x4 gv[2][2];
#pragma unroll
        for (int bj = 0; bj < 2; ++bj)
#pragma unroll
            for (int n = 0; n < 2; ++n) gv[bj][n] = *(const f32x4*)(gv_ + col0 + bj * HALF + n * 4);
#pragma unroll
        for (int ai = 0; ai < 2; ++ai)
#pragma unroll
            for (int m = 0; m < 4; ++m) { const size_t off = (size_t)(u.pm * BM + ai * HALF + wr * 64 + m * 16 + fr) * D + col0;
#pragma unroll
                for (int bj = 0; bj < 2; ++bj) {
                    const size_t e = off + bj * HALF;
                    f32x4 o0 = gv[bj][0] * acc[ai][bj][m][0], o1 = gv[bj][1] * acc[ai][bj][m][1];
                    if (u.ks == 0) { o0 += *(const f32x4*)(rs + e); o1 += *(const f32x4*)(rs + e + 4);
                        if (Pin) { const u32x4 pw = *(const u32x4*)(Pin + e);
                            o0[0] += __builtin_bit_cast(float, pw.x << 16); o0[1] += __builtin_bit_cast(float, pw.x & 0xffff0000u); o0[2] += __builtin_bit_cast(float, pw.y << 16); o0[3] += __builtin_bit_cast(float, pw.y & 0xffff0000u);
                            o1[0] += __builtin_bit_cast(float, pw.z << 16); o1[1] += __builtin_bit_cast(float, pw.z & 0xffff0000u); o1[2] += __builtin_bit_cast(float, pw.w << 16); o1[3] += __builtin_bit_cast(float, pw.w & 0xffff0000u); }
                        *(f32x4*)(X + e) = o0; *(f32x4*)(X + e + 4) = o1; }
                    else { u32x4 w; w.x = pk2(o0[0], o0[1]); w.y = pk2(o0[2], o0[3]); w.z = pk2(o1[0], o1[1]); w.w = pk2(o1[2], o1[3]); *(u32x4*)(P1 + e) = w; } } }
    }
};
struct EpiGlu {
    static constexpr bool PERM = true;
    float* X; const float* gate; const bf16_t* Pin;
    __device__ __forceinline__ void operator()(const f32x4 (&acc)[2][2][4][2], const Unit& u, int wr, int wc, int fr, int fq) const {
        const int vec = u.pm < 16 ? 0 : (u.pm < 24 ? 1 : 2);
        const float* gv_ = gate + vec * 6144;
        const int col0 = u.pn * HALF + wc * 32 + 8 * fq;
        f32x4 gv[2];
#pragma unroll
        for (int n = 0; n < 2; ++n) gv[n] = *(const f32x4*)(gv_ + col0 + n * 4);
#pragma unroll
        for (int ai = 0; ai < 2; ++ai)
#pragma unroll
            for (int m = 0; m < 4; ++m) { const size_t off = (size_t)(u.pm * BM + ai * HALF + wr * 64 + m * 16 + fr) * D + col0;
#pragma unroll
                for (int n = 0; n < 2; ++n) { const f32x4 a = acc[ai][0][m][n], b = acc[ai][1][m][n]; f32x4 o;
#pragma unroll
                    for (int j = 0; j < 4; ++j) o[j] = a[j] / (1.f + __expf(-b[j]));
                    const size_t e = off + n * 4; f32x4 xo = *(const f32x4*)(X + e) + gv[n] * o;
                    { const u32x2 pw = *(const u32x2*)(Pin + e); xo[0] += __builtin_bit_cast(float, pw.x << 16); xo[1] += __builtin_bit_cast(float, pw.x & 0xffff0000u); xo[2] += __builtin_bit_cast(float, pw.y << 16); xo[3] += __builtin_bit_cast(float, pw.y & 0xffff0000u); }
                    *(f32x4*)(X + e) = xo; } }
    }
};
struct EpiQkv {
    static constexpr bool PERM = false;
    bf16_t* QB; bf16_t* KB; bf16_t* VT; float* outK; float* outV; const float* ropec; const float* ropes;
    __device__ __forceinline__ void operator()(const f32x4 (&acc)[2][2][4][2], const Unit& u, int wr, int wc, int fr, int fq) const {
        const bool lat = u.pm >= 16;
#pragma unroll
        for (int ai = 0; ai < 2; ++ai)
#pragma unroll
            for (int m = 0; m < 4; ++m) {
                const int row = u.pm * BM + ai * HALF + wr * 64 + m * 16 + fr;
                f32x4 cs = {1.f, 1.f, 1.f, 1.f}, sn = {0.f, 0.f, 0.f, 0.f};
                if (lat && u.pn < 5) { const int tp = row & 2047; cs = *(const f32x4*)(ropec + tp * 32 + (wc & 1) * 16 + 4 * fq); sn = *(const f32x4*)(ropes + tp * 32 + (wc & 1) * 16 + 4 * fq); }
#pragma unroll
                for (int bj = 0; bj < 2; ++bj) {
                    f32x4 x1 = acc[ai][bj][m][0], x2 = acc[ai][bj][m][1];
                    const int cl = bj * HALF + wc * 32 + 4 * fq;
                    if (u.pn < 5) {
                        f32x4 y1 = x1 * cs - x2 * sn, y2 = x1 * sn + x2 * cs;
                        if (u.pn < 4) { y1 = y1 * (0.125f * 1.44269504089f); y2 = y2 * (0.125f * 1.44269504089f); }
                        bf16_t* dst = (u.pn < 4) ? (QB + (size_t)row * D + u.pn * BM + cl) : (KB + (size_t)row * 256 + cl);
                        u32x2 w1, w2; w1.x = pk2(y1[0], y1[1]); w1.y = pk2(y1[2], y1[3]); w2.x = pk2(y2[0], y2[1]); w2.y = pk2(y2[2], y2[3]);
                        *(u32x2*)dst = w1; *(u32x2*)(dst + 16) = w2;
                        if (u.pn == 4 && !lat) { *(f32x4*)(outK + (size_t)row * 256 + cl) = x1; *(f32x4*)(outK + (size_t)row * 256 + cl + 16) = x2; }
                    } else {
#pragma unroll
                        for (int j = 0; j < 4; ++j) { VT[(size_t)(cl + j) * KROWS + row] = (bf16_t)(pk2(x1[j], 0.f) & 0xffffu); VT[(size_t)(cl + 16 + j) * KROWS + row] = (bf16_t)(pk2(x2[j], 0.f) & 0xffffu); }
                        if (!lat) { *(f32x4*)(outV + (size_t)row * 256 + cl) = x1; *(f32x4*)(outV + (size_t)row * 256 + cl + 16) = x2; }
                    }
                }
            }
    }
};
}

DI void transpose_item(const float* W, int K, int N, bf16_t* WT, int k0, int n0, int drow0, LAS float* scr, int lane) {
#pragma unroll 8
    for (int i = 0; i < 32; ++i) { const int kk = 2 * i + (lane >> 5); scr[kk * 33 + (lane & 31)] = W[(size_t)(k0 + kk) * N + n0 + (lane & 31)]; }
    asm volatile("" ::: "memory");
    const int c = lane & 7;
#pragma unroll
    for (int j = 0; j < 4; ++j) { const int n = (lane >> 3) + 8 * j; const LAS float* s = scr + (8 * c) * 33 + n;
        u32x4 o; o.x = pk2(s[0 * 33], s[1 * 33]); o.y = pk2(s[2 * 33], s[3 * 33]); o.z = pk2(s[4 * 33], s[5 * 33]); o.w = pk2(s[6 * 33], s[7 * 33]);
        *(u32x4*)(WT + (size_t)(drow0 + n) * K + k0 + 8 * c) = o; }
    asm volatile("" ::: "memory");
}
DI void transpose_mat(const float* W, int K, int N, bf16_t* WT, int item, LAS float* scr, int lane, int glu  ) {
    const int nblk = N / 32, kb = item / nblk, nb = item % nblk, n0 = 32 * nb;
    int drow0 = n0;
    if (glu) drow0 = 256 * (n0 >> 7) + (n0 & 127) + (glu == 2 ? 128 : 0);
    transpose_item(W, K, N, WT, 64 * kb, n0, drow0, scr, lane);
}

constexpr int TR_I_QKV = 16 * 48, TR_I_O = 16 * 32, TR_I_G = 16 * 32, TR_I_1 = 16 * 128, TR_I_2 = 64 * 32;
constexpr int TR_NIT = TR_I_QKV + TR_I_O + 2 * TR_I_G + 2 * TR_I_1 + 2 * TR_I_2;
constexpr int TR_PREP = TR_I_QKV + TR_I_O, TR_P2 = 2560;
DI void transpose_dispatch(const Params& P, int it, LAS unsigned char* lds, int wid, int lane) {
    unsigned char* ws = P.ws;
    LAS float* scr = (LAS float*)(lds + 32768 + wid * 8704);
    int r = it;
    if (r < TR_I_QKV) { transpose_mat(P.in[11], 1024, 1536, (bf16_t*)(ws + WS_WQKV), r, scr, lane, 0); return; } r -= TR_I_QKV;
    if (r < TR_I_O) { transpose_mat(P.in[12], 1024, 1024, (bf16_t*)(ws + WS_WO), r, scr, lane, 0); return; } r -= TR_I_O;
    if (r < TR_I_G) { transpose_mat(P.in[22], 1024, 1024, (bf16_t*)(ws + WS_WGLU), r, scr, lane, 1); return; } r -= TR_I_G;
    if (r < TR_I_G) { transpose_mat(P.in[23], 1024, 1024, (bf16_t*)(ws + WS_WGLU), r, scr, lane, 2); return; } r -= TR_I_G;
    if (r < 2 * TR_I_1) { const int l = r / TR_I_1; transpose_mat(P.in[24] + (size_t)l * D * FF, 1024, 4096, (bf16_t*)(ws + WS_W1) + (size_t)l * D * FF, r % TR_I_1, scr, lane, 0); return; } r -= 2 * TR_I_1;
    { const int l = r / TR_I_2; transpose_mat(P.in[25] + (size_t)l * D * FF, 4096, 1024, (bf16_t*)(ws + WS_W2) + (size_t)l * D * FF, r % TR_I_2, scr, lane, 0); }
}
DI void transpose_tail(const Params& P, LAS unsigned char* lds, int first_idle, int lo, int hi) {
    const int G = gridDim.x, bid = blockIdx.x, wid = threadIdx.x >> 6, lane = threadIdx.x & 63;
    if (bid < first_idle) return;
    const int iw = (bid - first_idle) * 8 + wid, NIW = (G - first_idle) * 8;
    for (int it = lo + iw; it < hi; it += NIW) transpose_dispatch(P, it, lds, wid, lane);
}

DI void prep_phase(const Params& P, LAS unsigned char* lds) {
    const int tid = threadIdx.x, wid = tid >> 6, lane = tid & 63, G = gridDim.x, bid = blockIdx.x;
    unsigned char* ws = P.ws;
    if (bid < 192) {
        LAS float* sl = (LAS float*)lds;
        LAS float* red = (LAS float*)(lds + 12288);
        for (int e = tid; e < 3072; e += 512) { const int v = e >> 10, k = e & 1023; const float x = (v == 0) ? P.in[6][k] : P.in[5][(v - 1) * 1024 + k]; sl[e] = x / (1.f + __expf(-x)); }
        __syncthreads();
        const int l = bid / 96, n0 = (bid % 96) * 64, cq = lane & 15, kr = lane >> 4;
        const float* wm = P.in[9] + (size_t)l * 1024 * 6144 + n0 + 4 * cq;
        f32x4 a0 = {0.f, 0.f, 0.f, 0.f}, a1 = a0, a2 = a0;
#pragma unroll
        for (int hb = 0; hb < 2; ++hb) { f32x4 wv[16];
#pragma unroll
            for (int i = 0; i < 16; ++i) wv[i] = *(const f32x4*)(wm + (size_t)(128 * wid + 4 * (16 * hb + i) + kr) * 6144);
#pragma unroll
            for (int i = 0; i < 16; ++i) { const int k = 128 * wid + 4 * (16 * hb + i) + kr; a0 += wv[i] * sl[k]; a1 += wv[i] * sl[1024 + k]; a2 += wv[i] * sl[2048 + k]; } }
#pragma unroll
        for (int j = 0; j < 4; ++j) { a0[j] += __shfl_xor(a0[j], 16); a0[j] += __shfl_xor(a0[j], 32); a1[j] += __shfl_xor(a1[j], 16); a1[j] += __shfl_xor(a1[j], 32); a2[j] += __shfl_xor(a2[j], 16); a2[j] += __shfl_xor(a2[j], 32); }
        if (kr == 0) { *(LAS f32x4*)(red + (wid * 3 + 0) * 64 + 4 * cq) = a0; *(LAS f32x4*)(red + (wid * 3 + 1) * 64 + 4 * cq) = a1; *(LAS f32x4*)(red + (wid * 3 + 2) * 64 + 4 * cq) = a2; }
        __syncthreads();
        if (tid < 192) { const int v = tid >> 6, cc = tid & 63; float s = P.in[10][l * 6144 + n0 + cc];
#pragma unroll
            for (int w = 0; w < 8; ++w) s += red[(w * 3 + v) * 64 + cc];
            ((float*)(ws + WS_MOD))[(l * 3 + v) * 6144 + n0 + cc] = s; }
    }
    {
        const int gw = bid * 8 + wid, NGW = G * 8;
        for (int it = gw; it < (G == 256 ? TR_PREP : TR_NIT); it += NGW) transpose_dispatch(P, it, lds, wid, lane);
    }
    const int gt = bid * 512 + tid, NGT = G * 512;
    for (int e = gt; e < 2 * 256 * 256; e += NGT) {
        const int tok = e >> 8, c = e & 255;
        ((bf16_t*)(ws + WS_KB))[(size_t)(T + tok) * 256 + c] = (bf16_t)(pk2(P.in[2][e], 0.f) & 0xffffu);
    }
    for (int e = gt; e < 2 * 256 * 256; e += NGT) {
        const int c = e >> 9, tok = e & 511;
        ((bf16_t*)(ws + WS_VT))[(size_t)c * KROWS + T + tok] = (bf16_t)(pk2(P.in[3][tok * 256 + c], 0.f) & 0xffffu);
    }
    for (int e = gt; e < 2048 * 32; e += NGT) {
        const int tp = e >> 5, k = e & 31, f = k & 15; const float pos = (k >> 4) ? (float)(tp & 63) : (float)(tp >> 6);
        const float freq = powf(10000.f, -(float)f / 16.f); const float ang = pos * freq;
        ((float*)(ws + WS_ROPE))[e] = cosf(ang); ((float*)(ws + WS_ROPE))[2048 * 32 + e] = sinf(ang);
    }
    for (int idx = gt; idx < 2 * 64 * 64 * 16; idx += NGT) {
        const int e = idx >> 4, c = idx & 15, dg = e >> 6, p = e & 63;
        const float dt = expf(P.in[16][dg]), lre = P.in[14][e], lim = P.in[15][e];
        const float mag = expf(lre * dt), ang = lim * dt; const float are = mag * cosf(ang), aim = mag * sinf(ang);
        const float den = lre * lre + lim * lim, nre = are - 1.f, nim = aim;
        const float fre = (nre * lre + nim * lim) / den, fim = (nim * lre - nre * lim) / den;
        if (c == 0) { ((float*)(ws + WS_ABAR))[e * 2] = are; ((float*)(ws + WS_ABAR))[e * 2 + 1] = aim; }
        bf16_t* bbm = (bf16_t*)(ws + WS_BBM) + (size_t)dg * 128 * 16; bf16_t* ccm = (bf16_t*)(ws + WS_CCM) + (size_t)dg * 16 * 128;
        const float br = P.in[17][idx], bi = P.in[18][idx];
        bbm[p * 16 + c] = (bf16_t)(pk2(fre * br - fim * bi, 0.f) & 0xffffu);
        bbm[(64 + p) * 16 + c] = (bf16_t)(pk2(fre * bi + fim * br, 0.f) & 0xffffu);
        const float cr = P.in[19][((size_t)dg * 16 + c) * 64 + p], ci = P.in[20][((size_t)dg * 16 + c) * 64 + p];
        const int k = 4 * (p & 31) + 2 * (p >> 5);
        ccm[c * 128 + k] = (bf16_t)(pk2(cr, 0.f) & 0xffffu); ccm[c * 128 + k + 1] = (bf16_t)(pk2(-ci, 0.f) & 0xffffu);
    }
}

template <int MODE>
DI void norm_phase(const Params& P, const float* gain, const float* modl, int sh_off, int sc_off, const bf16_t* P1) {
    const int tid = threadIdx.x, wid = tid >> 6, lane = tid & 63;
    float* X = (float*)(P.ws + WS_X); bf16_t* HB = (bf16_t*)(P.ws + WS_HB);
    for (int row = blockIdx.x * 8 + wid; row < T; row += gridDim.x * 8) {
        const float* src = (MODE == 0) ? (row < TCTX ? P.in[0] + (size_t)row * D : P.in[1] + (size_t)(row - TCTX) * D) : X + (size_t)row * D;
        f32x4 v[4]; float ss = 0.f;
#pragma unroll
        for (int j = 0; j < 4; ++j) { v[j] = *(const f32x4*)(src + 4 * lane + 256 * j);
            if (MODE >= 2) { const u32x2 pw = *(const u32x2*)(P1 + (size_t)row * D + 4 * lane + 256 * j);
                v[j][0] += __builtin_bit_cast(float, pw.x << 16); v[j][1] += __builtin_bit_cast(float, pw.x & 0xffff0000u); v[j][2] += __builtin_bit_cast(float, pw.y << 16); v[j][3] += __builtin_bit_cast(float, pw.y & 0xffff0000u);
                }
            ss += (v[j][0] * v[j][0] + v[j][1] * v[j][1]) + (v[j][2] * v[j][2] + v[j][3] * v[j][3]); }
        const float rinv = rsqrtf(wave_sum(ss) * (1.f / D) + 1e-6f);
        if (MODE == 3) {
#pragma unroll
            for (int j = 0; j < 4; ++j) { const f32x4 g = *(const f32x4*)(gain + 4 * lane + 256 * j); *(f32x4*)(P.out + (size_t)row * D + 4 * lane + 256 * j) = v[j] * rinv * g; }
        } else {
            const int vec = row < TCTX ? 0 : (row < TCTX + LLAT ? 1 : 2); const float* mv = modl + vec * 6144;
#pragma unroll
            for (int j = 0; j < 4; ++j) { const int c = 4 * lane + 256 * j; const f32x4 g = *(const f32x4*)(gain + c), sc = *(const f32x4*)(mv + sc_off + c), sh = *(const f32x4*)(mv + sh_off + c);
                const f32x4 h = (v[j] * rinv * g) * (sc + 1.f) + sh; u32x2 w; w.x = pk2(h[0], h[1]); w.y = pk2(h[2], h[3]); *(u32x2*)(HB + (size_t)row * D + c) = w; }
        }
    }
}

DI void attn_phase(const Params& P, LAS unsigned char* lds) {
    const int tid = threadIdx.x, wid = tid >> 6, lane = tid & 63, r = lane & 15, g4 = lane >> 4;
    const bf16_t* QB = (const bf16_t*)(P.ws + WS_QB); const bf16_t* KB = (const bf16_t*)(P.ws + WS_KB); const bf16_t* VT = (const bf16_t*)(P.ws + WS_VT); bf16_t* OB = (bf16_t*)(P.ws + WS_OB);
    const float LOG2E = 1.44269504089f;
    const int lrow = tid >> 3, lch = tid & 7;
    for (int u = blockIdx.x; u < 1024; u += gridDim.x) {
        int h, tok0, win0, nwin, ctx0, ipos0; bool lat;
        if (u < 512) { const int b = u >> 5; h = (u >> 1) & 15; const int n = u & 1; tok0 = 256 * b + 128 * n; win0 = 0; nwin = 0; ctx0 = 256 * b; lat = false; ipos0 = 0; }
        else { const int v = u - 512, b = v >> 8; h = (v >> 4) & 15; const int n = v & 15; const int tb = TCTX + LLAT * b; tok0 = tb + 128 * n;
            const int j0 = (128 * n - 128) < 0 ? 0 : (128 * n - 128), j1 = (128 * n + 256) > LLAT ? LLAT : (128 * n + 256);
            win0 = tb + j0; nwin = (j1 - j0) >> 6; ctx0 = T + 256 * b; lat = true; ipos0 = 128 * n - j0; }
        const int kvh = h >> 2, ntile = nwin + 4;
        const bf16_t* qp = QB + (size_t)(tok0 + 16 * wid + r) * D + h * 64 + 8 * g4;
        const bf16x8 qb0 = *(const bf16x8*)qp, qb1 = *(const bf16x8*)(qp + 32);
        float m_run = P.in[13][h] * LOG2E, l_run = (g4 == 0) ? 1.f : 0.f;
        f32x4 o[4];
#pragma unroll
        for (int dt = 0; dt < 4; ++dt) o[dt] = (f32x4){0.f, 0.f, 0.f, 0.f};
        const int iq = ipos0 + 16 * wid + r;
        u32x4 kreg, vreg;
        { const int tk = (0 < nwin) ? win0 : ctx0;
          kreg = *(const u32x4*)(KB + (size_t)(tk + lrow) * 256 + kvh * 64 + lch * 8); vreg = *(const u32x4*)(VT + (size_t)(kvh * 64 + lrow) * KROWS + tk + lch * 8); }
        *(LAS u32x4*)(lds + lrow * 144 + lch * 16) = kreg; *(LAS u32x4*)(lds + 9216 + lrow * 144 + lch * 16) = vreg;
        __syncthreads();
        for (int t = 0; t < ntile; ++t) {
            LAS unsigned char* Kb = lds + (t & 1) * 18432; LAS unsigned char* Vb = Kb + 9216;
            if (t + 1 < ntile) { const int tk = (t + 1 < nwin) ? win0 + 64 * (t + 1) : ctx0 + 64 * (t + 1 - nwin);
                kreg = *(const u32x4*)(KB + (size_t)(tk + lrow) * 256 + kvh * 64 + lch * 8); vreg = *(const u32x4*)(VT + (size_t)(kvh * 64 + lrow) * KROWS + tk + lch * 8); }
            int cls = 0;
            if (lat && t < nwin) { const int iq0 = ipos0 + 16 * wid, dmin = 64 * t - (iq0 + 15), dmax = 64 * t + 63 - iq0; cls = (dmax < -128 || dmin > 128) ? 2 : ((dmin >= -128 && dmax <= 128) ? 0 : 1); }
            if (cls != 2) {
            f32x4 s[4];
#pragma unroll
            for (int kt = 0; kt < 4; ++kt) {
                const bf16x8 a0 = *(const LAS bf16x8*)(Kb + (16 * kt + r) * 144 + g4 * 16), a1 = *(const LAS bf16x8*)(Kb + (16 * kt + r) * 144 + 64 + g4 * 16);
                f32x4 z = {0.f, 0.f, 0.f, 0.f};
                z = __builtin_amdgcn_mfma_f32_16x16x32_bf16(a0, qb0, z, 0, 0, 0);
                s[kt] = __builtin_amdgcn_mfma_f32_16x16x32_bf16(a1, qb1, z, 0, 0, 0);
            }
            float mx = -3.0e38f;
            if (cls == 1) {
#pragma unroll
                for (int kt = 0; kt < 4; ++kt)
#pragma unroll
                    for (int i = 0; i < 4; ++i) { const int dj = 64 * t + 16 * kt + 4 * g4 + i - iq; if (dj > 128 || dj < -128) s[kt][i] = -1.0e30f; }
            }
#pragma unroll
            for (int kt = 0; kt < 4; ++kt)
#pragma unroll
                for (int i = 0; i < 4; ++i) mx = fmaxf(mx, s[kt][i]);
            mx = fmaxf(mx, __shfl_xor(mx, 16)); mx = fmaxf(mx, __shfl_xor(mx, 32));
            const float mnew = fmaxf(m_run, mx), alpha = __builtin_amdgcn_exp2f(m_run - mnew); m_run = mnew;
            float ls = 0.f;
#pragma unroll
            for (int kt = 0; kt < 4; ++kt)
#pragma unroll
                for (int i = 0; i < 4; ++i) { const float p = __builtin_amdgcn_exp2f(s[kt][i] - mnew); s[kt][i] = p; ls += p; }
            l_run = l_run * alpha + ls;
#pragma unroll
            for (int dt = 0; dt < 4; ++dt) o[dt] *= alpha;
            u32x4 pw01, pw23;
            pw01.x = pk2(s[0][0], s[0][1]); pw01.y = pk2(s[0][2], s[0][3]); pw01.z = pk2(s[1][0], s[1][1]); pw01.w = pk2(s[1][2], s[1][3]);
            pw23.x = pk2(s[2][0], s[2][1]); pw23.y = pk2(s[2][2], s[2][3]); pw23.z = pk2(s[3][0], s[3][1]); pw23.w = pk2(s[3][2], s[3][3]);
            const bf16x8 pb01 = __builtin_bit_cast(bf16x8, pw01), pb23 = __builtin_bit_cast(bf16x8, pw23);
#pragma unroll
            for (int dt = 0; dt < 4; ++dt) {
                const LAS unsigned char* vr = Vb + (16 * dt + r) * 144 + g4 * 8;
                u32x4 va; const u32x2 l0 = *(const LAS u32x2*)(vr), h0 = *(const LAS u32x2*)(vr + 32), l1 = *(const LAS u32x2*)(vr + 64), h1 = *(const LAS u32x2*)(vr + 96);
                va.x = l0.x; va.y = l0.y; va.z = h0.x; va.w = h0.y;
                o[dt] = __builtin_amdgcn_mfma_f32_16x16x32_bf16(__builtin_bit_cast(bf16x8, va), pb01, o[dt], 0, 0, 0);
                va.x = l1.x; va.y = l1.y; va.z = h1.x; va.w = h1.y;
                o[dt] = __builtin_amdgcn_mfma_f32_16x16x32_bf16(__builtin_bit_cast(bf16x8, va), pb23, o[dt], 0, 0, 0);
            }
            }
            if (t + 1 < ntile) { LAS unsigned char* Kn = lds + ((t + 1) & 1) * 18432; *(LAS u32x4*)(Kn + lrow * 144 + lch * 16) = kreg; *(LAS u32x4*)(Kn + 9216 + lrow * 144 + lch * 16) = vreg; }
            __syncthreads();
        }
        float l = l_run; l += __shfl_xor(l, 16); l += __shfl_xor(l, 32);
        const float inv = 1.f / l;
        bf16_t* op = OB + (size_t)(tok0 + 16 * wid + r) * D + h * 64 + 4 * g4;
#pragma unroll
        for (int dt = 0; dt < 4; ++dt) { u32x2 w; w.x = pk2(o[dt][0] * inv, o[dt][1] * inv); w.y = pk2(o[dt][2] * inv, o[dt][3] * inv); *(u32x2*)(op + 16 * dt) = w; }
    }
}

constexpr size_t WS_E = 232 * MiB;
struct SsmItem { int g, k, nchunk, seqX, tokX, tokY; bool lat; };
DI SsmItem ssm_item(int gw) {
    SsmItem it; int pi;
    if (gridDim.x == 256) { const int bid = gw & 255, wid = gw >> 8; it.g = (bid & 7) * 8 + ((bid >> 3) & 7); pi = wid * 4 + (bid >> 6); }
    else { it.g = gw & 63; pi = gw >> 6; }
    if (pi < 16) { const int sp = pi >> 1; it.k = pi & 1; it.nchunk = 2; it.seqX = 2 * sp; it.tokX = 512 * sp + 128 * it.k; it.tokY = it.tokX + 256; it.lat = false; }
    else { it.k = pi - 16; it.nchunk = 16; it.seqX = 16; it.tokX = TCTX + 128 * it.k; it.tokY = it.tokX + LLAT; it.lat = true; }
    return it;
}
DI size_t ssm_eidx(int dir, int seq, int chunk, int g) { return ((((size_t)dir * 18 + seq) * 16 + chunk) * 64 + g) * 128; }

#define SSM_SCAN_STEP(i, WRITE_S) { const float nr0 = ar0 * sr0 - ai0 * si0 + acc[0][i], ni0 = ar0 * si0 + ai0 * sr0 + acc[2][i]; \
        const float nr1 = ar1 * sr1 - ai1 * si1 + acc[1][i], ni1 = ar1 * si1 + ai1 * sr1 + acc[3][i]; \
        sr0 = nr0; si0 = ni0; sr1 = nr1; si1 = ni1; \
        if (WRITE_S) { u32x2 w; w.x = pk2(nr0, ni0); w.y = pk2(nr1, ni1); *(LAS u32x2*)(S + (16 * h + (i)) * 272 + p * 8) = w; } }

DI void ssm_pass1(const Params& P) {
    const int tid = threadIdx.x, wid = tid >> 6, lane = tid & 63, p = lane & 31, h = lane >> 5;
    const int gw = wid * gridDim.x + blockIdx.x;
    if (gw >= 2048) return;
    const SsmItem it = ssm_item(gw);
    const bf16_t* HB = (const bf16_t*)(P.ws + WS_HB);
    float* E = (float*)(P.ws + WS_E);
    const int hh = (p >> 2) & 1, ii = 4 * (p >> 3) + (p & 3);
    const bf16_t* ubase = HB + (size_t)((hh ? it.tokY : it.tokX) + ii) * D + 16 * it.g + 8 * h;
    bf16x8 a[8];
#pragma unroll
    for (int t = 0; t < 8; ++t) a[t] = *(const bf16x8*)(ubase + (size_t)(16 * t) * D);
    LAS unsigned char* S = nullptr;
#pragma unroll
    for (int dir = 0; dir < 2; ++dir) {
        const int dg = dir * 64 + it.g;
        const float* ab = (const float*)(P.ws + WS_ABAR) + (size_t)dg * 128;
        const float ar0 = ab[2 * p], ai0 = ab[2 * p + 1], ar1 = ab[2 * (p + 32)], ai1 = ab[2 * (p + 32) + 1];
        bf16x8 bbq[4];
#pragma unroll
        for (int q = 0; q < 4; ++q) bbq[q] = *(const bf16x8*)((const bf16_t*)(P.ws + WS_BBM) + ((size_t)dg * 128 + q * 32 + p) * 16 + 8 * h);
        float sr0 = 0.f, si0 = 0.f, sr1 = 0.f, si1 = 0.f;
#pragma unroll
        for (int tt = 0; tt < 8; ++tt) {
            const int ti = dir ? 7 - tt : tt;
            f32x16 acc[4];
#pragma unroll
            for (int q = 0; q < 4; ++q) { f32x16 z;
#pragma unroll
                for (int i = 0; i < 16; ++i) z[i] = 0.f;
                acc[q] = __builtin_amdgcn_mfma_f32_32x32x16_bf16(a[ti], bbq[q], z, 0, 0, 0); }
            if (dir == 0) {
#pragma unroll
                for (int i = 0; i < 16; ++i) SSM_SCAN_STEP(i, false)
            } else {
#pragma unroll
                for (int i = 15; i >= 0; --i) SSM_SCAN_STEP(i, false)
            }
        }
        float* e = E + ssm_eidx(dir, it.seqX + h, it.k, it.g);
        e[p] = sr0; e[p + 32] = sr1; e[64 + p] = si0; e[64 + p + 32] = si1;
    }
}

template <int DIR>
DI void ssm_dir(const Params& P, const SsmItem& it, LAS unsigned char* S, f32x4 (&st)[8][2], int lane) {
    const int p = lane & 31, h = lane >> 5, c16 = lane & 15, g4 = lane >> 4;
    const int dg = DIR * 64 + it.g;
    const float* ab = (const float*)(P.ws + WS_ABAR) + (size_t)dg * 128;
    const float ar0 = ab[2 * p], ai0 = ab[2 * p + 1], ar1 = ab[2 * (p + 32)], ai1 = ab[2 * (p + 32) + 1];
    bf16x8 bbq[4], ccb[4];
#pragma unroll
    for (int q = 0; q < 4; ++q) bbq[q] = *(const bf16x8*)((const bf16_t*)(P.ws + WS_BBM) + ((size_t)dg * 128 + q * 32 + p) * 16 + 8 * h);
#pragma unroll
    for (int ks = 0; ks < 4; ++ks) ccb[ks] = *(const bf16x8*)((const bf16_t*)(P.ws + WS_CCM) + ((size_t)dg * 16 + c16) * 128 + 32 * ks + 8 * g4);
    const bf16_t* HB = (const bf16_t*)(P.ws + WS_HB);
    float sr0 = 0.f, si0 = 0.f, sr1 = 0.f, si1 = 0.f;
    const int seq = it.seqX + h;
    if (it.lat) { const float* s0 = P.in[4] + ((size_t)(h * 2 + DIR) * 2) * 4096 + it.g * 64; sr0 = s0[p]; sr1 = s0[p + 32]; si0 = s0[4096 + p]; si1 = s0[4096 + p + 32]; }
    {
        const float* E = (const float*)(P.ws + WS_E);
        const int nj = DIR ? (it.nchunk - 1 - it.k) : it.k;
        float er0[15], er1[15], ei0[15], ei1[15];
#pragma unroll
        for (int jj = 0; jj < 15; ++jj) { int j = DIR ? (it.nchunk - 1 - jj) : jj; j = j < 0 ? 0 : j; j = j > it.nchunk - 1 ? it.nchunk - 1 : j;
            const float* e = E + ssm_eidx(DIR, seq, j, it.g); er0[jj] = e[p]; er1[jj] = e[p + 32]; ei0[jj] = e[64 + p]; ei1[jj] = e[64 + p + 32]; }
        float pr0 = ar0, pi0 = ai0, pr1 = ar1, pi1 = ai1;
#pragma unroll
        for (int q = 0; q < 7; ++q) { const float t0 = pr0 * pr0 - pi0 * pi0, t1 = 2.f * pr0 * pi0, t2 = pr1 * pr1 - pi1 * pi1, t3 = 2.f * pr1 * pi1; pr0 = t0; pi0 = t1; pr1 = t2; pi1 = t3; }
#pragma unroll
        for (int jj = 0; jj < 15; ++jj) {
            const float n0 = pr0 * sr0 - pi0 * si0 + er0[jj], m0 = pr0 * si0 + pi0 * sr0 + ei0[jj], n1 = pr1 * sr1 - pi1 * si1 + er1[jj], m1 = pr1 * si1 + pi1 * sr1 + ei1[jj];
            if (jj < nj) { sr0 = n0; si0 = m0; sr1 = n1; si1 = m1; }
        }
    }
    bf16_t* YB = (bf16_t*)(P.ws + WS_QB);
    bf16x8 dd;
    { const float dsk = P.in[21][16 * it.g + c16]; const unsigned short db = (unsigned short)(pk2(dsk, 0.f) & 0xffffu);
#pragma unroll
      for (int j = 0; j < 8; ++j) dd[j] = (g4 < 2 && (8 * g4 + j) == c16) ? (short)db : (short)0; }
    const int hh = (p >> 2) & 1, ii = 4 * (p >> 3) + (p & 3);
    const bf16_t* ubase = HB + (size_t)((hh ? it.tokY : it.tokX) + ii) * D + 16 * it.g + 8 * h;
    const bf16_t* uaX = HB + (size_t)(it.tokX + c16) * D + 16 * it.g + 8 * (g4 & 1);
    const bf16_t* uaY = HB + (size_t)(it.tokY + c16) * D + 16 * it.g + 8 * (g4 & 1);
    const bf16x8 zero8 = {0, 0, 0, 0, 0, 0, 0, 0};
    bf16x8 a_n = *(const bf16x8*)(ubase + (size_t)(DIR ? 112 : 0) * D), ux_n = zero8, uy_n = zero8;
    if (DIR == 0 && g4 < 2) { ux_n = *(const bf16x8*)(uaX); uy_n = *(const bf16x8*)(uaY); }
    for (int tt = 0; tt < 8; ++tt) {
        const int ti = DIR ? 7 - tt : tt;
        const bf16x8 a = a_n, ux = ux_n, uy = uy_n;
        if (tt < 7) { const int tn = DIR ? ti - 1 : ti + 1; a_n = *(const bf16x8*)(ubase + (size_t)(16 * tn) * D);
            if (DIR == 0 && g4 < 2) { ux_n = *(const bf16x8*)(uaX + (size_t)(16 * tn) * D); uy_n = *(const bf16x8*)(uaY + (size_t)(16 * tn) * D); } }
        f32x16 acc[4];
#pragma unroll
        for (int q = 0; q < 4; ++q) { f32x16 z;
#pragma unroll
            for (int i = 0; i < 16; ++i) z[i] = 0.f;
            acc[q] = __builtin_amdgcn_mfma_f32_32x32x16_bf16(a, bbq[q], z, 0, 0, 0); }
        if (DIR == 0) {
#pragma unroll
            for (int i = 0; i < 16; ++i) SSM_SCAN_STEP(i, true)
        } else {
#pragma unroll
            for (int i = 15; i >= 0; --i) SSM_SCAN_STEP(i, true)
        }
        asm volatile("" ::: "memory");
        f32x4 y[2];
        if (DIR) {
            y[0] = st[0][0]; y[1] = st[0][1];
#pragma unroll
            for (int q = 0; q < 7; ++q) { st[q][0] = st[q + 1][0]; st[q][1] = st[q + 1][1]; }
        } else { y[0] = (f32x4){0.f, 0.f, 0.f, 0.f}; y[1] = y[0];
            y[0] = __builtin_amdgcn_mfma_f32_16x16x32_bf16(ux, dd, y[0], 0, 0, 0); y[1] = __builtin_amdgcn_mfma_f32_16x16x32_bf16(uy, dd, y[1], 0, 0, 0); }
#pragma unroll
        for (int mt = 0; mt < 2; ++mt)
#pragma unroll
            for (int ks = 0; ks < 4; ++ks) { const bf16x8 sa = *(const LAS bf16x8*)(S + (16 * mt + c16) * 272 + 64 * ks + 16 * g4);
                y[mt] = __builtin_amdgcn_mfma_f32_16x16x32_bf16(sa, ccb[ks], y[mt], 0, 0, 0); }
        asm volatile("" ::: "memory");
        if (DIR == 0) {
#pragma unroll
            for (int q = 7; q > 0; --q) { st[q][0] = st[q - 1][0]; st[q][1] = st[q - 1][1]; }
            st[0][0] = y[0]; st[0][1] = y[1];
        } else {
#pragma unroll
            for (int mt = 0; mt < 2; ++mt) {
                const size_t base = (size_t)((mt ? it.tokY : it.tokX) + 16 * ti + 4 * g4) * D + 16 * it.g + c16;
#pragma unroll
                for (int i = 0; i < 4; ++i) { const float x = y[mt][i]; const float z = 1.5957691216f * (x + 0.044715f * x * x * x);
                    YB[base + (size_t)i * D] = (bf16_t)(pk2(x * __builtin_amdgcn_rcpf(1.f + __expf(-z)), 0.f) & 0xffffu); }
            }
        }
    }
    if (!it.lat && ((DIR == 0 && it.k == it.nchunk - 1) || (DIR == 1 && it.k == 0))) {
        float* so = P.out + OUT_S + ((size_t)seq * 2 + DIR) * 2 * 4096 + it.g * 64;
        so[p] = sr0; so[p + 32] = sr1; so[4096 + p] = si0; so[4096 + p + 32] = si1; }
}

DI void ssm_pass3(const Params& P, LAS unsigned char* lds) {
    const int tid = threadIdx.x, wid = tid >> 6, lane = tid & 63;
    const int gw = wid * gridDim.x + blockIdx.x;
    if (gw >= 2048) return;
    const SsmItem it = ssm_item(gw);
    LAS unsigned char* S = lds + wid * 8704;
    f32x4 st[8][2];
#pragma unroll
    for (int q = 0; q < 8; ++q) { st[q][0] = (f32x4){0.f, 0.f, 0.f, 0.f}; st[q][1] = st[q][0]; }
    ssm_dir<0>(P, it, S, st, lane);
    ssm_dir<1>(P, it, S, st, lane);
}
#undef SSM_SCAN_STEP

#define XB_TMO      128
#define XB_XCNT(j)  (256  + 64 * (j))
#define XB_XSUB(j)  (1280 + 64 * (j))
#define XB_XGEN(j)  (2304 + 64 * (j))
#define XB_TOP      3328
#define XB_TOPGEN   3392
#define XCD_BAR_WORDS 3456
#define XB_SPIN_CAP (1u << 18)
DI unsigned xb_ld(unsigned* p)              { return __hip_atomic_load(p, __ATOMIC_RELAXED, __HIP_MEMORY_SCOPE_AGENT); }
DI unsigned xb_add(unsigned* p, unsigned v) { return __hip_atomic_fetch_add(p, v, __ATOMIC_RELAXED, __HIP_MEMORY_SCOPE_AGENT); }
DI unsigned xb_xcc_id() { return (unsigned)__builtin_amdgcn_s_getreg((3 << 11) | 20) & 0xFu; }
#define XB_SPIN(cond, bar) do { unsigned _sp = 0; while (cond) { __builtin_amdgcn_s_sleep(1); \
    if ((++_sp & 255u) == 0u) { if (xb_ld(&(bar)[XB_TMO])) break; if (_sp > XB_SPIN_CAP) { atomicAdd(&(bar)[XB_TMO], 1u); break; } } } } while (0)
struct XcdBarrier { unsigned* bar; unsigned x; volatile LAS unsigned* st; };
DI XcdBarrier xcd_barrier_post(unsigned* bar, volatile LAS unsigned* st) {
    XcdBarrier b; b.bar = bar; b.x = xb_xcc_id(); b.st = st;
    if (threadIdx.x == 0) (void)xb_add(&bar[XB_XCNT(b.x)], 1u);
    return b;
}
DI void xcd_barrier_complete(unsigned* bar, unsigned x, unsigned& nloc, unsigned& nx) {
    const unsigned G = gridDim.x * gridDim.y * gridDim.z;
    unsigned sum, cnt, mine, sp = 0u;
    for (;;) {
        sum = 0u; cnt = 0u; mine = 0u;
#pragma unroll
        for (unsigned j = 0; j < 16; ++j) { const unsigned c = xb_ld(&bar[XB_XCNT(j)]); sum += c; cnt += (c > 0u) ? 1u : 0u; mine = (j == x) ? c : mine; }
        if (sum == G) break;
        __builtin_amdgcn_s_sleep(1);
        if ((++sp & 255u) == 0u) { if (xb_ld(&bar[XB_TMO])) break; if (sp > XB_SPIN_CAP) { atomicAdd(&bar[XB_TMO], 1u); break; } }
    }
    nloc = mine > 0u ? mine : 1u; nx = cnt > 0u ? cnt : 1u;
}
DI void xcd_barrier(const XcdBarrier& b) {
    asm volatile("s_waitcnt vmcnt(0)" ::: "memory");
    __syncthreads();
    if (threadIdx.x == 0) {
        unsigned* bar = b.bar;
        __builtin_amdgcn_s_waitcnt(0);
        unsigned nloc = b.st[0], nx = b.st[1];
        if (nloc == 0u) { xcd_barrier_complete(bar, b.x, nloc, nx); b.st[0] = nloc; b.st[1] = nx; }
        const unsigned old = xb_add(&bar[XB_XSUB(b.x)], 1u);
        const unsigned gen = old / nloc;
        if (old + 1u == (gen + 1u) * nloc) {
            __builtin_amdgcn_fence(__ATOMIC_RELEASE, "agent");
            asm volatile("s_waitcnt vmcnt(0)" ::: "memory");
            const unsigned og = xb_add(&bar[XB_TOP], 1u);
            const unsigned tg = og / nx;
            if (og + 1u == (tg + 1u) * nx) xb_add(&bar[XB_TOPGEN], 1u);
            else XB_SPIN(xb_ld(&bar[XB_TOPGEN]) == tg, bar);
            __builtin_amdgcn_fence(__ATOMIC_ACQUIRE, "agent");
            xb_add(&bar[XB_XGEN(b.x)], 1u);
            asm volatile("s_waitcnt vmcnt(0)" ::: "memory");
        } else {
            XB_SPIN(xb_ld(&bar[XB_XGEN(b.x)]) == gen, bar);
            __builtin_amdgcn_fence(__ATOMIC_ACQUIRE, "agent");
            asm volatile("s_waitcnt vmcnt(0)" ::: "memory");
        }
    }
    __syncthreads();
}

constexpr int NPHASE = 16;
#ifndef REPMASK
#define REPMASK 0
#endif
#ifndef EXTRA_SYNCS
#define EXTRA_SYNCS 0
#endif
constexpr int LDS_BYTES = 147456;
__global__ void __launch_bounds__(512, 2) fwd_kernel(Params P) {
    extern __shared__ __attribute__((aligned(16))) unsigned char lds_raw[];
    LAS unsigned char* lds = (LAS unsigned char*)lds_raw;
    cg::grid_group grid = cg::this_grid();
    unsigned char* ws = P.ws;
    const float* MOD = (const float*)(ws + WS_MOD);
    const int lo = P.ph_lo, hi = P.ph_hi, G = gridDim.x;
    volatile LAS unsigned* MISC = (volatile LAS unsigned*)(lds + 131072);
    if (threadIdx.x < 64) MISC[threadIdx.x] = 0u;
    __syncthreads();
    XcdBarrier bar = xcd_barrier_post((unsigned*)ws, MISC + 8);
    if (hi < 0) grid.sync();
#define IN(k) (lo <= (k) && (k) < hi)
#define SYNC(k) do { if (IN(k) && IN((k) + 1)) { xcd_barrier(bar); } } while (0)
#define PHASE(k, ...) do { if (IN(k)) { __VA_ARGS__; if ((REPMASK >> (k)) & 1) { xcd_barrier(bar); __VA_ARGS__; } } SYNC(k); } while (0)
#define GEMM_QKV { pg8::Gemm g{(const bf16_t*)(ws + WS_HB), (const bf16_t*)(ws + WS_WQKV), D, D}; pg8::StaticOrder S; S.init(T, NQKV, 1, G, blockIdx.x); \
        pg8::EpiQkv E{(bf16_t*)(ws + WS_QB), (bf16_t*)(ws + WS_KB), (bf16_t*)(ws + WS_VT), P.out + OUT_K, P.out + OUT_V, (const float*)(ws + WS_ROPE), (const float*)(ws + WS_ROPE) + 2048 * 32}; \
        pg8::gemm_phase(lds, g, S, E); }
#define GEMM_WO { pg8::Gemm g{(const bf16_t*)(ws + WS_OB), (const bf16_t*)(ws + WS_WO), D, D}; pg8::StaticOrder S; S.init(T, D, 1, G, blockIdx.x); \
        pg8::EpiResid E{P.in[0], P.in[1] - (size_t)TCTX * D, (float*)(ws + WS_X), P1A, MOD + 2048, nullptr}; \
        pg8::gemm_phase(lds, g, S, E); }
#define GEMM_MLP1(l) { pg8::Gemm g{(const bf16_t*)(ws + WS_HB), (const bf16_t*)(ws + WS_W1) + (size_t)(l) * D * FF, D, D}; pg8::StaticOrder S; S.init(T, FF, 1, G, blockIdx.x); \
        pg8::EpiRelu2 E{(bf16_t*)(ws + WS_AB), FF}; pg8::gemm_phase(lds, g, S, E); }
#define GEMM_MLP2(l) { pg8::Gemm g{(const bf16_t*)(ws + WS_AB), (const bf16_t*)(ws + WS_W2) + (size_t)(l) * D * FF, FF, FF / 2}; pg8::StaticOrder S; S.init(T, D, 2, G, blockIdx.x); \
        pg8::EpiResid E{(const float*)(ws + WS_X), (const float*)(ws + WS_X), (float*)(ws + WS_X), (l) ? P1A : P1B, MOD + (l) * 3 * 6144 + 5120, (const bf16_t*)nullptr}; \
        pg8::gemm_phase(lds, g, S, E); }
#define GEMM_GLU { pg8::Gemm g{(const bf16_t*)(ws + WS_QB), (const bf16_t*)(ws + WS_WGLU), D, D}; pg8::StaticOrder S; S.init(T, 2 * D, 1, G, blockIdx.x); \
        pg8::EpiGlu E{(float*)(ws + WS_X), MOD + 3 * 6144 + 2048, P1B}; pg8::gemm_phase(lds, g, S, E); }
    PHASE(0, prep_phase(P, lds));
    for (int x = 0; x < EXTRA_SYNCS; ++x) xcd_barrier(bar);
    bf16_t* const P1A = (bf16_t*)(ws + WS_P1); bf16_t* const P1B = P1A + (size_t)T * D;
    PHASE(1, norm_phase<0>(P, P.in[7], MOD, 0, 1024, nullptr));
    PHASE(2, GEMM_QKV; if (G == 256) transpose_tail(P, lds, 192, TR_PREP, TR_PREP + TR_P2));
    PHASE(3, attn_phase(P, lds));
    PHASE(4, GEMM_WO; if (G == 256) transpose_tail(P, lds, 128, TR_PREP + TR_P2, TR_NIT));
    PHASE(5, norm_phase<1>(P, P.in[8], MOD, 3072, 4096, nullptr));
    PHASE(6, GEMM_MLP1(0));
    PHASE(7, GEMM_MLP2(0));
    PHASE(8, norm_phase<2>(P, P.in[7] + D, MOD + 3 * 6144, 0, 1024, P1B));
    PHASE(9, ssm_pass1(P));
    PHASE(10, ssm_pass3(P, lds));
    PHASE(11, GEMM_GLU);
    PHASE(12, norm_phase<1>(P, P.in[8] + D, MOD + 3 * 6144, 3072, 4096, nullptr));
    PHASE(13, GEMM_MLP1(1));
    PHASE(14, GEMM_MLP2(1));
    PHASE(15, norm_phase<3>(P, P.in[26], MOD, 0, 0, P1A));
#undef IN
}

#ifndef MK_MULTI
#define MK_MULTI 0
#endif
extern "C" void kernel_launch(void* const* d_in, const int* in_sizes, int n_in, void* d_out, int out_size, void* d_ws, size_t ws_size, hipStream_t stream) {
    static int grid = 0;
    if (grid == 0) {
        int dev = 0, cus = 0, per_cu = 0;
        hipGetDevice(&dev);
        hipDeviceGetAttribute(&cus, hipDeviceAttributeMultiprocessorCount, dev);
        hipFuncSetAttribute((const void*)fwd_kernel, hipFuncAttributeMaxDynamicSharedMemorySize, LDS_BYTES);
        hipOccupancyMaxActiveBlocksPerMultiprocessor(&per_cu, (const void*)fwd_kernel, 512, LDS_BYTES);
        if (per_cu < 1) { fprintf(stderr, "occupancy query gave %d\n", per_cu); per_cu = 1; }
        if (per_cu > 1) per_cu = 1;
        grid = cus * per_cu;
        if (grid > 256) grid = 256;
    }
    (void)hipMemsetAsync(d_ws, 0, 16384, stream);
    Params p{};
    for (int i = 0; i < 27; ++i) p.in[i] = (const float*)d_in[i];
    p.out = (float*)d_out; p.ws = (unsigned char*)d_ws;
#if MK_MULTI
    for (int k = 0; k < NPHASE; ++k) { p.ph_lo = k; p.ph_hi = k + 1; hipLaunchKernelGGL(fwd_kernel, dim3(grid), dim3(512), LDS_BYTES, stream, p); }
#else
    p.ph_lo = 0; p.ph_hi = NPHASE;
    void* args[] = {&p};
    hipError_t e = hipLaunchCooperativeKernel((const void*)fwd_kernel, dim3(grid), dim3(512), args, LDS_BYTES, stream);
    if (e != hipSuccess) fprintf(stderr, "cooperative launch failed: %s (grid %d)\n", hipGetErrorString(e), grid);
#endif
}
```
